# Optimizing an MI355X kernel written in HIP

```python
import math
import jax, jax.numpy as jnp
from jax import lax
import numpy as np

D_MODEL = 1024
BATCH = 2
SEQ = 8192
DEPTH = 2

D_MIX = D_MODEL
HEAD_DIM = 64
N_HEADS = 8
N_KV_HEADS = 2
Q_PER_KV = N_HEADS // N_KV_HEADS
D_ATTN = N_HEADS * HEAD_DIM
D_KV = N_KV_HEADS * HEAD_DIM
WINDOW = 128
BLOCK = 128
N_GM_GROUPS = 8
GM_GROUP_DIM = 64
D_GM = N_GM_GROUPS * GM_GROUP_DIM
CHUNK = 128
D_IN = D_ATTN + 2 * D_KV + D_ATTN + 3 * D_GM
EPS = 1e-6
NEG_INF = -1e30

kernel_name = "hymba_style_bidir_attn_gmlp_hybrid"


def _rms(x, eps=EPS):
    xf = x.astype(jnp.float32)
    return (xf * lax.rsqrt(jnp.mean(xf * xf, axis=-1, keepdims=True) + eps)).astype(x.dtype)


def _alibi_slopes(n_heads):
    return 2.0 ** (-8.0 * jnp.arange(1, n_heads + 1, dtype=jnp.float32) / n_heads)


def _windowed_gqa(q, k, v, q_gain, k_gain, sink):
    b, s = q.shape[0], q.shape[1]
    nb = s // BLOCK
    q = _rms(q) * q_gain
    k = _rms(k) * k_gain
    qb = q.reshape(b, nb, BLOCK, N_KV_HEADS, Q_PER_KV, HEAD_DIM)
    pad = ((0, 0), (BLOCK, BLOCK), (0, 0), (0, 0))
    kp = jnp.pad(k, pad).reshape(b, nb + 2, BLOCK, N_KV_HEADS, HEAD_DIM)
    vp = jnp.pad(v, pad).reshape(b, nb + 2, BLOCK, N_KV_HEADS, HEAD_DIM)
    kb = jnp.concatenate([kp[:, :-2], kp[:, 1:-1], kp[:, 2:]], axis=2)
    vb = jnp.concatenate([vp[:, :-2], vp[:, 1:-1], vp[:, 2:]], axis=2)
    scores = jnp.einsum('bnqkgd,bnskd->bnkgqs', qb, kb).astype(jnp.float32) / math.sqrt(HEAD_DIM)
    blk = jnp.arange(nb)[:, None, None]
    qpos = blk * BLOCK + jnp.arange(BLOCK)[None, :, None]
    kpos = blk * BLOCK - BLOCK + jnp.arange(3 * BLOCK)[None, None, :]
    dist = jnp.abs(kpos - qpos).astype(jnp.float32)
    valid = (dist <= WINDOW) & (kpos >= 0) & (kpos < s)
    slopes = _alibi_slopes(N_HEADS).reshape(N_KV_HEADS, Q_PER_KV)
    scores = scores - slopes[None, None, :, :, None, None] * dist[None, :, None, None]
    scores = jnp.where(valid[None, :, None, None], scores, NEG_INF)
    sink_col = jnp.broadcast_to(
        sink.astype(jnp.float32).reshape(N_KV_HEADS, Q_PER_KV)[None, None, :, :, None, None],
        scores.shape[:-1] + (1,))
    probs = jax.nn.softmax(jnp.concatenate([scores, sink_col], axis=-1), axis=-1)[..., :-1]
    out = jnp.einsum('bnkgqs,bnskd->bnqkgd', probs.astype(v.dtype), vb)
    return out.reshape(b, s, D_ATTN)


def _chunked_gmlp(u, vg, w_s, b_s):
    b, s = u.shape[0], u.shape[1]
    nc = s // CHUNK
    vn = _rms(vg.reshape(b, nc, CHUNK, N_GM_GROUPS, GM_GROUP_DIM))
    sv = jnp.einsum('gts,bcsge->bctge', w_s, vn) + b_s.T[None, None, :, :, None]
    return u * sv.reshape(b, s, D_GM)


def setup_inputs(seed: int = 0) -> dict:
    key = jax.random.key(seed)
    ks = jax.random.split(key, 12)
    f32 = jnp.float32
    x = jax.random.normal(ks[0], (BATCH, SEQ, D_MODEL), f32)
    c = jax.random.normal(ks[1], (BATCH, D_MODEL), f32)
    w_ada = jax.random.normal(ks[2], (DEPTH, D_MODEL, 3 * D_MODEL), f32) * D_MODEL ** -0.5
    b_ada = jax.random.normal(ks[3], (DEPTH, 3 * D_MODEL), f32) * 0.02
    norm_gain = 1.0 + 0.01 * jax.random.normal(ks[4], (DEPTH, D_MODEL), f32)
    w_in = jax.random.normal(ks[5], (DEPTH, D_MODEL, D_IN), f32) * D_MODEL ** -0.5
    q_gain = 1.0 + 0.01 * jax.random.normal(ks[6], (DEPTH, HEAD_DIM), f32)
    k_gain = 1.0 + 0.01 * jax.random.normal(ks[7], (DEPTH, HEAD_DIM), f32)
    sink = jax.random.normal(ks[8], (DEPTH, N_HEADS), f32) * 0.5
    w_s = jax.random.normal(ks[9], (DEPTH, N_GM_GROUPS, CHUNK, CHUNK), f32) * (0.5 * CHUNK ** -0.5)
    b_s = 1.0 + 0.01 * jax.random.normal(ks[10], (DEPTH, N_GM_GROUPS, CHUNK), f32)
    w_out = jax.random.normal(ks[11], (DEPTH, D_MIX, D_MODEL), f32) * D_MIX ** -0.5
    return {"x": x, "c": c, "w_ada": w_ada, "b_ada": b_ada, "norm_gain": norm_gain,
            "w_in": w_in, "q_gain": q_gain, "k_gain": k_gain, "sink": sink,
            "w_s": w_s, "b_s": b_s, "w_out": w_out}


def reference(x, c, w_ada, b_ada, norm_gain, w_in, q_gain, k_gain, sink, w_s, b_s, w_out):
    b, s, _ = x.shape
    cond = jax.nn.silu(c)
    splits = np.cumsum([D_ATTN, D_KV, D_KV, D_ATTN, D_GM, D_GM])
    for l in range(DEPTH):
        ada = cond @ w_ada[l] + b_ada[l]
        shift, scale, gate = jnp.split(ada, 3, axis=-1)
        h = _rms(x) * norm_gain[l]
        h = h * (1.0 + scale[:, None, :]) + shift[:, None, :]
        proj = h @ w_in[l]
        q, k, v, g_attn, u, v_gm, g_gm = jnp.split(proj, splits, axis=-1)
        attn = _windowed_gqa(q.reshape(b, s, N_HEADS, HEAD_DIM),
                             k.reshape(b, s, N_KV_HEADS, HEAD_DIM),
                             v.reshape(b, s, N_KV_HEADS, HEAD_DIM),
                             q_gain[l], k_gain[l], sink[l])
        gm = _chunked_gmlp(u, v_gm, w_s[l], b_s[l])
        y = jnp.concatenate([attn * jax.nn.silu(g_attn), gm * jax.nn.silu(g_gm)], axis=-1)
        x = x + gate[:, None, :] * (y @ w_out[l])
    return x
```

```cpp
#include <hip/hip_runtime.h>
#include <cstdio>
#include <cstdint>

constexpr int NB = 2, SEQ = 8192, DM = 1024, M = NB * SEQ, DIN = 2816, NL = 2;
constexpr int OFF_Q = 0, OFF_K = 512, OFF_V = 640, OFF_GA = 768, OFF_U = 1280, OFF_VG = 1792, OFF_GG = 2304;
constexpr float EPS = 1e-6f;

__device__ __forceinline__ float wave_sum(float v) {
#pragma unroll
    for (int o = 1; o < 64; o <<= 1) v += __shfl_xor(v, o);
    return v;
}
__device__ __forceinline__ float wave_max(float v) {
#pragma unroll
    for (int o = 1; o < 64; o <<= 1) v = fmaxf(v, __shfl_xor(v, o));
    return v;
}
__device__ __forceinline__ float silu(float v) { return v / (1.f + expf(-v)); }

__global__ void __launch_bounds__(256) k_ada(const float* c, const float* w_ada, const float* b_ada, float* ada) {
    __shared__ float sc[2][DM];
    const int l = blockIdx.y, col = blockIdx.x * 256 + threadIdx.x;
    for (int i = threadIdx.x; i < 2 * DM; i += 256) sc[i / DM][i % DM] = silu(c[i]);
    __syncthreads();
    const float* w = w_ada + (size_t)l * DM * 3 * DM + col;
    float a0 = 0.f, a1 = 0.f;
    for (int k = 0; k < DM; ++k) { const float wv = w[(size_t)k * 3 * DM]; a0 += sc[0][k] * wv; a1 += sc[1][k] * wv; }
    const float bb = b_ada[l * 3 * DM + col];
    ada[(l * 2 + 0) * 3 * DM + col] = a0 + bb;
    ada[(l * 2 + 1) * 3 * DM + col] = a1 + bb;
}

__global__ void __launch_bounds__(256) k_norm(const float* x, const float* gain, const float* ada_l  , float* h) {
    __shared__ float red[4];
    const int r = blockIdx.x, b = r / SEQ, t = threadIdx.x;
    const float4 v = *(const float4*)(x + (size_t)r * DM + t * 4);
    float ss = v.x * v.x + v.y * v.y + v.z * v.z + v.w * v.w;
    ss = wave_sum(ss);
    if ((t & 63) == 0) red[t >> 6] = ss;
    __syncthreads();
    const float tot = red[0] + red[1] + red[2] + red[3];
    const float rstd = rsqrtf(tot * (1.f / DM) + EPS);
    const float* shift = ada_l + b * 3 * DM; const float* scale = shift + DM;
    float o[4]; const float xv[4] = {v.x, v.y, v.z, v.w};
#pragma unroll
    for (int j = 0; j < 4; ++j) { const int k = t * 4 + j; o[j] = xv[j] * rstd * gain[k] * (1.f + scale[k]) + shift[k]; }
    *(float4*)(h + (size_t)r * DM + t * 4) = make_float4(o[0], o[1], o[2], o[3]);
}

template <int EPI>
__global__ void __launch_bounds__(256) k_gemm(const float* A, const float* B, float* C, int Mm, int N, int K, const float* xin, const float* ada_l) {
    __shared__ float As[16][68];
    __shared__ float Bs[16][64];
    const int tid = threadIdx.x, tx = tid & 15, ty = tid >> 4;
    const int m0 = blockIdx.y * 64, n0 = blockIdx.x * 64;
    float acc[4][4];
#pragma unroll
    for (int i = 0; i < 4; ++i)
#pragma unroll
        for (int j = 0; j < 4; ++j) acc[i][j] = 0.f;
    for (int k0 = 0; k0 < K; k0 += 16) {
        const float4 a = *(const float4*)(A + (size_t)(m0 + (tid >> 2)) * K + k0 + (tid & 3) * 4);
        As[(tid & 3) * 4 + 0][tid >> 2] = a.x; As[(tid & 3) * 4 + 1][tid >> 2] = a.y; As[(tid & 3) * 4 + 2][tid >> 2] = a.z; As[(tid & 3) * 4 + 3][tid >> 2] = a.w;
        const float4 bq = *(const float4*)(B + (size_t)(k0 + (tid >> 4)) * N + n0 + (tid & 15) * 4);
        *(float4*)&Bs[tid >> 4][(tid & 15) * 4] = bq;
        __syncthreads();
#pragma unroll
        for (int kk = 0; kk < 16; ++kk) {
            const float4 av = *(const float4*)&As[kk][ty * 4];
            const float4 bv = *(const float4*)&Bs[kk][tx * 4];
            const float aa[4] = {av.x, av.y, av.z, av.w}, bb[4] = {bv.x, bv.y, bv.z, bv.w};
#pragma unroll
            for (int i = 0; i < 4; ++i)
#pragma unroll
                for (int j = 0; j < 4; ++j) acc[i][j] += aa[i] * bb[j];
        }
        __syncthreads();
    }
#pragma unroll
    for (int i = 0; i < 4; ++i) {
        const int r = m0 + ty * 4 + i; const int c0 = n0 + tx * 4;
        float o[4];
        if (EPI == 1) {
            const int b = r / SEQ; const float* gate = ada_l + b * 3 * DM + 2 * DM;
            const float4 xv = *(const float4*)(xin + (size_t)r * N + c0);
            o[0] = xv.x + gate[c0 + 0] * acc[i][0]; o[1] = xv.y + gate[c0 + 1] * acc[i][1]; o[2] = xv.z + gate[c0 + 2] * acc[i][2]; o[3] = xv.w + gate[c0 + 3] * acc[i][3];
        } else { o[0] = acc[i][0]; o[1] = acc[i][1]; o[2] = acc[i][2]; o[3] = acc[i][3]; }
        *(float4*)(C + (size_t)r * N + c0) = make_float4(o[0], o[1], o[2], o[3]);
    }
}

__global__ void __launch_bounds__(256) k_qknorm(float* proj, const float* qg, const float* kg) {
    const int w = blockIdx.x * 4 + (threadIdx.x >> 6), lane = threadIdx.x & 63;
    const int r = w / 10, g = w % 10;
    float* p = proj + (size_t)r * DIN + (g < 8 ? OFF_Q + g * 64 : OFF_K + (g - 8) * 64) + lane;
    const float v = *p;
    const float ss = wave_sum(v * v);
    *p = v * rsqrtf(ss * (1.f / 64.f) + EPS) * (g < 8 ? qg[lane] : kg[lane]);
}

__global__ void __launch_bounds__(64) k_attn(const float* proj, const float* sink_l, float* y) {
    __shared__ float p[320];
    const int r = blockIdx.x >> 3, h = blockIdx.x & 7, lane = threadIdx.x;
    const int b = r / SEQ, s = r % SEQ, kvh = h >> 2;
    const float q = proj[(size_t)r * DIN + OFF_Q + h * 64 + lane];
    const float slope = exp2f(-(float)(h + 1));
    for (int j = 0; j < 257; ++j) {
        const int kpos = s - 128 + j; float sc = -1e30f;
        if (kpos >= 0 && kpos < SEQ) {
            const float kv = proj[(size_t)(b * SEQ + kpos) * DIN + OFF_K + kvh * 64 + lane];
            const float d = wave_sum(q * kv);
            sc = d * 0.125f - slope * fabsf((float)(j - 128));
        }
        if (lane == 0) p[j] = sc;
    }
    __syncthreads();
    const float snk = sink_l[h];
    float m = snk;
    for (int j = lane; j < 257; j += 64) m = fmaxf(m, p[j]);
    m = wave_max(m);
    float sum = 0.f;
    for (int j = lane; j < 257; j += 64) { const float e = expf(p[j] - m); p[j] = e; sum += e; }
    sum = wave_sum(sum) + expf(snk - m);
    __syncthreads();
    float o = 0.f;
    for (int j = 0; j < 257; ++j) {
        const int kpos = s - 128 + j;
        if (kpos >= 0 && kpos < SEQ) o += p[j] * proj[(size_t)(b * SEQ + kpos) * DIN + OFF_V + kvh * 64 + lane];
    }
    o /= sum;
    const float g = proj[(size_t)r * DIN + OFF_GA + h * 64 + lane];
    y[(size_t)r * DM + h * 64 + lane] = o * silu(g);
}

__global__ void __launch_bounds__(256) k_gmlp(const float* proj, const float* ws_l, const float* bs_l, float* y) {
    __shared__ float vn[128][64];
    const int g = blockIdx.x, ch = blockIdx.y, tid = threadIdx.x, lane = tid & 63, wv = tid >> 6;
    const size_t row0 = (size_t)ch * 128;
    for (int s = wv; s < 128; s += 4) {
        const float v = proj[(row0 + s) * DIN + OFF_VG + g * 64 + lane];
        const float ss = wave_sum(v * v);
        vn[s][lane] = v * rsqrtf(ss * (1.f / 64.f) + EPS);
    }
    __syncthreads();
    for (int t = wv; t < 128; t += 4) {
        const float* wr = ws_l + ((size_t)g * 128 + t) * 128;
        float acc = 0.f;
        for (int s = 0; s < 128; ++s) acc += wr[s] * vn[s][lane];
        acc += bs_l[g * 128 + t];
        const float u = proj[(row0 + t) * DIN + OFF_U + g * 64 + lane];
        const float gg = proj[(row0 + t) * DIN + OFF_GG + g * 64 + lane];
        y[(row0 + t) * DM + 512 + g * 64 + lane] = u * acc * silu(gg);
    }
}

extern "C" void kernel_launch(void* const* d_in, const int* in_sizes, int n_in, void* d_out, int out_size, void* d_ws, size_t ws_size, hipStream_t stream) {
    const float* x = (const float*)d_in[0]; const float* c = (const float*)d_in[1]; const float* w_ada = (const float*)d_in[2]; const float* b_ada = (const float*)d_in[3];
    const float* norm_gain = (const float*)d_in[4]; const float* w_in = (const float*)d_in[5]; const float* q_gain = (const float*)d_in[6]; const float* k_gain = (const float*)d_in[7];
    const float* sink = (const float*)d_in[8]; const float* w_s = (const float*)d_in[9]; const float* b_s = (const float*)d_in[10]; const float* w_out = (const float*)d_in[11];
    float* out = (float*)d_out;
    char* ws = (char*)d_ws;
    constexpr size_t MiB = 1u << 20;
    float* ada = (float*)ws;
    float* hy = (float*)(ws + 1 * MiB);
    float* proj = (float*)(ws + 66 * MiB);
    if (ws_size < 243 * MiB) { fprintf(stderr, "ws too small: %zu\n", ws_size); return; }
    k_ada<<<dim3(3 * DM / 256, NL), 256, 0, stream>>>(c, w_ada, b_ada, ada);
    for (int l = 0; l < NL; ++l) {
        const float* xin = (l == 0) ? x : out;
        const float* ada_l = ada + (size_t)l * 2 * 3 * DM;
        k_norm<<<M, 256, 0, stream>>>(xin, norm_gain + l * DM, ada_l, hy);
        k_gemm<0><<<dim3(DIN / 64, M / 64), 256, 0, stream>>>(hy, w_in + (size_t)l * DM * DIN, proj, M, DIN, DM, nullptr, nullptr);
        k_qknorm<<<M * 10 / 4, 256, 0, stream>>>(proj, q_gain + l * 64, k_gain + l * 64);
        k_attn<<<M * 8, 64, 0, stream>>>(proj, sink + l * 8, hy);
        k_gmlp<<<dim3(8, M / 128), 256, 0, stream>>>(proj, w_s + (size_t)l * 8 * 128 * 128, b_s + l * 8 * 128, hy);
        k_gemm<1><<<dim3(DM / 64, M / 64), 256, 0, stream>>>(hy, w_out + (size_t)l * DM * DM, out, M, DM, DM, xin, ada_l);
    }
}
```

```cpp
#include <hip/hip_runtime.h>
#include <cstdio>
#include <cstdint>

#ifndef PH_MASK
#define PH_MASK 0xff
#endif
#ifndef MK_PER_PHASE
#define MK_PER_PHASE 0
#endif

constexpr int NB = 2, SEQ = 8192, DM = 1024, M = NB * SEQ, DIN = 2816, NL = 2;
constexpr int OFF_Q = 0, OFF_K = 512, OFF_V = 640, OFF_GA = 768, OFF_U = 1280, OFF_VG = 1792, OFF_GG = 2304;
constexpr float EPS = 1e-6f;
constexpr float LOG2E = 1.4426950408889634f;
constexpr float C2 = 0.125f * LOG2E;

#define LAS __attribute__((address_space(3)))
#define GAS __attribute__((address_space(1)))
typedef unsigned short bf16_t;
typedef short bf16x8 __attribute__((ext_vector_type(8)));
typedef short s16x4 __attribute__((ext_vector_type(4)));
typedef float f32x4 __attribute__((ext_vector_type(4)));
typedef float f32x16 __attribute__((ext_vector_type(16)));
typedef unsigned u32x4 __attribute__((ext_vector_type(4)));
typedef unsigned u32x2 __attribute__((ext_vector_type(2)));
typedef GAS unsigned gu32;

__device__ __forceinline__ unsigned f2bf(float f) { unsigned u = __builtin_bit_cast(unsigned, f); return (u + 0x7fffu + ((u >> 16) & 1u)) >> 16; }
__device__ __forceinline__ unsigned pk2(float lo, float hi) { return f2bf(lo) | (f2bf(hi) << 16); }
__device__ __forceinline__ float bf2f(unsigned short h) { return __builtin_bit_cast(float, (unsigned)h << 16); }
__device__ __forceinline__ float bflo(unsigned w) { return __builtin_bit_cast(float, w << 16); }
__device__ __forceinline__ float bfhi(unsigned w) { return __builtin_bit_cast(float, w & 0xffff0000u); }
typedef float f32x2_t __attribute__((ext_vector_type(2))); typedef __bf16 bf16x2_t __attribute__((ext_vector_type(2)));
__device__ __forceinline__ unsigned cvtpk(float lo, float hi) { f32x2_t v = {lo, hi}; bf16x2_t b = __builtin_convertvector(v, bf16x2_t); return __builtin_bit_cast(unsigned, b); }
__device__ __forceinline__ float fsilu(float v) { return v * __builtin_amdgcn_rcpf(1.f + __builtin_amdgcn_exp2f(-LOG2E * v)); }
__device__ __forceinline__ float wave_sum(float v) {
#pragma unroll
    for (int o = 1; o < 64; o <<= 1) v += __shfl_xor(v, o);
    return v;
}

namespace pg8 {
constexpr int BM = 256, BK = 64, HALF = 128, HTB = HALF * BK * 2, STAGE_BYTES = 8 * HTB, NXCD = 8, WGM = 8;
__host__ __device__ __forceinline__ int lds_byte(int r, int c) { const int st = (r >> 4) * 2 + (c >> 5), rr = r & 15, cc = c & 31, ob = rr * 64 + cc * 2; return st * 1024 + (ob ^ (((ob >> 9) & 1) << 5)); }
__host__ __device__ __forceinline__ void stage_rc(int b, int& R, int& C) { const int st = b / 1024, sb = b % 1024, swz = sb ^ (((sb >> 9) & 1) << 5); R = (st >> 1) * 16 + swz / 64; C = (st & 1) * 32 + (swz % 64) / 2; }
__host__ __device__ __forceinline__ int perm32(int rho) { const int n = rho >> 4, i = rho & 15; return 8 * (i >> 2) + 4 * n + (i & 3); }

struct Unit { int pm, pn; };
struct Gemm { const bf16_t* A; const bf16_t* Bt; int M, N, K; };

struct StaticOrder {
    int nM, nN, nwg, G, c;
    __host__ __device__ void init(int M_, int N_, int G_, int c_) { nM = M_ / BM; nN = N_ / BM; nwg = nM * nN; G = G_; c = c_; }
    __host__ __device__ bool next(int i, Unit& u) const {
        const long L = (long)i * G + c; if (L >= nwg) return false;
        int wgid = (int)L; { const int q = nwg / NXCD, r = nwg % NXCD, xcd = wgid % NXCD, off = wgid / NXCD; wgid = (xcd < r ? xcd * (q + 1) : r * (q + 1) + (xcd - r) * q) + off; }
        const int nig = WGM * nN, gid = wgid / nig, fm = gid * WGM, gsz = (nM - fm) < WGM ? (nM - fm) : WGM;
        u.pm = fm + ((wgid % nig) % gsz); u.pn = (wgid % nig) / gsz; return true;
    }
};

template <class Epi, bool ALIGN_EPI>
__device__ __forceinline__ void gemm_phase(LAS unsigned char* lds, const Gemm g, const StaticOrder& S, const Epi& E) {
    int tid = threadIdx.x; asm volatile("" : "+v"(tid));
    const int wid = __builtin_amdgcn_readfirstlane(tid >> 6), lane = tid & 63, wr = wid >> 2, wc = wid & 3, fr = lane & 15, fq = lane >> 4;
    const int K = g.K, nt = K / BK;
    unsigned voffA[2], voffB0[2], voffB1[2];
#pragma unroll
    for (int i = 0; i < 2; ++i) { int R, C; stage_rc(tid * 16 + i * 8192, R, C); const int cb = 64 * (R >> 5) + perm32(R & 31);
        voffA[i] = (unsigned)(R * K + C) * 2u; voffB0[i] = (unsigned)(cb * K + C) * 2u; voffB1[i] = (unsigned)((cb + 32) * K + C) * 2u; }
    const size_t kstep = (size_t)(BK * 2);
    const size_t hstep = (size_t)HALF * K * 2;
    const size_t tstep = 2 * hstep;
    const unsigned ldsw = (unsigned)wid * 1024u;
    const int aoff = lds_byte(wr * 64 + fr, fq * 8), boff = lds_byte(wc * 32 + fr, fq * 8);
#define PG8_SA(b, h) (((b) * 2 + (h)) * HTB)
#define PG8_SB(b, h) ((4 + (b) * 2 + (h)) * HTB)
#define PG8_STAGE(bufoff, gbase, voff) do { _Pragma("unroll") for (int _i = 0; _i < 2; ++_i) \
        __builtin_amdgcn_global_load_lds((const unsigned*)((const char*)(gbase) + (voff)[_i]), (LAS unsigned*)(lds + (bufoff) + ldsw + _i * 8192), 16, 0, 0); } while (0)
#define PG8_LDA(dst, b, h) do { _Pragma("unroll") for (int m = 0; m < 4; ++m) _Pragma("unroll") for (int k = 0; k < 2; ++k) dst[m][k] = *(const LAS bf16x8*)(lds + PG8_SA(b, h) + aoff + m * 2048 + k * 1024); } while (0)
#define PG8_LDB(dst, b, h) do { _Pragma("unroll") for (int n = 0; n < 2; ++n) _Pragma("unroll") for (int k = 0; k < 2; ++k) dst[n][k] = *(const LAS bf16x8*)(lds + PG8_SB(b, h) + boff + n * 2048 + k * 1024); } while (0)
#define PG8_MMA(ai, bj, At, Bt) do { __builtin_amdgcn_s_setprio(1); _Pragma("unroll") for (int m = 0; m < 4; ++m) _Pragma("unroll") for (int n = 0; n < 2; ++n) _Pragma("unroll") for (int k = 0; k < 2; ++k) \
        acc[ai][bj][m][n] = __builtin_amdgcn_mfma_f32_16x16x32_bf16(Bt[n][k], At[m][k], acc[ai][bj][m][n], 0, 0, 0); __builtin_amdgcn_s_setprio(0); } while (0)
#define PG8_WAIT_V(n) asm volatile("s_waitcnt vmcnt(" #n ")" ::: "memory")
#define PG8_WAIT_L(n) asm volatile("s_waitcnt lgkmcnt(" #n ")" ::: "memory")
#define PG8_BAR __builtin_amdgcn_s_barrier()
#define PG8_SCHED __builtin_amdgcn_sched_barrier(0)
    Unit cur, nxt; int ui = 0;
    if (!S.next(0, cur)) return;
    f32x4 acc[2][2][4][2];
#pragma unroll
    for (int a = 0; a < 2; ++a)
#pragma unroll
        for (int b = 0; b < 2; ++b)
#pragma unroll
            for (int m = 0; m < 4; ++m)
#pragma unroll
                for (int n = 0; n < 2; ++n) acc[a][b][m][n] = (f32x4){0.f, 0.f, 0.f, 0.f};
    bf16x8 At[4][2], B0[2][2], B1[2][2];
    const char* cA = (const char*)g.A + (size_t)cur.pm * tstep; const char* cB = (const char*)g.Bt + (size_t)cur.pn * tstep;
    PG8_STAGE(PG8_SB(0, 0), cB, voffB0); PG8_STAGE(PG8_SB(0, 1), cB, voffB1); PG8_STAGE(PG8_SA(0, 0), cA, voffA); PG8_STAGE(PG8_SA(0, 1), cA + hstep, voffA);
    if (wr == 1) PG8_BAR;
    PG8_WAIT_V(2); PG8_BAR;
    PG8_STAGE(PG8_SB(1, 0), cB + kstep, voffB0); PG8_STAGE(PG8_SA(1, 0), cA + kstep, voffA); PG8_STAGE(PG8_SB(1, 1), cB + kstep, voffB1);
    PG8_WAIT_V(6); PG8_BAR;
    for (;;) {
        const bool has_next = S.next(ui + 1, nxt);
        const char* nA = has_next ? (const char*)g.A + (size_t)nxt.pm * tstep : cA; const char* nB = has_next ? (const char*)g.Bt + (size_t)nxt.pn * tstep : cB;
        for (int t = 0; t < nt; t += 2) {
            const bool last = (t == nt - 2);
            const char* a1 = cA + (size_t)(t + 1) * kstep;
            const char* a2 = last ? nA : cA + (size_t)(t + 2) * kstep; const char* b2 = last ? nB : cB + (size_t)(t + 2) * kstep;
            const char* a3 = a2 + kstep; const char* b3 = b2 + kstep;
            PG8_LDB(B0, 0, 0); PG8_LDB(B1, 0, 1); PG8_SCHED; PG8_LDA(At, 0, 0); PG8_STAGE(PG8_SA(1, 1), a1 + hstep, voffA);
            PG8_WAIT_V(8); PG8_WAIT_L(0); PG8_BAR; PG8_MMA(0, 0, At, B0); PG8_MMA(0, 1, At, B1); PG8_BAR; PG8_SCHED;
            PG8_LDA(At, 0, 1); PG8_STAGE(PG8_SB(0, 0), b2, voffB0); PG8_STAGE(PG8_SB(0, 1), b2, voffB1); PG8_STAGE(PG8_SA(0, 0), a2, voffA);
            PG8_WAIT_V(8); PG8_WAIT_L(0); PG8_BAR; PG8_MMA(1, 0, At, B0); PG8_MMA(1, 1, At, B1); PG8_BAR; PG8_SCHED;
            PG8_LDB(B0, 1, 0); PG8_LDB(B1, 1, 1); PG8_SCHED; PG8_LDA(At, 1, 0); PG8_STAGE(PG8_SA(0, 1), a2 + hstep, voffA);
            PG8_WAIT_V(8); PG8_WAIT_L(0); PG8_BAR; PG8_MMA(0, 0, At, B0); PG8_MMA(0, 1, At, B1); PG8_BAR; PG8_SCHED;
            PG8_LDA(At, 1, 1); PG8_STAGE(PG8_SB(1, 0), b3, voffB0); PG8_STAGE(PG8_SB(1, 1), b3, voffB1); PG8_STAGE(PG8_SA(1, 0), a3, voffA);
            PG8_WAIT_V(8); PG8_WAIT_L(0); PG8_BAR; PG8_MMA(1, 0, At, B0); PG8_MMA(1, 1, At, B1); PG8_BAR; PG8_SCHED;
        }
        if constexpr (ALIGN_EPI) { if (wr == 0) PG8_BAR; }
        if constexpr (!Epi::AFTER_DRAIN) { E(acc, cur, wr, wc, fr, fq); }
        if (!has_next) break;
#pragma unroll
        for (int a = 0; a < 2; ++a)
#pragma unroll
            for (int b = 0; b < 2; ++b)
#pragma unroll
                for (int m = 0; m < 4; ++m)
#pragma unroll
                    for (int n = 0; n < 2; ++n) acc[a][b][m][n] = (f32x4){0.f, 0.f, 0.f, 0.f};
        cur = nxt; cA = nA; cB = nB; ++ui;
        if constexpr (ALIGN_EPI) { if (wr == 1) PG8_BAR; }
    }
    PG8_WAIT_V(0);
    if constexpr (!ALIGN_EPI) { if (wr == 0) PG8_BAR; }
    PG8_BAR;
    if constexpr (Epi::AFTER_DRAIN) { E.fused(acc, cur, wr, wc, fr, fq, lds, wid, lane); }
#undef PG8_SA
#undef PG8_SB
#undef PG8_STAGE
#undef PG8_LDA
#undef PG8_LDB
#undef PG8_MMA
#undef PG8_WAIT_V
#undef PG8_WAIT_L
#undef PG8_BAR
#undef PG8_SCHED
}

struct EpiProj {
    static constexpr bool AFTER_DRAIN = false;
    bf16_t* PB; const float* ssq4; const float* bias; const float* qg; const float* kg;
    __device__ __forceinline__ void operator()(const f32x4 (&acc)[2][2][4][2], const Unit& u, int wr, int wc, int fr, int fq) const {
        const int b = u.pm >> 5;
        const int colw = u.pn * 256 + wc * 64 + 8 * fq;
        int type;
        if (u.pn < 2) type = 0; else if (u.pn == 2) type = (wc < 2) ? 1 : 2; else if (u.pn < 5) type = 3; else if (u.pn < 7) type = 2; else if (u.pn < 9) type = 4; else type = 3;
        const float* bp = bias + b * DIN + colw;
        const float* gp = (type == 0 ? qg : kg) + 8 * fq;
        const float gsc = (type == 0) ? C2 : 1.f;
#pragma unroll
        for (int ai = 0; ai < 2; ++ai)
#pragma unroll
            for (int m = 0; m < 4; ++m) {
                const int row = u.pm * 256 + ai * 128 + wr * 64 + m * 16 + fr;
                const f32x4 s4 = *(const f32x4*)(ssq4 + (size_t)row * 4);
                const float rstd = __builtin_amdgcn_rsqf(((s4[0] + s4[1]) + (s4[2] + s4[3])) * (1.f / DM) + EPS);
                f32x4 v[2][2];
#pragma unroll
                for (int bj = 0; bj < 2; ++bj)
#pragma unroll
                    for (int n = 0; n < 2; ++n) v[bj][n] = acc[ai][bj][m][n] * rstd + *(const f32x4*)(bp + 32 * bj + 4 * n);
                if (type == 0 || type == 1 || type == 4) {
                    float ss = 0.f;
#pragma unroll
                    for (int bj = 0; bj < 2; ++bj)
#pragma unroll
                        for (int n = 0; n < 2; ++n) ss += (v[bj][n][0] * v[bj][n][0] + v[bj][n][1] * v[bj][n][1]) + (v[bj][n][2] * v[bj][n][2] + v[bj][n][3] * v[bj][n][3]);
                    ss += __shfl_xor(ss, 16); ss += __shfl_xor(ss, 32);
                    const float rs = __builtin_amdgcn_rsqf(ss * (1.f / 64.f) + EPS) * gsc;
                    if (type != 4) {
#pragma unroll
                        for (int bj = 0; bj < 2; ++bj)
#pragma unroll
                            for (int n = 0; n < 2; ++n) v[bj][n] = v[bj][n] * rs * *(const f32x4*)(gp + 32 * bj + 4 * n);
                    } else {
#pragma unroll
                        for (int bj = 0; bj < 2; ++bj)
#pragma unroll
                            for (int n = 0; n < 2; ++n) v[bj][n] = v[bj][n] * rs;
                    }
                } else if (type == 3) {
#pragma unroll
                    for (int bj = 0; bj < 2; ++bj)
#pragma unroll
                        for (int n = 0; n < 2; ++n)
#pragma unroll
                            for (int e = 0; e < 4; ++e) v[bj][n][e] = fsilu(v[bj][n][e]);
                }
                bf16_t* rowp = PB + (size_t)row * DIN + colw;
#pragma unroll
                for (int bj = 0; bj < 2; ++bj) {
                    u32x4 w; w.x = cvtpk(v[bj][0][0], v[bj][0][1]); w.y = cvtpk(v[bj][0][2], v[bj][0][3]); w.z = cvtpk(v[bj][1][0], v[bj][1][1]); w.w = cvtpk(v[bj][1][2], v[bj][1][3]);
                    *(u32x4*)(rowp + 32 * bj) = w;
                }
                asm volatile("" ::: "memory");
            }
    }
};

struct EpiOut {
    static constexpr bool AFTER_DRAIN = true;
    const float* xin; float* xout; const float* gate; bf16_t* xs; const float* gsn; float* ssq4;
    __device__ __forceinline__ void fused(f32x4 (&acc)[2][2][4][2], const Unit& u, int wr, int wc, int fr, int fq, LAS unsigned char* lds, int wid, int lane) const {
        const int b = u.pm >> 5;
        const int colw = u.pn * 256 + wc * 64 + 8 * fq;
        const bool nx = (xs != nullptr);
        const float* gtp = gate + b * 3 * DM + 2 * DM + colw;
        const float* gnp = gsn + b * DM + colw;
        LAS float* P = (LAS float*)lds;
#pragma unroll
        for (int ai = 0; ai < 2; ++ai)
#pragma unroll
            for (int m = 0; m < 4; ++m) {
                const int rl = ai * 128 + wr * 64 + m * 16 + fr;
                const size_t off = (size_t)(u.pm * 256 + rl) * DM + colw;
                float ss = 0.f;
#pragma unroll
                for (int bj = 0; bj < 2; ++bj) {
                    f32x4 o[2];
#pragma unroll
                    for (int n = 0; n < 2; ++n) {
                        const f32x4 xv = *(const f32x4*)(xin + off + 32 * bj + 4 * n);
                        o[n] = xv + *(const f32x4*)(gtp + 32 * bj + 4 * n) * acc[ai][bj][m][n];
                        *(f32x4*)(xout + off + 32 * bj + 4 * n) = o[n];
                        ss += (o[n][0] * o[n][0] + o[n][1] * o[n][1]) + (o[n][2] * o[n][2] + o[n][3] * o[n][3]);
                    }
                    if (nx) {
                        const f32x4 a = o[0] * *(const f32x4*)(gnp + 32 * bj), c = o[1] * *(const f32x4*)(gnp + 32 * bj + 4);
                        u32x4 w; w.x = cvtpk(a[0], a[1]); w.y = cvtpk(a[2], a[3]); w.z = cvtpk(c[0], c[1]); w.w = cvtpk(c[2], c[3]);
                        *(u32x4*)(xs + off + 32 * bj) = w;
                    }
                }
                if (nx) { ss += __shfl_xor(ss, 16); ss += __shfl_xor(ss, 32); if (fq == 0) P[rl * 4 + wc] = ss; }
                asm volatile("" ::: "memory");
            }
        if (nx) {
            __syncthreads();
            if (threadIdx.x < 256) { const int rl = threadIdx.x; const float s = (P[rl * 4 + 0] + P[rl * 4 + 1]) + (P[rl * 4 + 2] + P[rl * 4 + 3]); ssq4[(size_t)(u.pm * 256 + rl) * 4 + u.pn] = s; }
            __syncthreads();
        }
    }
};
}

namespace mix {
typedef LAS const char* lds_cptr;
constexpr int SLOTB = 8192, NSLOT = 6;
constexpr int L_K = 0, L_V = NSLOT * SLOTB, L_WS = 2 * NSLOT * SLOTB, L_OST = L_WS + 8 * 256, L_END = L_OST + 8 * 4096;
__device__ __forceinline__ int crow(int r, int hi) { return (r & 3) + 8 * (r >> 2) + 4 * hi; }
__device__ __forceinline__ void glds16(const void* gsrc, unsigned lds_dst) { unsigned keep;
    asm volatile("s_mov_b32 %0, m0\n\ts_mov_b32 m0, %2\n\ts_nop 0\n\tglobal_load_lds_dwordx4 %1, off\n\ts_mov_b32 m0, %0" : "=&s"(keep) : "v"(gsrc), "s"(lds_dst) : "memory"); }
__device__ __forceinline__ s16x4 vtr(lds_cptr p) { typedef short v4i16_t __attribute__((ext_vector_type(4))); return __builtin_bit_cast(s16x4, __builtin_amdgcn_ds_read_tr16_b64_v4i16((LAS v4i16_t*)p)); }

__device__ __forceinline__ void qkt(f32x16& p0, f32x16& p1, lds_cptr kslot, const bf16x8* qr, const f32x16& cinit, int r32, int hi) {
    lds_cptr kb = kslot + hi * 1024 + r32 * 16;
#pragma unroll
    for (int d0 = 0; d0 < 4; ++d0) {
        const bf16x8 b0 = *(const LAS bf16x8*)(kb + d0 * 2048);
        const bf16x8 b1 = *(const LAS bf16x8*)(kb + d0 * 2048 + 512);
        if (d0 == 0) { p0 = __builtin_amdgcn_mfma_f32_32x32x16_bf16(b0, qr[0], cinit, 0, 0, 0); p1 = __builtin_amdgcn_mfma_f32_32x32x16_bf16(b1, qr[0], cinit, 0, 0, 0); }
        else { p0 = __builtin_amdgcn_mfma_f32_32x32x16_bf16(b0, qr[d0], p0, 0, 0, 0); p1 = __builtin_amdgcn_mfma_f32_32x32x16_bf16(b1, qr[d0], p1, 0, 0, 0); }
    }
}
__device__ __forceinline__ void pv(f32x16* o, lds_cptr vp, bf16x8 pa0, bf16x8 pa1, bf16x8 pa2, bf16x8 pa3) {
#pragma unroll
    for (int d0 = 0; d0 < 2; ++d0) {
        s16x4 lo[4], hi[4];
#pragma unroll
        for (int ks = 0; ks < 4; ++ks) { lo[ks] = vtr(vp + d0 * 4096 + ks * 1024); hi[ks] = vtr(vp + d0 * 4096 + ks * 1024 + 512); }
#define MIX_PK(k) (bf16x8){lo[k][0], lo[k][1], lo[k][2], lo[k][3], hi[k][0], hi[k][1], hi[k][2], hi[k][3]}
        o[d0] = __builtin_amdgcn_mfma_f32_32x32x16_bf16(pa0, MIX_PK(0), o[d0], 0, 0, 0);
        o[d0] = __builtin_amdgcn_mfma_f32_32x32x16_bf16(pa1, MIX_PK(1), o[d0], 0, 0, 0);
        o[d0] = __builtin_amdgcn_mfma_f32_32x32x16_bf16(pa2, MIX_PK(2), o[d0], 0, 0, 0);
        o[d0] = __builtin_amdgcn_mfma_f32_32x32x16_bf16(pa3, MIX_PK(3), o[d0], 0, 0, 0);
#undef MIX_PK
    }
}

__device__ __forceinline__ void attn_unit(int b, int kvh, int qb, const bf16_t* PB, bf16_t* Y, const float* sink_l, float sb2, LAS unsigned char* shm) {
    int tid = threadIdx.x; asm volatile("" : "+v"(tid));
    const int lane = tid & 63, r32 = lane & 31, hi = lane >> 5; const int wid = __builtin_amdgcn_readfirstlane(tid >> 6);
    const int g = wid >> 1, jj = wid & 1, h = kvh * 4 + g;
    const long rowbase = (long)b * SEQ; const int q0 = qb * 128, kb0 = q0 - 128;
    const int t_lo = (qb == 0) ? 2 : 0, t_hi = (qb == SEQ / 128 - 1) ? 3 : 5;
    const unsigned lds0 = (unsigned)(uintptr_t)shm;
    const bf16_t* Kh = PB + rowbase * DIN + OFF_K + kvh * 64; const bf16_t* Vh = PB + rowbase * DIN + OFF_V + kvh * 64;
    for (int t = t_lo; t <= t_hi; ++t) {
        const long kr = kb0 + 64 * t;
        glds16(Kh + (kr + lane) * DIN + wid * 8, (unsigned)__builtin_amdgcn_readfirstlane(lds0 + L_K + t * SLOTB + wid * 1024));
        glds16(Vh + (kr + 16 * (wid & 3) + (lane >> 2)) * DIN + (wid >> 2) * 32 + (lane & 3) * 8, (unsigned)__builtin_amdgcn_readfirstlane(lds0 + L_V + t * SLOTB + wid * 1024));
    }
    const float slope2 = __builtin_amdgcn_exp2f(-(float)(h + 1)) * LOG2E;
    const float snk = __builtin_amdgcn_exp2f(sink_l[h] * LOG2E - sb2);
    LAS float* wsf = (LAS float*)(shm + L_WS) + wid * 64;
    const lds_cptr shm3 = (lds_cptr)shm;
    const lds_cptr vp0 = shm3 + L_V + ((lane >> 4) & 1) * 32 + (lane & 3) * 8 + (4 * hi + ((lane & 15) >> 2)) * 64;
    f32x16 cinit;
#pragma unroll
    for (int r = 0; r < 16; ++r) cinit[r] = -sb2;
    asm volatile("s_waitcnt vmcnt(0)" ::: "memory");
    __syncthreads();
    for (int i = 0; i < 2; ++i) {
        const int R0 = q0 + 64 * jj + 32 * i;
        const bf16_t* Qw = PB + (rowbase + R0 + r32) * DIN + OFF_Q + h * 64 + hi * 8;
        bf16x8 qr[4];
#pragma unroll
        for (int d0 = 0; d0 < 4; ++d0) qr[d0] = *(const bf16x8*)(Qw + d0 * 16);
        f32x16 o[2]; o[0] = f32x16{}; o[1] = f32x16{};
        float lsum = 0.f;
        const int ta = jj > t_lo ? jj : t_lo, tb = (jj + 4) < t_hi ? (jj + 4) : t_hi;
        for (int t = ta; t <= tb; ++t) {
            f32x16 p0, p1;
            qkt(p0, p1, shm3 + L_K + t * SLOTB, qr, cinit, r32, hi);
            const float Lf = (float)(kb0 + 64 * t + 4 * hi - (R0 + r32));
            const bool edge = (t == jj) || (t == jj + 4);
#pragma unroll
            for (int r = 0; r < 16; ++r) {
                const float c = (float)((r & 3) + 8 * (r >> 2));
                const float x0 = __builtin_fabsf(Lf + c), x1 = __builtin_fabsf(Lf + (c + 32.f));
                float a0 = p0[r] - slope2 * x0, a1 = p1[r] - slope2 * x1;
                if (edge) { a0 = (x0 > 128.f) ? -INFINITY : a0; a1 = (x1 > 128.f) ? -INFINITY : a1; }
                p0[r] = __builtin_amdgcn_exp2f(a0); p1[r] = __builtin_amdgcn_exp2f(a1);
            }
            float sacc = 0.f;
#pragma unroll
            for (int r = 0; r < 16; ++r) sacc += p0[r] + p1[r];
            lsum += sacc;
            u32x4 pw0, pw1, pw2, pw3;
            pw0 = (u32x4){cvtpk(p0[0], p0[1]), cvtpk(p0[2], p0[3]), cvtpk(p0[4], p0[5]), cvtpk(p0[6], p0[7])};
            pw1 = (u32x4){cvtpk(p0[8], p0[9]), cvtpk(p0[10], p0[11]), cvtpk(p0[12], p0[13]), cvtpk(p0[14], p0[15])};
            pw2 = (u32x4){cvtpk(p1[0], p1[1]), cvtpk(p1[2], p1[3]), cvtpk(p1[4], p1[5]), cvtpk(p1[6], p1[7])};
            pw3 = (u32x4){cvtpk(p1[8], p1[9]), cvtpk(p1[10], p1[11]), cvtpk(p1[12], p1[13]), cvtpk(p1[14], p1[15])};
            pv(o, vp0 + t * SLOTB, __builtin_bit_cast(bf16x8, pw0), __builtin_bit_cast(bf16x8, pw1), __builtin_bit_cast(bf16x8, pw2), __builtin_bit_cast(bf16x8, pw3));
        }
        lsum += __shfl_xor(lsum, 32);
        const float rl = __builtin_amdgcn_rcpf(lsum + snk);
        if (hi == 0) wsf[r32] = rl;
        asm volatile("s_waitcnt lgkmcnt(0)" ::: "memory");
        LAS bf16_t* stg = (LAS bf16_t*)(shm + L_OST) + wid * 2048;
#pragma unroll
        for (int r = 0; r < 16; ++r) { const int orow = crow(r, hi); const float rr = wsf[orow];
#pragma unroll
            for (int d0 = 0; d0 < 2; ++d0) stg[orow * 64 + d0 * 32 + r32] = (bf16_t)f2bf(o[d0][r] * rr); }
        asm volatile("s_waitcnt lgkmcnt(0)" ::: "memory");
#pragma unroll
        for (int it = 0; it < 4; ++it) {
            const int row = it * 8 + (lane >> 3), ch = lane & 7;
            const u32x4 ov = *(const LAS u32x4*)(stg + row * 64 + ch * 8);
            const u32x4 gv = *(const u32x4*)(PB + (rowbase + R0 + row) * DIN + OFF_GA + h * 64 + ch * 8);
            u32x4 w;
#pragma unroll
            for (int e = 0; e < 4; ++e) w[e] = cvtpk(bflo(ov[e]) * bflo(gv[e]), bfhi(ov[e]) * bfhi(gv[e]));
            *(u32x4*)(Y + (rowbase + R0 + row) * DM + h * 64 + ch * 8) = w;
        }
        asm volatile("s_waitcnt lgkmcnt(0)" ::: "memory");
    }
    __syncthreads();
}

__device__ __forceinline__ void gmlp_half(int item, const bf16_t* PB, bf16_t* Y, const bf16_t* Wsb, const float* bs_l, LAS unsigned char* shw  ) {
    int tid = threadIdx.x; asm volatile("" : "+v"(tid));
    const int lane = tid & 63, r32 = lane & 31, hi = lane >> 5;
    const int th = item & 1, g = (item >> 1) & 7, ch = item >> 4;
    const long row0 = (long)ch * 128;
    const unsigned ldsw = (unsigned)(uintptr_t)shw;
#pragma unroll
    for (int pc = 0; pc < 16; ++pc) { const int tt = pc >> 3, pw = pc & 7;
        glds16(PB + (row0 + 64 * tt + 16 * (pw & 3) + (lane >> 2)) * DIN + OFF_VG + g * 64 + (pw >> 2) * 32 + (lane & 3) * 8, (unsigned)__builtin_amdgcn_readfirstlane(ldsw + tt * 8192 + pw * 1024)); }
    asm volatile("s_waitcnt vmcnt(0)" ::: "memory");
    const lds_cptr vp0 = (lds_cptr)shw + ((lane >> 4) & 1) * 32 + (lane & 3) * 8 + (4 * hi + ((lane & 15) >> 2)) * 64;
    for (int tb = 0; tb < 2; ++tb) {
        const int tloc = 64 * th + 32 * tb;
        f32x16 o[2]; o[0] = f32x16{}; o[1] = f32x16{};
        const bf16_t* wrow = Wsb + ((size_t)g * 128 + tloc + r32) * 128 + 4 * hi;
#pragma unroll
        for (int ks = 0; ks < 8; ++ks) {
            const u32x2 wl = *(const u32x2*)(wrow + 16 * ks), wh = *(const u32x2*)(wrow + 16 * ks + 8);
            const u32x4 wa = (u32x4){wl.x, wl.y, wh.x, wh.y};
            const bf16x8 A = __builtin_bit_cast(bf16x8, wa);
#pragma unroll
            for (int d0 = 0; d0 < 2; ++d0) {
                const s16x4 lo = vtr(vp0 + (ks >> 2) * 8192 + d0 * 4096 + (ks & 3) * 1024), hh = vtr(vp0 + (ks >> 2) * 8192 + d0 * 4096 + (ks & 3) * 1024 + 512);
                const bf16x8 B = (bf16x8){lo[0], lo[1], lo[2], lo[3], hh[0], hh[1], hh[2], hh[3]};
                o[d0] = __builtin_amdgcn_mfma_f32_32x32x16_bf16(A, B, o[d0], 0, 0, 0);
            }
        }
#pragma unroll
        for (int r = 0; r < 16; ++r) {
            const int t = tloc + crow(r, hi); const float bsv = bs_l[g * 128 + t];
            const bf16_t* prow = PB + (row0 + t) * DIN + g * 64 + r32;
            bf16_t* yrow = Y + (row0 + t) * DM + 512 + g * 64 + r32;
#pragma unroll
            for (int d0 = 0; d0 < 2; ++d0) {
                const float uu = bf2f(prow[OFF_U + 32 * d0]), gg = bf2f(prow[OFF_GG + 32 * d0]);
                yrow[32 * d0] = (bf16_t)f2bf((o[d0][r] + bsv) * uu * gg);
            }
        }
    }
}
}

constexpr int NWAVES = 8;
constexpr size_t MiB = 1u << 20;
constexpr size_t WS_CTL = 0, CTL_ZERO_BYTES = 64 * 1024;
constexpr size_t WS_ADA = 1 * MiB;
constexpr size_t WS_GS = 1 * MiB + 64 * 1024;
constexpr size_t WS_BIAS = 1 * MiB + 128 * 1024;
constexpr size_t WS_SSQ = 1 * MiB + 256 * 1024;
constexpr size_t WS_WIN = 2 * MiB;
constexpr size_t WS_WOUT = 14 * MiB;
constexpr size_t WS_WS = 18 * MiB;
constexpr size_t WS_XS = 20 * MiB;
constexpr size_t WS_Y = 52 * MiB;
constexpr size_t WS_PB = 84 * MiB;
constexpr size_t WS_END = 176 * MiB;
static_assert(WS_PB + (size_t)M * DIN * 2 <= WS_END, "ws map");
constexpr int CW_BAR = 1024;

constexpr int RING_BYTES = 136 * 1024;
constexpr int MISC_OFF = RING_BYTES;
constexpr int LDS_BYTES = 144 * 1024;
static_assert(mix::L_END <= RING_BYTES && pg8::STAGE_BYTES <= RING_BYTES && 8 * 16384 <= RING_BYTES, "LDS map");

#define XB_TMO      128
#define XB_XCNT(j)  (256  + 64 * (j))
#define XB_XSUB(j)  (1280 + 64 * (j))
#define XB_XGEN(j)  (2304 + 64 * (j))
#define XB_TOP      3328
#define XB_TOPGEN   3392
#define XCD_BAR_WORDS 3456
#define XB_SPIN_CAP (1u << 18)
static_assert((CW_BAR + XCD_BAR_WORDS) * 4 <= (int)CTL_ZERO_BYTES, "barrier words inside the memset region");

__device__ __forceinline__ unsigned xb_ld(unsigned* p)              { return __hip_atomic_load(p, __ATOMIC_RELAXED, __HIP_MEMORY_SCOPE_AGENT); }
__device__ __forceinline__ unsigned xb_add(unsigned* p, unsigned v) { return __hip_atomic_fetch_add(p, v, __ATOMIC_RELAXED, __HIP_MEMORY_SCOPE_AGENT); }
__device__ __forceinline__ unsigned xb_xcc_id() { return (unsigned)__builtin_amdgcn_s_getreg((3 << 11) | 20) & 0xFu; }
#define XB_SPIN(cond, bar) do { unsigned _sp = 0; while (cond) { __builtin_amdgcn_s_sleep(1); \
    if ((++_sp & 255u) == 0u) { if (xb_ld(&(bar)[XB_TMO])) break; if (_sp > XB_SPIN_CAP) { atomicAdd(&(bar)[XB_TMO], 1u); break; } } } } while (0)

struct XcdBarrier { unsigned* bar; unsigned x; volatile LAS unsigned* st; };
__device__ __forceinline__ XcdBarrier xcd_barrier_post(unsigned* bar, volatile LAS unsigned* st) {
    XcdBarrier b; b.bar = bar; b.x = xb_xcc_id(); b.st = st;
    if (threadIdx.x == 0) (void)xb_add(&bar[XB_XCNT(b.x)], 1u);
    return b;
}
__device__ __forceinline__ void xcd_barrier_complete(unsigned* bar, unsigned x, unsigned& nloc, unsigned& nx) {
    const unsigned G = gridDim.x * gridDim.y * gridDim.z;
    unsigned sum, cnt, mine, sp = 0u;
    for (;;) {
        sum = 0u; cnt = 0u; mine = 0u;
#pragma unroll
        for (unsigned j = 0; j < 16; ++j) { const unsigned c = xb_ld(&bar[XB_XCNT(j)]); sum += c; cnt += (c > 0u) ? 1u : 0u; mine = (j == x) ? c : mine; }
        if (sum == G) break;
        __builtin_amdgcn_s_sleep(1);
        if ((++sp & 255u) == 0u) { if (xb_ld(&bar[XB_TMO])) break; if (sp > XB_SPIN_CAP) { atomicAdd(&bar[XB_TMO], 1u); break; } }
    }
    nloc = mine > 0u ? mine : 1u; nx = cnt > 0u ? cnt : 1u;
}
__device__ __forceinline__ void xcd_barrier(const XcdBarrier& b) {
    asm volatile("s_waitcnt vmcnt(0)" ::: "memory");
    __syncthreads();
    if (threadIdx.x == 0) {
        unsigned* bar = b.bar;
        __builtin_amdgcn_s_waitcnt(0);
        unsigned nloc = b.st[0], nx = b.st[1];
        if (nloc == 0u) { xcd_barrier_complete(bar, b.x, nloc, nx); b.st[0] = nloc; b.st[1] = nx; }
        const unsigned old = xb_add(&bar[XB_XSUB(b.x)], 1u);
        const unsigned gen = old / nloc;
        if (old + 1u == (gen + 1u) * nloc) {
            __builtin_amdgcn_fence(__ATOMIC_RELEASE, "agent");
            asm volatile("s_waitcnt vmcnt(0)" ::: "memory");
            const unsigned og = xb_add(&bar[XB_TOP], 1u);
            const unsigned tg = og / nx;
            if (og + 1u == (tg + 1u) * nx) xb_add(&bar[XB_TOPGEN], 1u);
            else XB_SPIN(xb_ld(&bar[XB_TOPGEN]) == tg, bar);
            __builtin_amdgcn_fence(__ATOMIC_ACQUIRE, "agent");
            xb_add(&bar[XB_XGEN(b.x)], 1u);
            asm volatile("s_waitcnt vmcnt(0)" ::: "memory");
        } else {
            XB_SPIN(xb_ld(&bar[XB_XGEN(b.x)]) == gen, bar);
            __builtin_amdgcn_fence(__ATOMIC_ACQUIRE, "agent");
            asm volatile("s_waitcnt vmcnt(0)" ::: "memory");
        }
    }
    __syncthreads();
}

struct Args { const float* in[12]; float* out; unsigned char* ws; int ph_lo, ph_hi; };
static_assert(sizeof(Args) == 14 * 8 + 8, "Args has no padding");

__device__ __forceinline__ void transpose_item(const float* W, int K, int N, bf16_t* WT, LAS float* scr, int item, int lane) {
    const int nblk = N / 32, kb = item / nblk, nb = item % nblk, k0 = 64 * kb, n0 = 32 * nb;
#pragma unroll 8
    for (int i = 0; i < 32; ++i) { const int kk = 2 * i + (lane >> 5); scr[kk * 33 + (lane & 31)] = W[(size_t)(k0 + kk) * N + n0 + (lane & 31)]; }
    asm volatile("s_waitcnt lgkmcnt(0)" ::: "memory");
    const int c = lane & 7;
#pragma unroll
    for (int j = 0; j < 4; ++j) { const int n = (lane >> 3) + 8 * j; const LAS float* s = scr + (8 * c) * 33 + n;
        u32x4 o; o.x = pk2(s[0 * 33], s[1 * 33]); o.y = pk2(s[2 * 33], s[3 * 33]); o.z = pk2(s[4 * 33], s[5 * 33]); o.w = pk2(s[6 * 33], s[7 * 33]);
        *(u32x4*)(WT + (size_t)(n0 + n) * K + k0 + 8 * c) = o; }
    asm volatile("s_waitcnt lgkmcnt(0)" ::: "memory");
}

template <bool SILU>
__device__ __forceinline__ void gemv32(const float* W, int N, int n0, const float* vec  , int vstride, const float* addb, float* out  , int ostride, LAS float* red  ) {
    const int tid = threadIdx.x, lane = tid & 63, w = tid >> 6, cg = lane & 7, rg = lane >> 3;
    f32x4 a0 = {0.f, 0.f, 0.f, 0.f}, a1 = {0.f, 0.f, 0.f, 0.f};
#pragma unroll 4
    for (int it = 0; it < 16; ++it) {
        const int k = 128 * w + 8 * it + rg;
        const f32x4 wv = *(const f32x4*)(W + (size_t)k * N + n0 + 4 * cg);
        float s0 = vec[k], s1 = vec[vstride + k];
        if (SILU) { s0 = fsilu(s0); s1 = fsilu(s1); }
        a0 += wv * s0; a1 += wv * s1;
    }
#pragma unroll
    for (int e = 0; e < 4; ++e) {
        a0[e] += __shfl_xor(a0[e], 8); a0[e] += __shfl_xor(a0[e], 16); a0[e] += __shfl_xor(a0[e], 32);
        a1[e] += __shfl_xor(a1[e], 8); a1[e] += __shfl_xor(a1[e], 16); a1[e] += __shfl_xor(a1[e], 32);
    }
    if (rg == 0) {
#pragma unroll
        for (int e = 0; e < 4; ++e) { red[(w * 2 + 0) * 32 + 4 * cg + e] = a0[e]; red[(w * 2 + 1) * 32 + 4 * cg + e] = a1[e]; }
    }
    __syncthreads();
    if (tid < 64) { const int bb = tid >> 5, col = tid & 31; float s = addb ? addb[n0 + col] : 0.f;
#pragma unroll
        for (int ww = 0; ww < 8; ++ww) s += red[(ww * 2 + bb) * 32 + col];
        out[bb * ostride + n0 + col] = s; }
    __syncthreads();
}

__global__ void __launch_bounds__(NWAVES * 64, 2) mk_fwd(Args args) {
    __shared__ __attribute__((aligned(16))) unsigned char lds_raw[LDS_BYTES];
    LAS unsigned char* lds = (LAS unsigned char*)lds_raw;
    volatile LAS unsigned* MISC = (volatile LAS unsigned*)(lds + MISC_OFF);
    const int tid = threadIdx.x, lane = tid & 63, wave = __builtin_amdgcn_readfirstlane(tid >> 6);
    const int G = gridDim.x; const int bx = blockIdx.x; const int vcu = (G % 8 == 0) ? (bx % 8) * (G / 8) + bx / 8 : bx;
    unsigned char* ws = args.ws;
    const float* x = args.in[0]; const float* cvec = args.in[1]; const float* w_ada = args.in[2]; const float* b_ada = args.in[3]; const float* norm_gain = args.in[4]; const float* w_in = args.in[5];
    const float* q_gain = args.in[6]; const float* k_gain = args.in[7]; const float* sink = args.in[8]; const float* w_s = args.in[9]; const float* b_s = args.in[10]; const float* w_out = args.in[11];
    float* out = args.out;
    float* ADA = (float*)(ws + WS_ADA); float* GS = (float*)(ws + WS_GS); float* BIAS = (float*)(ws + WS_BIAS); float* SSQ = (float*)(ws + WS_SSQ);
    bf16_t* WIN = (bf16_t*)(ws + WS_WIN); bf16_t* WOUT = (bf16_t*)(ws + WS_WOUT); bf16_t* WSB = (bf16_t*)(ws + WS_WS);
    bf16_t* XS = (bf16_t*)(ws + WS_XS); bf16_t* Y = (bf16_t*)(ws + WS_Y); bf16_t* PB = (bf16_t*)(ws + WS_PB);
    if (tid < 64) MISC[tid] = 0u;
    __syncthreads();
    const int lo = args.ph_lo, hi = args.ph_hi;
    XcdBarrier bar; bar.bar = (unsigned*)(ws + WS_CTL) + CW_BAR; bar.x = 0; bar.st = MISC + 8;
    if (hi - lo > 1) bar = xcd_barrier_post((unsigned*)(ws + WS_CTL) + CW_BAR, MISC + 8);
#define IN(k) (lo <= (k) && (k) < hi)
#define SEAM(k) do { if ((k) + 1 < hi) xcd_barrier(bar); } while (0)
    const int gw = vcu * NWAVES + wave, NGW = G * NWAVES;

    if (((PH_MASK >> 0) & 1) && IN(0)) {
        if (vcu < 192) { const int l = vcu / 96, cb = vcu % 96;
            gemv32<true>(w_ada + (size_t)l * DM * 3 * DM, 3 * DM, 32 * cb, cvec, DM, b_ada + l * 3 * DM, ADA + l * 2 * 3 * DM, 3 * DM, (LAS float*)lds); }
        LAS float* scr = (LAS float*)(lds + wave * 16384);
        constexpr int I_IN = (DM / 64) * (DIN / 32), I_OUT = (DM / 64) * (DM / 32), NIT = NL * (I_IN + I_OUT);
        for (int it = gw; it < NIT; it += NGW) {
            int r = it; const int l = r / (I_IN + I_OUT); r -= l * (I_IN + I_OUT);
            if (r < I_IN) transpose_item(w_in + (size_t)l * DM * DIN, DM, DIN, WIN + (size_t)l * DIN * DM, scr, r, lane);
            else transpose_item(w_out + (size_t)l * DM * DM, DM, DM, WOUT + (size_t)l * DM * DM, scr, r - I_IN, lane);
        }
        for (int it = gw; it < NL * 8 * 128 * 128 / 512; it += NGW) {
            const float* s = w_s + (size_t)it * 512 + lane * 8; const f32x4 a = *(const f32x4*)s, b2 = *(const f32x4*)(s + 4);
            u32x4 o; o.x = pk2(a[0], a[1]); o.y = pk2(a[2], a[3]); o.z = pk2(b2[0], b2[1]); o.w = pk2(b2[2], b2[3]);
            *(u32x4*)(WSB + (size_t)it * 512 + lane * 8) = o; }
        SEAM(0);
    }
    if (((PH_MASK >> 1) & 1) && IN(1)) {
        if (vcu < 176) { const int l = vcu / 88, nb = vcu % 88;
            gemv32<false>(w_in + (size_t)l * DM * DIN, DIN, 32 * nb, ADA + l * 2 * 3 * DM  , 3 * DM, nullptr, BIAS + l * 2 * DIN, DIN, (LAS float*)lds); }
        else if (vcu == 200) { for (int i = tid; i < NL * 2 * DM; i += NWAVES * 64) { const int l = i / (2 * DM), b = (i / DM) & 1, k = i % DM; GS[i] = norm_gain[l * DM + k] * (1.f + ADA[(l * 2 + b) * 3 * DM + DM + k]); } }
        {
            const int r0 = gw * (M / NGW), b = r0 / SEQ;
            f32x4 gsv[4];
#pragma unroll
            for (int j = 0; j < 4; ++j) { const int k = 256 * j + 4 * lane; const f32x4 gn = *(const f32x4*)(norm_gain + k), sc = *(const f32x4*)(ADA + b * 3 * DM + DM + k); gsv[j] = gn * (1.f + sc); }
            for (int rr = 0; rr < M / NGW; ++rr) {
                const int m = r0 + rr;
                const f32x4* xr = (const f32x4*)(x + (size_t)m * DM) + lane;
                f32x4 v[4]; float s = 0.f;
#pragma unroll
                for (int j = 0; j < 4; ++j) { v[j] = xr[64 * j]; s += (v[j][0] * v[j][0] + v[j][1] * v[j][1]) + (v[j][2] * v[j][2] + v[j][3] * v[j][3]); }
                s = wave_sum(s);
                u32x2* o8 = (u32x2*)(XS + (size_t)m * DM) + lane;
#pragma unroll
                for (int j = 0; j < 4; ++j) { const f32x4 t = v[j] * gsv[j]; u32x2 w; w.x = cvtpk(t[0], t[1]); w.y = cvtpk(t[2], t[3]); o8[64 * j] = w; }
                if (lane == 0) *(f32x4*)(SSQ + (size_t)m * 4) = (f32x4){s, 0.f, 0.f, 0.f};
            }
        }
        SEAM(1);
    }
    for (int l = 0; l < NL; ++l) {
        const int p0 = 2 + 3 * l;
        if (((PH_MASK >> 2) & 1) && IN(p0)) {
            pg8::Gemm g{XS, WIN + (size_t)l * DIN * DM, M, DIN, DM}; pg8::StaticOrder S; S.init(M, DIN, G, bx);
            pg8::EpiProj E{PB, SSQ, BIAS + l * 2 * DIN, q_gain + l * 64, k_gain + l * 64};
            pg8::gemm_phase<pg8::EpiProj, true>(lds, g, S, E);
            SEAM(p0);
        }
        if (((PH_MASK >> 3) & 3) && IN(p0 + 1)) {
            float aq = 0.f, ak = 0.f;
            { const float qv = __builtin_fabsf(q_gain[l * 64 + lane]), kv = __builtin_fabsf(k_gain[l * 64 + lane]); aq = qv; ak = kv;
#pragma unroll
              for (int o = 1; o < 64; o <<= 1) { aq = fmaxf(aq, __shfl_xor(aq, o)); ak = fmaxf(ak, __shfl_xor(ak, o)); } }
            const float sb2 = 8.f * aq * ak * LOG2E;
            if ((PH_MASK >> 3) & 1) for (int uidx = vcu; uidx < 256; uidx += G) mix::attn_unit(uidx >> 7, (uidx >> 6) & 1, uidx & 63, PB, Y, sink + l * 8, sb2, lds);
            if ((PH_MASK >> 4) & 1) for (int it = gw; it < 2048; it += NGW) mix::gmlp_half(it, PB, Y, WSB + (size_t)l * 8 * 128 * 128, b_s + l * 8 * 128, lds + wave * 16384);
            SEAM(p0 + 1);
        }
        if (((PH_MASK >> 5) & 1) && IN(p0 + 2)) {
            pg8::Gemm g{Y, WOUT + (size_t)l * DM * DM, M, DM, DM}; pg8::StaticOrder S; S.init(M, DM, G, bx);
            const bool lastl = (l == NL - 1);
            pg8::EpiOut E{l == 0 ? x : out, out, ADA + l * 2 * 3 * DM, lastl ? nullptr : XS, GS + (lastl ? 0 : (l + 1) * 2 * DM), SSQ};
            pg8::gemm_phase<pg8::EpiOut, false>(lds, g, S, E);
            SEAM(p0 + 2);
        }
    }
#undef IN
#undef SEAM
}

extern "C" void kernel_launch(void* const* d_in, const int* in_sizes, int n_in, void* d_out, int out_size, void* d_ws, size_t ws_size, hipStream_t stream) {
    static int grid = 0;
    if (grid == 0) {
        if (n_in != 12 || in_sizes[0] != M * DM || out_size != M * DM || ws_size < WS_END) { fprintf(stderr, "kernel_launch: unexpected shapes (n_in %d, in0 %d, out %d, ws %zu)\n", n_in, n_in > 0 ? in_sizes[0] : -1, out_size, ws_size); grid = -1; return; }
        int dev = 0, cus = 0, per_cu = 0;
        if (hipGetDevice(&dev) != hipSuccess || hipDeviceGetAttribute(&cus, hipDeviceAttributeMultiprocessorCount, dev) != hipSuccess) { grid = -1; return; }
        if (hipOccupancyMaxActiveBlocksPerMultiprocessor(&per_cu, (const void*)mk_fwd, NWAVES * 64, 0) != hipSuccess || per_cu < 1) { fprintf(stderr, "kernel_launch: occupancy query says %d\n", per_cu); per_cu = 1; }
        (void)hipGetLastError();
        grid = cus;
    }
    if (grid < 0) return;
    (void)hipMemsetAsync((char*)d_ws + WS_CTL, 0, CTL_ZERO_BYTES, stream);
    Args a{};
    for (int i = 0; i < 12; ++i) a.in[i] = (const float*)d_in[i];
    a.out = (float*)d_out; a.ws = (unsigned char*)d_ws;
#if MK_PER_PHASE
    for (int p = 0; p < 8; ++p) { a.ph_lo = p; a.ph_hi = p + 1; hipLaunchKernelGGL(mk_fwd, dim3(grid), dim3(NWAVES * 64), 0, stream, a); }
#else
    a.ph_lo = 0; a.ph_hi = 8;
    hipLaunchKernelGGL(mk_fwd, dim3(grid), dim3(NWAVES * 64), 0, stream, a);
#endif
}
```

```cpp
#include <hip/hip_runtime.h>
#include <cstdio>
#include <cstdint>

#ifndef PH_MASK
#define PH_MASK 0xff
#endif
#ifndef PROBE_REP
#define PROBE_REP -1
#endif
#ifndef PROBE_BAR
#define PROBE_BAR 0
#endif
#ifndef MK_PER_PHASE
#define MK_PER_PHASE 0
#endif

constexpr int NB = 2, SEQ = 8192, DM = 1024, M = NB * SEQ, DIN = 2816, NL = 2;
constexpr int OFF_Q = 0, OFF_K = 512, OFF_V = 640, OFF_GA = 768, OFF_U = 1280, OFF_VG = 1792, OFF_GG = 2304;
constexpr float EPS = 1e-6f;
constexpr float LOG2E = 1.4426950408889634f;
constexpr float C2 = 0.125f * LOG2E;

#define LAS __attribute__((address_space(3)))
#define GAS __attribute__((address_space(1)))
typedef unsigned short bf16_t;
typedef short bf16x8 __attribute__((ext_vector_type(8)));
typedef short s16x4 __attribute__((ext_vector_type(4)));
typedef float f32x4 __attribute__((ext_vector_type(4)));
typedef float f32x16 __attribute__((ext_vector_type(16)));
typedef unsigned u32x4 __attribute__((ext_vector_type(4)));
typedef unsigned u32x2 __attribute__((ext_vector_type(2)));
typedef GAS unsigned gu32;

__device__ __forceinline__ unsigned f2bf(float f) { unsigned u = __builtin_bit_cast(unsigned, f); return (u + 0x7fffu + ((u >> 16) & 1u)) >> 16; }
__device__ __forceinline__ unsigned pk2(float lo, float hi) { return f2bf(lo) | (f2bf(hi) << 16); }
__device__ __forceinline__ float bf2f(unsigned short h) { return __builtin_bit_cast(float, (unsigned)h << 16); }
__device__ __forceinline__ float bflo(unsigned w) { return __builtin_bit_cast(float, w << 16); }
__device__ __forceinline__ float bfhi(unsigned w) { return __builtin_bit_cast(float, w & 0xffff0000u); }
typedef float f32x2_t __attribute__((ext_vector_type(2))); typedef __bf16 bf16x2_t __attribute__((ext_vector_type(2)));
__device__ __forceinline__ unsigned cvtpk(float lo, float hi) { f32x2_t v = {lo, hi}; bf16x2_t b = __builtin_convertvector(v, bf16x2_t); return __builtin_bit_cast(unsigned, b); }
__device__ __forceinline__ float fsilu(float v) { return v * __builtin_amdgcn_rcpf(1.f + __builtin_amdgcn_exp2f(-LOG2E * v)); }
__device__ __forceinline__ float wave_sum(float v) {
#pragma unroll
    for (int o = 1; o < 64; o <<= 1) v += __shfl_xor(v, o);
    return v;
}

namespace pg8 {
constexpr int BM = 256, BK = 64, HALF = 128, HTB = HALF * BK * 2, STAGE_BYTES = 8 * HTB, NXCD = 8, WGM = 8;
__host__ __device__ __forceinline__ int lds_byte(int r, int c) { const int st = (r >> 4) * 2 + (c >> 5), rr = r & 15, cc = c & 31, ob = rr * 64 + cc * 2; return st * 1024 + (ob ^ (((ob >> 9) & 1) << 5)); }
__host__ __device__ __forceinline__ void stage_rc(int b, int& R, int& C) { const int st = b / 1024, sb = b % 1024, swz = sb ^ (((sb >> 9) & 1) << 5); R = (st >> 1) * 16 + swz / 64; C = (st & 1) * 32 + (swz % 64) / 2; }
__host__ __device__ __forceinline__ int perm32(int rho) { const int n = rho >> 4, i = rho & 15; return 8 * (i >> 2) + 4 * n + (i & 3); }

struct Unit { int pm, pn; };
struct Gemm { const bf16_t* A; const bf16_t* Bt; int M, N, K; };

struct StaticOrder {
    int nM, nN, nwg, G, c;
    __host__ __device__ void init(int M_, int N_, int G_, int c_) { nM = M_ / BM; nN = N_ / BM; nwg = nM * nN; G = G_; c = c_; }
    __host__ __device__ bool next(int i, Unit& u) const {
        const long L = (long)i * G + c; if (L >= nwg) return false;
        int wgid = (int)L; { const int q = nwg / NXCD, r = nwg % NXCD, xcd = wgid % NXCD, off = wgid / NXCD; wgid = (xcd < r ? xcd * (q + 1) : r * (q + 1) + (xcd - r) * q) + off; }
        const int nig = WGM * nN, gid = wgid / nig, fm = gid * WGM, gsz = (nM - fm) < WGM ? (nM - fm) : WGM;
        u.pm = fm + ((wgid % nig) % gsz); u.pn = (wgid % nig) / gsz; return true;
    }
};

template <class Epi, bool ALIGN_EPI>
__device__ __forceinline__ void gemm_phase(LAS unsigned char* lds, const Gemm g, const StaticOrder& S, const Epi& E) {
    int tid = threadIdx.x; asm volatile("" : "+v"(tid));
    const int wid = __builtin_amdgcn_readfirstlane(tid >> 6), lane = tid & 63, wr = wid >> 2, wc = wid & 3, fr = lane & 15, fq = lane >> 4;
    const int K = g.K, nt = K / BK;
    unsigned voffA[2], voffB0[2], voffB1[2];
#pragma unroll
    for (int i = 0; i < 2; ++i) { int R, C; stage_rc(tid * 16 + i * 8192, R, C); const int cb = 64 * (R >> 5) + perm32(R & 31);
        voffA[i] = (unsigned)(R * K + C) * 2u; voffB0[i] = (unsigned)(cb * K + C) * 2u; voffB1[i] = (unsigned)((cb + 32) * K + C) * 2u; }
    const size_t kstep = (size_t)(BK * 2);
    const size_t hstep = (size_t)HALF * K * 2;
    const size_t tstep = 2 * hstep;
    const unsigned ldsw = (unsigned)wid * 1024u;
    const int aoff = lds_byte(wr * 64 + fr, fq * 8), boff = lds_byte(wc * 32 + fr, fq * 8);
#define PG8_SA(b, h) (((b) * 2 + (h)) * HTB)
#define PG8_SB(b, h) ((4 + (b) * 2 + (h)) * HTB)
#define PG8_STAGE(bufoff, gbase, voff) do { _Pragma("unroll") for (int _i = 0; _i < 2; ++_i) \
        __builtin_amdgcn_global_load_lds((const unsigned*)((const char*)(gbase) + (voff)[_i]), (LAS unsigned*)(lds + (bufoff) + ldsw + _i * 8192), 16, 0, 0); } while (0)
#define PG8_LDA(dst, b, h) do { _Pragma("unroll") for (int m = 0; m < 4; ++m) _Pragma("unroll") for (int k = 0; k < 2; ++k) dst[m][k] = *(const LAS bf16x8*)(lds + PG8_SA(b, h) + aoff + m * 2048 + k * 1024); } while (0)
#define PG8_LDB(dst, b, h) do { _Pragma("unroll") for (int n = 0; n < 2; ++n) _Pragma("unroll") for (int k = 0; k < 2; ++k) dst[n][k] = *(const LAS bf16x8*)(lds + PG8_SB(b, h) + boff + n * 2048 + k * 1024); } while (0)
#define PG8_MMA(ai, bj, At, Bt) do { __builtin_amdgcn_s_setprio(1); _Pragma("unroll") for (int m = 0; m < 4; ++m) _Pragma("unroll") for (int n = 0; n < 2; ++n) _Pragma("unroll") for (int k = 0; k < 2; ++k) \
        acc[ai][bj][m][n] = __builtin_amdgcn_mfma_f32_16x16x32_bf16(Bt[n][k], At[m][k], acc[ai][bj][m][n], 0, 0, 0); __builtin_amdgcn_s_setprio(0); } while (0)
#define PG8_WAIT_V(n) asm volatile("s_waitcnt vmcnt(" #n ")" ::: "memory")
#define PG8_WAIT_L(n) asm volatile("s_waitcnt lgkmcnt(" #n ")" ::: "memory")
#define PG8_BAR __builtin_amdgcn_s_barrier()
#define PG8_SCHED __builtin_amdgcn_sched_barrier(0)
    Unit cur, nxt; int ui = 0;
    if (!S.next(0, cur)) return;
    f32x4 acc[2][2][4][2];
#pragma unroll
    for (int a = 0; a < 2; ++a)
#pragma unroll
        for (int b = 0; b < 2; ++b)
#pragma unroll
            for (int m = 0; m < 4; ++m)
#pragma unroll
                for (int n = 0; n < 2; ++n) acc[a][b][m][n] = (f32x4){0.f, 0.f, 0.f, 0.f};
    bf16x8 At[4][2], B0[2][2], B1[2][2];
    const char* cA = (const char*)g.A + (size_t)cur.pm * tstep; const char* cB = (const char*)g.Bt + (size_t)cur.pn * tstep;
    PG8_STAGE(PG8_SB(0, 0), cB, voffB0); PG8_STAGE(PG8_SB(0, 1), cB, voffB1); PG8_STAGE(PG8_SA(0, 0), cA, voffA); PG8_STAGE(PG8_SA(0, 1), cA + hstep, voffA);
    if (wr == 1) PG8_BAR;
    PG8_WAIT_V(2); PG8_BAR;
    PG8_STAGE(PG8_SB(1, 0), cB + kstep, voffB0); PG8_STAGE(PG8_SA(1, 0), cA + kstep, voffA); PG8_STAGE(PG8_SB(1, 1), cB + kstep, voffB1);
    PG8_WAIT_V(6); PG8_BAR;
    for (;;) {
        const bool has_next = S.next(ui + 1, nxt);
        const char* nA = has_next ? (const char*)g.A + (size_t)nxt.pm * tstep : cA; const char* nB = has_next ? (const char*)g.Bt + (size_t)nxt.pn * tstep : cB;
        for (int t = 0; t < nt; t += 2) {
            const bool last = (t == nt - 2);
            const char* a1 = cA + (size_t)(t + 1) * kstep;
            const char* a2 = last ? nA : cA + (size_t)(t + 2) * kstep; const char* b2 = last ? nB : cB + (size_t)(t + 2) * kstep;
            const char* a3 = a2 + kstep; const char* b3 = b2 + kstep;
            PG8_LDB(B0, 0, 0); PG8_LDB(B1, 0, 1); PG8_SCHED; PG8_LDA(At, 0, 0); PG8_STAGE(PG8_SA(1, 1), a1 + hstep, voffA);
            PG8_WAIT_V(8); PG8_WAIT_L(0); PG8_BAR; PG8_MMA(0, 0, At, B0); PG8_MMA(0, 1, At, B1); PG8_BAR; PG8_SCHED;
            PG8_LDA(At, 0, 1); PG8_STAGE(PG8_SB(0, 0), b2, voffB0); PG8_STAGE(PG8_SB(0, 1), b2, voffB1); PG8_STAGE(PG8_SA(0, 0), a2, voffA);
            PG8_WAIT_V(8); PG8_WAIT_L(0); PG8_BAR; PG8_MMA(1, 0, At, B0); PG8_MMA(1, 1, At, B1); PG8_BAR; PG8_SCHED;
            PG8_LDB(B0, 1, 0); PG8_LDB(B1, 1, 1); PG8_SCHED; PG8_LDA(At, 1, 0); PG8_STAGE(PG8_SA(0, 1), a2 + hstep, voffA);
            PG8_WAIT_V(8); PG8_WAIT_L(0); PG8_BAR; PG8_MMA(0, 0, At, B0); PG8_MMA(0, 1, At, B1); PG8_BAR; PG8_SCHED;
            PG8_LDA(At, 1, 1); PG8_STAGE(PG8_SB(1, 0), b3, voffB0); PG8_STAGE(PG8_SB(1, 1), b3, voffB1); PG8_STAGE(PG8_SA(1, 0), a3, voffA);
            PG8_WAIT_V(8); PG8_WAIT_L(0); PG8_BAR; PG8_MMA(1, 0, At, B0); PG8_MMA(1, 1, At, B1); PG8_BAR; PG8_SCHED;
        }
        if constexpr (ALIGN_EPI) { if (wr == 0) PG8_BAR; }
        if constexpr (!Epi::AFTER_DRAIN) { E(acc, cur, wr, wc, fr, fq); }
        if (!has_next) break;
#pragma unroll
        for (int a = 0; a < 2; ++a)
#pragma unroll
            for (int b = 0; b < 2; ++b)
#pragma unroll
                for (int m = 0; m < 4; ++m)
#pragma unroll
                    for (int n = 0; n < 2; ++n) acc[a][b][m][n] = (f32x4){0.f, 0.f, 0.f, 0.f};
        cur = nxt; cA = nA; cB = nB; ++ui;
        if constexpr (ALIGN_EPI) { if (wr == 1) PG8_BAR; }
    }
    PG8_WAIT_V(0);
    if constexpr (!ALIGN_EPI) { if (wr == 0) PG8_BAR; }
    PG8_BAR;
    if constexpr (Epi::AFTER_DRAIN) { E.fused(acc, cur, wr, wc, fr, fq, lds, wid, lane); }
#undef PG8_SA
#undef PG8_SB
#undef PG8_STAGE
#undef PG8_LDA
#undef PG8_LDB
#undef PG8_MMA
#undef PG8_WAIT_V
#undef PG8_WAIT_L
#undef PG8_BAR
#undef PG8_SCHED
}

struct EpiProj {
    static constexpr bool AFTER_DRAIN = false;
    bf16_t* PB; const float* ssq4; const float* bias; const float* qg; const float* kg;
    __device__ __forceinline__ void operator()(const f32x4 (&acc)[2][2][4][2], const Unit& u, int wr, int wc, int fr, int fq) const {
        const int b = u.pm >> 5;
        const int colw = u.pn * 256 + wc * 64 + 8 * fq;
        int type;
        if (u.pn < 2) type = 0; else if (u.pn == 2) type = (wc < 2) ? 1 : 2; else if (u.pn < 5) type = 3; else if (u.pn < 7) type = 2; else if (u.pn < 9) type = 4; else type = 3;
        const float* bp = bias + b * DIN + colw;
        f32x4 bv[2][2];
#pragma unroll
        for (int bj = 0; bj < 2; ++bj)
#pragma unroll
            for (int n = 0; n < 2; ++n) bv[bj][n] = *(const f32x4*)(bp + 32 * bj + 4 * n);
        float rstd[2][4];
        const float* sp = ssq4 + (size_t)(u.pm * 256 + wr * 64 + fr) * 4;
#pragma unroll
        for (int ai = 0; ai < 2; ++ai)
#pragma unroll
            for (int m = 0; m < 4; ++m) { const f32x4 s4 = *(const f32x4*)(sp + (size_t)(ai * 128 + m * 16) * 4); rstd[ai][m] = __builtin_amdgcn_rsqf(((s4[0] + s4[1]) + (s4[2] + s4[3])) * (1.f / DM) + EPS); }
        f32x4 gk[2][2];
        if (type == 1) {
#pragma unroll
            for (int bj = 0; bj < 2; ++bj)
#pragma unroll
                for (int n = 0; n < 2; ++n) gk[bj][n] = *(const f32x4*)(kg + 8 * fq + 32 * bj + 4 * n) * *(const f32x4*)(qg + 8 * fq + 32 * bj + 4 * n);
        }
        const float gsc = (type == 0) ? C2 : 1.f;
#pragma unroll
        for (int ai = 0; ai < 2; ++ai)
#pragma unroll
            for (int m = 0; m < 4; ++m) {
                const int row = u.pm * 256 + ai * 128 + wr * 64 + m * 16 + fr;
                f32x4 v[2][2];
#pragma unroll
                for (int bj = 0; bj < 2; ++bj)
#pragma unroll
                    for (int n = 0; n < 2; ++n) v[bj][n] = acc[ai][bj][m][n] * rstd[ai][m] + bv[bj][n];
                if (type == 0 || type == 1 || type == 4) {
                    float ss = 0.f;
#pragma unroll
                    for (int bj = 0; bj < 2; ++bj)
#pragma unroll
                        for (int n = 0; n < 2; ++n) ss += (v[bj][n][0] * v[bj][n][0] + v[bj][n][1] * v[bj][n][1]) + (v[bj][n][2] * v[bj][n][2] + v[bj][n][3] * v[bj][n][3]);
                    ss += __shfl_xor(ss, 16); ss += __shfl_xor(ss, 32);
                    const float rs = __builtin_amdgcn_rsqf(ss * (1.f / 64.f) + EPS) * gsc;
                    if (type == 1) {
#pragma unroll
                        for (int bj = 0; bj < 2; ++bj)
#pragma unroll
                            for (int n = 0; n < 2; ++n) v[bj][n] = v[bj][n] * rs * gk[bj][n];
                    } else {
#pragma unroll
                        for (int bj = 0; bj < 2; ++bj)
#pragma unroll
                            for (int n = 0; n < 2; ++n) v[bj][n] = v[bj][n] * rs;
                    }
                } else if (type == 3) {
#pragma unroll
                    for (int bj = 0; bj < 2; ++bj)
#pragma unroll
                        for (int n = 0; n < 2; ++n)
#pragma unroll
                            for (int e = 0; e < 4; ++e) v[bj][n][e] = fsilu(v[bj][n][e]);
                }
                bf16_t* rowp = PB + (size_t)row * DIN + colw;
#pragma unroll
                for (int bj = 0; bj < 2; ++bj) {
                    u32x4 w; w.x = cvtpk(v[bj][0][0], v[bj][0][1]); w.y = cvtpk(v[bj][0][2], v[bj][0][3]); w.z = cvtpk(v[bj][1][0], v[bj][1][1]); w.w = cvtpk(v[bj][1][2], v[bj][1][3]);
                    *(u32x4*)(rowp + 32 * bj) = w;
                }
            }
    }
};

struct EpiOut {
    static constexpr bool AFTER_DRAIN = true;
    const float* xin; float* xout; const float* gate; bf16_t* xs; const float* gsn; float* ssq4;
    __device__ __forceinline__ void fused(f32x4 (&acc)[2][2][4][2], const Unit& u, int wr, int wc, int fr, int fq, LAS unsigned char* lds, int wid, int lane) const {
        const int b = u.pm >> 5;
        const int colw = u.pn * 256 + wc * 64 + 8 * fq;
        const bool nx = (xs != nullptr);
        const float* gtp = gate + b * 3 * DM + 2 * DM + colw;
        const float* gnp = gsn + b * DM + colw;
        f32x4 gt[2][2];
#pragma unroll
        for (int bj = 0; bj < 2; ++bj)
#pragma unroll
            for (int n = 0; n < 2; ++n) gt[bj][n] = *(const f32x4*)(gtp + 32 * bj + 4 * n);
        LAS float* P = (LAS float*)lds;
#pragma unroll
        for (int ai = 0; ai < 2; ++ai) {
            f32x4 xv[4][2][2];
#pragma unroll
            for (int m = 0; m < 4; ++m)
#pragma unroll
                for (int bj = 0; bj < 2; ++bj)
#pragma unroll
                    for (int n = 0; n < 2; ++n) xv[m][bj][n] = *(const f32x4*)(xin + (size_t)(u.pm * 256 + ai * 128 + wr * 64 + m * 16 + fr) * DM + colw + 32 * bj + 4 * n);
#pragma unroll
            for (int m = 0; m < 4; ++m) {
                const int rl = ai * 128 + wr * 64 + m * 16 + fr;
                const size_t off = (size_t)(u.pm * 256 + rl) * DM + colw;
                float ss = 0.f;
#pragma unroll
                for (int bj = 0; bj < 2; ++bj) {
                    f32x4 o[2];
#pragma unroll
                    for (int n = 0; n < 2; ++n) {
                        o[n] = xv[m][bj][n] + gt[bj][n] * acc[ai][bj][m][n];
                        *(f32x4*)(xout + off + 32 * bj + 4 * n) = o[n];
                        ss += (o[n][0] * o[n][0] + o[n][1] * o[n][1]) + (o[n][2] * o[n][2] + o[n][3] * o[n][3]);
                    }
                    if (nx) {
                        const f32x4 a = o[0] * *(const f32x4*)(gnp + 32 * bj), c = o[1] * *(const f32x4*)(gnp + 32 * bj + 4);
                        u32x4 w; w.x = cvtpk(a[0], a[1]); w.y = cvtpk(a[2], a[3]); w.z = cvtpk(c[0], c[1]); w.w = cvtpk(c[2], c[3]);
                        *(u32x4*)(xs + off + 32 * bj) = w;
                    }
                }
                if (nx) { ss += __shfl_xor(ss, 16); ss += __shfl_xor(ss, 32); if (fq == 0) P[rl * 4 + wc] = ss; }
            }
            asm volatile("" ::: "memory");
        }
        if (nx) {
            __syncthreads();
            if (threadIdx.x < 256) { const int rl = threadIdx.x; const float s = (P[rl * 4 + 0] + P[rl * 4 + 1]) + (P[rl * 4 + 2] + P[rl * 4 + 3]); ssq4[(size_t)(u.pm * 256 + rl) * 4 + u.pn] = s; }
            __syncthreads();
        }
    }
};
}

namespace mix {
typedef LAS const char* lds_cptr;
constexpr int SLOTB = 8192, NSLOT = 6;
constexpr int L_K = 0, L_V = NSLOT * SLOTB, L_WS = 2 * NSLOT * SLOTB, L_OST = L_WS + 8 * 256, L_END = L_OST + 8 * 4096;
__device__ __forceinline__ int crow(int r, int hi) { return (r & 3) + 8 * (r >> 2) + 4 * hi; }
__device__ __forceinline__ void glds16(const void* gsrc, unsigned lds_dst) { unsigned keep;
    asm volatile("s_mov_b32 %0, m0\n\ts_mov_b32 m0, %2\n\ts_nop 0\n\tglobal_load_lds_dwordx4 %1, off\n\ts_mov_b32 m0, %0" : "=&s"(keep) : "v"(gsrc), "s"(lds_dst) : "memory"); }
__device__ __forceinline__ s16x4 vtr(lds_cptr p) { typedef short v4i16_t __attribute__((ext_vector_type(4))); return __builtin_bit_cast(s16x4, __builtin_amdgcn_ds_read_tr16_b64_v4i16((LAS v4i16_t*)p)); }

__device__ __forceinline__ void qkt(f32x16& p0, f32x16& p1, lds_cptr kslot, const bf16x8* qr, const f32x16& cinit, int r32, int hi) {
    lds_cptr kb = kslot + hi * 1024 + r32 * 16;
#pragma unroll
    for (int d0 = 0; d0 < 4; ++d0) {
        const bf16x8 b0 = *(const LAS bf16x8*)(kb + d0 * 2048);
        const bf16x8 b1 = *(const LAS bf16x8*)(kb + d0 * 2048 + 512);
        if (d0 == 0) { p0 = __builtin_amdgcn_mfma_f32_32x32x16_bf16(b0, qr[0], cinit, 0, 0, 0); p1 = __builtin_amdgcn_mfma_f32_32x32x16_bf16(b1, qr[0], cinit, 0, 0, 0); }
        else { p0 = __builtin_amdgcn_mfma_f32_32x32x16_bf16(b0, qr[d0], p0, 0, 0, 0); p1 = __builtin_amdgcn_mfma_f32_32x32x16_bf16(b1, qr[d0], p1, 0, 0, 0); }
    }
}
__device__ __forceinline__ void pv(f32x16* o, lds_cptr vp, bf16x8 pa0, bf16x8 pa1, bf16x8 pa2, bf16x8 pa3) {
#pragma unroll
    for (int d0 = 0; d0 < 2; ++d0) {
        s16x4 lo[4], hi[4];
#pragma unroll
        for (int ks = 0; ks < 4; ++ks) { lo[ks] = vtr(vp + d0 * 4096 + ks * 1024); hi[ks] = vtr(vp + d0 * 4096 + ks * 1024 + 512); }
#define MIX_PK(k) (bf16x8){lo[k][0], lo[k][1], lo[k][2], lo[k][3], hi[k][0], hi[k][1], hi[k][2], hi[k][3]}
        o[d0] = __builtin_amdgcn_mfma_f32_32x32x16_bf16(pa0, MIX_PK(0), o[d0], 0, 0, 0);
        o[d0] = __builtin_amdgcn_mfma_f32_32x32x16_bf16(pa1, MIX_PK(1), o[d0], 0, 0, 0);
        o[d0] = __builtin_amdgcn_mfma_f32_32x32x16_bf16(pa2, MIX_PK(2), o[d0], 0, 0, 0);
        o[d0] = __builtin_amdgcn_mfma_f32_32x32x16_bf16(pa3, MIX_PK(3), o[d0], 0, 0, 0);
#undef MIX_PK
    }
}

__device__ __forceinline__ void attn_unit(int b, int kvh, int qb, const bf16_t* PB, bf16_t* Y, const float* sink_l, float sb2, LAS unsigned char* shm) {
    int tid = threadIdx.x; asm volatile("" : "+v"(tid));
    const int lane = tid & 63, r32 = lane & 31, hi = lane >> 5; const int wid = __builtin_amdgcn_readfirstlane(tid >> 6);
    const int g = wid >> 1, jj = wid & 1, h = kvh * 4 + g;
    const long rowbase = (long)b * SEQ; const int q0 = qb * 128, kb0 = q0 - 128;
    const int t_lo = (qb == 0) ? 2 : 0, t_hi = (qb == SEQ / 128 - 1) ? 3 : 5;
    const unsigned lds0 = (unsigned)(uintptr_t)shm;
    const bf16_t* Kh = PB + rowbase * DIN + OFF_K + kvh * 64; const bf16_t* Vh = PB + rowbase * DIN + OFF_V + kvh * 64;
    for (int t = t_lo; t <= t_hi; ++t) {
        const long kr = kb0 + 64 * t;
        glds16(Kh + (kr + lane) * DIN + wid * 8, (unsigned)__builtin_amdgcn_readfirstlane(lds0 + L_K + t * SLOTB + wid * 1024));
        glds16(Vh + (kr + 16 * (wid & 3) + (lane >> 2)) * DIN + (wid >> 2) * 32 + (lane & 3) * 8, (unsigned)__builtin_amdgcn_readfirstlane(lds0 + L_V + t * SLOTB + wid * 1024));
    }
    const float slope2 = __builtin_amdgcn_exp2f(-(float)(h + 1)) * LOG2E;
    const float snk = __builtin_amdgcn_exp2f(sink_l[h] * LOG2E - sb2);
    LAS float* wsf = (LAS float*)(shm + L_WS) + wid * 64;
    const lds_cptr shm3 = (lds_cptr)shm;
    const lds_cptr vp0 = shm3 + L_V + ((lane >> 4) & 1) * 32 + (lane & 3) * 8 + (4 * hi + ((lane & 15) >> 2)) * 64;
    f32x16 cinit;
#pragma unroll
    for (int r = 0; r < 16; ++r) cinit[r] = -sb2;
    asm volatile("s_waitcnt vmcnt(0)" ::: "memory");
    __syncthreads();
    for (int i = 0; i < 2; ++i) {
        const int R0 = q0 + 64 * jj + 32 * i;
        const bf16_t* Qw = PB + (rowbase + R0 + r32) * DIN + OFF_Q + h * 64 + hi * 8;
        bf16x8 qr[4];
#pragma unroll
        for (int d0 = 0; d0 < 4; ++d0) qr[d0] = *(const bf16x8*)(Qw + d0 * 16);
        u32x4 gav[4];
#pragma unroll
        for (int it = 0; it < 4; ++it) gav[it] = *(const u32x4*)(PB + (rowbase + R0 + it * 8 + (lane >> 3)) * DIN + OFF_GA + h * 64 + (lane & 7) * 8);
        f32x16 o[2]; o[0] = f32x16{}; o[1] = f32x16{};
        float lsum = 0.f;
        const int ta = jj > t_lo ? jj : t_lo, tb = (jj + 4) < t_hi ? (jj + 4) : t_hi;
        for (int t = ta; t <= tb; ++t) {
            f32x16 p0, p1;
            qkt(p0, p1, shm3 + L_K + t * SLOTB, qr, cinit, r32, hi);
            const float Lf = (float)(kb0 + 64 * t + 4 * hi - (R0 + r32));
            const bool edge = (t == jj) || (t == jj + 4);
#pragma unroll
            for (int r = 0; r < 16; ++r) {
                const float c = (float)((r & 3) + 8 * (r >> 2));
                const float x0 = __builtin_fabsf(Lf + c), x1 = __builtin_fabsf(Lf + (c + 32.f));
                float a0 = p0[r] - slope2 * x0, a1 = p1[r] - slope2 * x1;
                if (edge) { a0 = (x0 > 128.f) ? -INFINITY : a0; a1 = (x1 > 128.f) ? -INFINITY : a1; }
                p0[r] = __builtin_amdgcn_exp2f(a0); p1[r] = __builtin_amdgcn_exp2f(a1);
            }
            float sacc = 0.f;
#pragma unroll
            for (int r = 0; r < 16; ++r) sacc += p0[r] + p1[r];
            lsum += sacc;
            u32x4 pw0, pw1, pw2, pw3;
            pw0 = (u32x4){cvtpk(p0[0], p0[1]), cvtpk(p0[2], p0[3]), cvtpk(p0[4], p0[5]), cvtpk(p0[6], p0[7])};
            pw1 = (u32x4){cvtpk(p0[8], p0[9]), cvtpk(p0[10], p0[11]), cvtpk(p0[12], p0[13]), cvtpk(p0[14], p0[15])};
            pw2 = (u32x4){cvtpk(p1[0], p1[1]), cvtpk(p1[2], p1[3]), cvtpk(p1[4], p1[5]), cvtpk(p1[6], p1[7])};
            pw3 = (u32x4){cvtpk(p1[8], p1[9]), cvtpk(p1[10], p1[11]), cvtpk(p1[12], p1[13]), cvtpk(p1[14], p1[15])};
            pv(o, vp0 + t * SLOTB, __builtin_bit_cast(bf16x8, pw0), __builtin_bit_cast(bf16x8, pw1), __builtin_bit_cast(bf16x8, pw2), __builtin_bit_cast(bf16x8, pw3));
        }
        lsum += __shfl_xor(lsum, 32);
        const float rl = __builtin_amdgcn_rcpf(lsum + snk);
        if (hi == 0) wsf[r32] = rl;
        asm volatile("s_waitcnt lgkmcnt(0)" ::: "memory");
        LAS bf16_t* stg = (LAS bf16_t*)(shm + L_OST) + wid * 2048;
#pragma unroll
        for (int r = 0; r < 16; ++r) { const int orow = crow(r, hi); const float rr = wsf[orow];
#pragma unroll
            for (int d0 = 0; d0 < 2; ++d0) stg[orow * 64 + d0 * 32 + r32] = (bf16_t)f2bf(o[d0][r] * rr); }
        asm volatile("s_waitcnt lgkmcnt(0)" ::: "memory");
#pragma unroll
        for (int it = 0; it < 4; ++it) {
            const int row = it * 8 + (lane >> 3), ch = lane & 7;
            const u32x4 ov = *(const LAS u32x4*)(stg + row * 64 + ch * 8);
            const u32x4 gv = gav[it];
            u32x4 w;
#pragma unroll
            for (int e = 0; e < 4; ++e) w[e] = cvtpk(bflo(ov[e]) * bflo(gv[e]), bfhi(ov[e]) * bfhi(gv[e]));
            *(u32x4*)(Y + (rowbase + R0 + row) * DM + h * 64 + ch * 8) = w;
        }
        asm volatile("s_waitcnt lgkmcnt(0)" ::: "memory");
    }
    __syncthreads();
}

__device__ __forceinline__ void gmlp_half(int item, const bf16_t* PB, bf16_t* Y, const bf16_t* Wsb, const float* bs_l, LAS unsigned char* shw  ) {
    int tid = threadIdx.x; asm volatile("" : "+v"(tid));
    const int lane = tid & 63, r32 = lane & 31, hi = lane >> 5;
    const int th = item & 1, g = (item >> 1) & 7, ch = item >> 4;
    const long row0 = (long)ch * 128;
    const unsigned ldsw = (unsigned)(uintptr_t)shw;
    u32x4 uv[8], gv[8];
    const bf16_t* pe = PB + (row0 + 64 * th + (lane >> 3)) * DIN + g * 64 + (lane & 7) * 8;
#pragma unroll
    for (int it = 0; it < 8; ++it) { uv[it] = *(const u32x4*)(pe + (size_t)it * 8 * DIN + OFF_U); gv[it] = *(const u32x4*)(pe + (size_t)it * 8 * DIN + OFF_GG); }
#pragma unroll
    for (int pc = 0; pc < 16; ++pc) { const int tt = pc >> 3, pw = pc & 7;
        glds16(PB + (row0 + 64 * tt + 16 * (pw & 3) + (lane >> 2)) * DIN + OFF_VG + g * 64 + (pw >> 2) * 32 + (lane & 3) * 8, (unsigned)__builtin_amdgcn_readfirstlane(ldsw + tt * 8192 + pw * 1024)); }
    float bsv[2][16];
#pragma unroll
    for (int tb = 0; tb < 2; ++tb)
#pragma unroll
        for (int r = 0; r < 16; ++r) bsv[tb][r] = bs_l[g * 128 + 64 * th + 32 * tb + crow(r, hi)];
    asm volatile("s_waitcnt vmcnt(0)" ::: "memory");
    const lds_cptr vp0 = (lds_cptr)shw + ((lane >> 4) & 1) * 32 + (lane & 3) * 8 + (4 * hi + ((lane & 15) >> 2)) * 64;
    f32x16 o[2][2];
#pragma unroll
    for (int tb = 0; tb < 2; ++tb) {
        const int tloc = 64 * th + 32 * tb;
        o[tb][0] = f32x16{}; o[tb][1] = f32x16{};
        const bf16_t* wrow = Wsb + ((size_t)g * 128 + tloc + r32) * 128 + 4 * hi;
#pragma unroll
        for (int ks = 0; ks < 8; ++ks) {
            const u32x2 wl = *(const u32x2*)(wrow + 16 * ks), wh = *(const u32x2*)(wrow + 16 * ks + 8);
            const u32x4 wa = (u32x4){wl.x, wl.y, wh.x, wh.y};
            const bf16x8 A = __builtin_bit_cast(bf16x8, wa);
#pragma unroll
            for (int d0 = 0; d0 < 2; ++d0) {
                const s16x4 lo = vtr(vp0 + (ks >> 2) * 8192 + d0 * 4096 + (ks & 3) * 1024), hh = vtr(vp0 + (ks >> 2) * 8192 + d0 * 4096 + (ks & 3) * 1024 + 512);
                const bf16x8 B = (bf16x8){lo[0], lo[1], lo[2], lo[3], hh[0], hh[1], hh[2], hh[3]};
                o[tb][d0] = __builtin_amdgcn_mfma_f32_32x32x16_bf16(A, B, o[tb][d0], 0, 0, 0);
            }
        }
    }
    asm volatile("s_waitcnt lgkmcnt(0)" ::: "memory");
    LAS float* sv = (LAS float*)shw;
#pragma unroll
    for (int tb = 0; tb < 2; ++tb)
#pragma unroll
        for (int r = 0; r < 16; ++r)
#pragma unroll
            for (int d0 = 0; d0 < 2; ++d0) sv[(32 * tb + crow(r, hi)) * 64 + 32 * d0 + r32] = o[tb][d0][r] + bsv[tb][r];
    asm volatile("s_waitcnt lgkmcnt(0)" ::: "memory");
    bf16_t* ye = Y + (row0 + 64 * th + (lane >> 3)) * DM + 512 + g * 64 + (lane & 7) * 8;
#pragma unroll
    for (int it = 0; it < 8; ++it) {
        const LAS float* sp = sv + (it * 8 + (lane >> 3)) * 64 + (lane & 7) * 8;
        const f32x4 s0 = *(const LAS f32x4*)sp, s1 = *(const LAS f32x4*)(sp + 4);
        u32x4 w;
        w.x = cvtpk(s0[0] * bflo(uv[it].x) * bflo(gv[it].x), s0[1] * bfhi(uv[it].x) * bfhi(gv[it].x));
        w.y = cvtpk(s0[2] * bflo(uv[it].y) * bflo(gv[it].y), s0[3] * bfhi(uv[it].y) * bfhi(gv[it].y));
        w.z = cvtpk(s1[0] * bflo(uv[it].z) * bflo(gv[it].z), s1[1] * bfhi(uv[it].z) * bfhi(gv[it].z));
        w.w = cvtpk(s1[2] * bflo(uv[it].w) * bflo(gv[it].w), s1[3] * bfhi(uv[it].w) * bfhi(gv[it].w));
        *(u32x4*)(ye + (size_t)it * 8 * DM) = w;
    }
    asm volatile("s_waitcnt lgkmcnt(0)" ::: "memory");
}
}

constexpr int NWAVES = 8;
constexpr size_t MiB = 1u << 20;
constexpr size_t WS_CTL = 0, CTL_ZERO_BYTES = 64 * 1024;
constexpr size_t WS_ADA = 1 * MiB;
constexpr size_t WS_GS = 1 * MiB + 64 * 1024;
constexpr size_t WS_BIAS = 1 * MiB + 128 * 1024;
constexpr size_t WS_SSQ = 1 * MiB + 256 * 1024;
constexpr size_t WS_WIN = 2 * MiB;
constexpr size_t WS_WOUT = 14 * MiB;
constexpr size_t WS_WS = 18 * MiB;
constexpr size_t WS_XS = 20 * MiB;
constexpr size_t WS_Y = 52 * MiB;
constexpr size_t WS_PB = 84 * MiB;
constexpr size_t WS_END = 176 * MiB;
static_assert(WS_PB + (size_t)M * DIN * 2 <= WS_END, "ws map");
constexpr int CW_BAR = 1024;

constexpr int RING_BYTES = 136 * 1024;
constexpr int MISC_OFF = RING_BYTES;
constexpr int LDS_BYTES = 144 * 1024;
static_assert(mix::L_END <= RING_BYTES && pg8::STAGE_BYTES <= RING_BYTES && 8 * 16384 <= RING_BYTES, "LDS map");

#define XB_TMO      128
#define XB_XCNT(j)  (256  + 64 * (j))
#define XB_XSUB(j)  (1280 + 64 * (j))
#define XB_XGEN(j)  (2304 + 64 * (j))
#define XB_TOP      3328
#define XB_TOPGEN   3392
#define XCD_BAR_WORDS 3456
#define XB_SPIN_CAP (1u << 18)
static_assert((CW_BAR + XCD_BAR_WORDS) * 4 <= (int)CTL_ZERO_BYTES, "barrier words inside the memset region");

__device__ __forceinline__ unsigned xb_ld(unsigned* p)              { return __hip_atomic_load(p, __ATOMIC_RELAXED, __HIP_MEMORY_SCOPE_AGENT); }
__device__ __forceinline__ unsigned xb_add(unsigned* p, unsigned v) { return __hip_atomic_fetch_add(p, v, __ATOMIC_RELAXED, __HIP_MEMORY_SCOPE_AGENT); }
__device__ __forceinline__ unsigned xb_xcc_id() { return (unsigned)__builtin_amdgcn_s_getreg((3 << 11) | 20) & 0xFu; }
#define XB_SPIN(cond, bar) do { unsigned _sp = 0; while (cond) { __builtin_amdgcn_s_sleep(1); \
    if ((++_sp & 255u) == 0u) { if (xb_ld(&(bar)[XB_TMO])) break; if (_sp > XB_SPIN_CAP) { atomicAdd(&(bar)[XB_TMO], 1u); break; } } } } while (0)

struct XcdBarrier { unsigned* bar; unsigned x; volatile LAS unsigned* st; };
__device__ __forceinline__ XcdBarrier xcd_barrier_post(unsigned* bar, volatile LAS unsigned* st) {
    XcdBarrier b; b.bar = bar; b.x = xb_xcc_id(); b.st = st;
    if (threadIdx.x == 0) (void)xb_add(&bar[XB_XCNT(b.x)], 1u);
    return b;
}
__device__ __forceinline__ void xcd_barrier_complete(unsigned* bar, unsigned x, unsigned& nloc, unsigned& nx) {
    const unsigned G = gridDim.x * gridDim.y * gridDim.z;
    unsigned sum, cnt, mine, sp = 0u;
    for (;;) {
        sum = 0u; cnt = 0u; mine = 0u;
#pragma unroll
        for (unsigned j = 0; j < 16; ++j) { const unsigned c = xb_ld(&bar[XB_XCNT(j)]); sum += c; cnt += (c > 0u) ? 1u : 0u; mine = (j == x) ? c : mine; }
        if (sum == G) break;
        __builtin_amdgcn_s_sleep(1);
        if ((++sp & 255u) == 0u) { if (xb_ld(&bar[XB_TMO])) break; if (sp > XB_SPIN_CAP) { atomicAdd(&bar[XB_TMO], 1u); break; } }
    }
    nloc = mine > 0u ? mine : 1u; nx = cnt > 0u ? cnt : 1u;
}
__device__ __forceinline__ void xcd_barrier(const XcdBarrier& b) {
    asm volatile("s_waitcnt vmcnt(0)" ::: "memory");
    __syncthreads();
    if (threadIdx.x == 0) {
        unsigned* bar = b.bar;
        __builtin_amdgcn_s_waitcnt(0);
        unsigned nloc = b.st[0], nx = b.st[1];
        if (nloc == 0u) { xcd_barrier_complete(bar, b.x, nloc, nx); b.st[0] = nloc; b.st[1] = nx; }
        const unsigned old = xb_add(&bar[XB_XSUB(b.x)], 1u);
        const unsigned gen = old / nloc;
        if (old + 1u == (gen + 1u) * nloc) {
            __builtin_amdgcn_fence(__ATOMIC_RELEASE, "agent");
            asm volatile("s_waitcnt vmcnt(0)" ::: "memory");
            const unsigned og = xb_add(&bar[XB_TOP], 1u);
            const unsigned tg = og / nx;
            if (og + 1u == (tg + 1u) * nx) xb_add(&bar[XB_TOPGEN], 1u);
            else XB_SPIN(xb_ld(&bar[XB_TOPGEN]) == tg, bar);
            __builtin_amdgcn_fence(__ATOMIC_ACQUIRE, "agent");
            xb_add(&bar[XB_XGEN(b.x)], 1u);
            asm volatile("s_waitcnt vmcnt(0)" ::: "memory");
        } else {
            XB_SPIN(xb_ld(&bar[XB_XGEN(b.x)]) == gen, bar);
            __builtin_amdgcn_fence(__ATOMIC_ACQUIRE, "agent");
            asm volatile("s_waitcnt vmcnt(0)" ::: "memory");
        }
    }
    __syncthreads();
}

struct Args { const float* in[12]; float* out; unsigned char* ws; int ph_lo, ph_hi; };
static_assert(sizeof(Args) == 14 * 8 + 8, "Args has no padding");

__device__ __forceinline__ void transpose_item(const float* W, int K, int N, bf16_t* WT, LAS float* scr, int item, int lane) {
    const int nblk = N / 32, kb = item / nblk, nb = item % nblk, k0 = 64 * kb, n0 = 32 * nb;
#pragma unroll
    for (int i = 0; i < 32; ++i) { const int kk = 2 * i + (lane >> 5); scr[kk * 33 + (lane & 31)] = W[(size_t)(k0 + kk) * N + n0 + (lane & 31)]; }
    asm volatile("s_waitcnt lgkmcnt(0)" ::: "memory");
    const int c = lane & 7;
#pragma unroll
    for (int j = 0; j < 4; ++j) { const int n = (lane >> 3) + 8 * j; const LAS float* s = scr + (8 * c) * 33 + n;
        u32x4 o; o.x = pk2(s[0 * 33], s[1 * 33]); o.y = pk2(s[2 * 33], s[3 * 33]); o.z = pk2(s[4 * 33], s[5 * 33]); o.w = pk2(s[6 * 33], s[7 * 33]);
        *(u32x4*)(WT + (size_t)(n0 + n) * K + k0 + 8 * c) = o; }
    asm volatile("s_waitcnt lgkmcnt(0)" ::: "memory");
}

template <bool SILU>
__device__ __forceinline__ void gemv32(const float* W, int N, int n0, const float* vec  , int vstride, const float* addb, float* out  , int ostride, LAS float* red  ) {
    const int tid = threadIdx.x, lane = tid & 63, w = tid >> 6, cg = lane & 7, rg = lane >> 3;
    f32x4 a0 = {0.f, 0.f, 0.f, 0.f}, a1 = {0.f, 0.f, 0.f, 0.f};
#pragma unroll
    for (int it = 0; it < 16; ++it) {
        const int k = 128 * w + 8 * it + rg;
        const f32x4 wv = *(const f32x4*)(W + (size_t)k * N + n0 + 4 * cg);
        float s0 = vec[k], s1 = vec[vstride + k];
        if (SILU) { s0 = fsilu(s0); s1 = fsilu(s1); }
        a0 += wv * s0; a1 += wv * s1;
    }
#pragma unroll
    for (int e = 0; e < 4; ++e) {
        a0[e] += __shfl_xor(a0[e], 8); a0[e] += __shfl_xor(a0[e], 16); a0[e] += __shfl_xor(a0[e], 32);
        a1[e] += __shfl_xor(a1[e], 8); a1[e] += __shfl_xor(a1[e], 16); a1[e] += __shfl_xor(a1[e], 32);
    }
    if (rg == 0) {
#pragma unroll
        for (int e = 0; e < 4; ++e) { red[(w * 2 + 0) * 32 + 4 * cg + e] = a0[e]; red[(w * 2 + 1) * 32 + 4 * cg + e] = a1[e]; }
    }
    __syncthreads();
    if (tid < 64) { const int bb = tid >> 5, col = tid & 31; float s = addb ? addb[n0 + col] : 0.f;
#pragma unroll
        for (int ww = 0; ww < 8; ++ww) s += red[(ww * 2 + bb) * 32 + col];
        out[bb * ostride + n0 + col] = s; }
    __syncthreads();
}

__global__ void __launch_bounds__(NWAVES * 64, 2) mk_fwd(Args args) {
    __shared__ __attribute__((aligned(16))) unsigned char lds_raw[LDS_BYTES];
    LAS unsigned char* lds = (LAS unsigned char*)lds_raw;
    volatile LAS unsigned* MISC = (volatile LAS unsigned*)(lds + MISC_OFF);
    const int tid = threadIdx.x, lane = tid & 63, wave = __builtin_amdgcn_readfirstlane(tid >> 6);
    const int G = gridDim.x; const int bx = blockIdx.x; const int vcu = (G % 8 == 0) ? (bx % 8) * (G / 8) + bx / 8 : bx;
    unsigned char* ws = args.ws;
    const float* x = args.in[0]; const float* cvec = args.in[1]; const float* w_ada = args.in[2]; const float* b_ada = args.in[3]; const float* norm_gain = args.in[4]; const float* w_in = args.in[5];
    const float* q_gain = args.in[6]; const float* k_gain = args.in[7]; const float* sink = args.in[8]; const float* w_s = args.in[9]; const float* b_s = args.in[10]; const float* w_out = args.in[11];
    float* out = args.out;
    float* ADA = (float*)(ws + WS_ADA); float* GS = (float*)(ws + WS_GS); float* BIAS = (float*)(ws + WS_BIAS); float* SSQ = (float*)(ws + WS_SSQ);
    bf16_t* WIN = (bf16_t*)(ws + WS_WIN); bf16_t* WOUT = (bf16_t*)(ws + WS_WOUT); bf16_t* WSB = (bf16_t*)(ws + WS_WS);
    bf16_t* XS = (bf16_t*)(ws + WS_XS); bf16_t* Y = (bf16_t*)(ws + WS_Y); bf16_t* PB = (bf16_t*)(ws + WS_PB);
    if (tid < 64) MISC[tid] = 0u;
    __syncthreads();
    const int lo = args.ph_lo, hi = args.ph_hi;
    XcdBarrier bar; bar.bar = (unsigned*)(ws + WS_CTL) + CW_BAR; bar.x = 0; bar.st = MISC + 8;
    if (hi - lo > 1) bar = xcd_barrier_post((unsigned*)(ws + WS_CTL) + CW_BAR, MISC + 8);
#define IN(k) (lo <= (k) && (k) < hi)
#define SEAM(k) do { if ((k) + 1 < hi) xcd_barrier(bar); } while (0)
#define REPS(k) (((k) == PROBE_REP) ? 2 : 1)
    const int gw = vcu * NWAVES + wave, NGW = G * NWAVES;

    if (((PH_MASK >> 0) & 1) && IN(0)) {
      for (int rep_ = 0; rep_ < REPS(0); ++rep_) {
        if (vcu < 192) { const int l = vcu / 96, cb = vcu % 96;
            gemv32<true>(w_ada + (size_t)l * DM * 3 * DM, 3 * DM, 32 * cb, cvec, DM, b_ada + l * 3 * DM, ADA + l * 2 * 3 * DM, 3 * DM, (LAS float*)lds); }
        LAS float* scr = (LAS float*)(lds + wave * 16384);
        constexpr int I_IN = (DM / 64) * (DIN / 32), I_OUT = (DM / 64) * (DM / 32), NIT = NL * (I_IN + I_OUT);
        for (int it = gw; it < NIT; it += NGW) {
            int r = it; const int l = r / (I_IN + I_OUT); r -= l * (I_IN + I_OUT);
            if (r < I_IN) transpose_item(w_in + (size_t)l * DM * DIN, DM, DIN, WIN + (size_t)l * DIN * DM, scr, r, lane);
            else transpose_item(w_out + (size_t)l * DM * DM, DM, DM, WOUT + (size_t)l * DM * DM, scr, r - I_IN, lane);
        }
        for (int it = gw; it < NL * 8 * 128 * 128 / 512; it += NGW) {
            const float* s = w_s + (size_t)it * 512 + lane * 8; const f32x4 a = *(const f32x4*)s, b2 = *(const f32x4*)(s + 4);
            u32x4 o; o.x = pk2(a[0], a[1]); o.y = pk2(a[2], a[3]); o.z = pk2(b2[0], b2[1]); o.w = pk2(b2[2], b2[3]);
            *(u32x4*)(WSB + (size_t)it * 512 + lane * 8) = o; }
      }
        SEAM(0);
    }
    if (((PH_MASK >> 1) & 1) && IN(1)) {
      for (int rep_ = 0; rep_ < REPS(1); ++rep_) {
        if (vcu < 176) { const int l = vcu / 88, nb = vcu % 88;
            gemv32<false>(w_in + (size_t)l * DM * DIN, DIN, 32 * nb, ADA + l * 2 * 3 * DM  , 3 * DM, nullptr, BIAS + l * 2 * DIN, DIN, (LAS float*)lds); }
        else if (vcu == 200) { for (int i = tid; i < NL * 2 * DM; i += NWAVES * 64) { const int l = i / (2 * DM), b = (i / DM) & 1, k = i % DM; GS[i] = norm_gain[l * DM + k] * (1.f + ADA[(l * 2 + b) * 3 * DM + DM + k]); } }
        {
            const int r0 = gw * (M / NGW), b = r0 / SEQ;
            f32x4 gsv[4];
#pragma unroll
            for (int j = 0; j < 4; ++j) { const int k = 256 * j + 4 * lane; const f32x4 gn = *(const f32x4*)(norm_gain + k), sc = *(const f32x4*)(ADA + b * 3 * DM + DM + k); gsv[j] = gn * (1.f + sc); }
            for (int rr = 0; rr < M / NGW; rr += 2) {
                const int m = r0 + rr;
                const f32x4* xr = (const f32x4*)(x + (size_t)m * DM) + lane;
                f32x4 v[2][4]; float sq[2] = {0.f, 0.f};
#pragma unroll
                for (int q = 0; q < 2; ++q)
#pragma unroll
                    for (int j = 0; j < 4; ++j) v[q][j] = xr[q * (DM / 4) + 64 * j];
#pragma unroll
                for (int q = 0; q < 2; ++q) {
#pragma unroll
                    for (int j = 0; j < 4; ++j) sq[q] += (v[q][j][0] * v[q][j][0] + v[q][j][1] * v[q][j][1]) + (v[q][j][2] * v[q][j][2] + v[q][j][3] * v[q][j][3]);
                    sq[q] = wave_sum(sq[q]);
                    u32x2* o8 = (u32x2*)(XS + (size_t)(m + q) * DM) + lane;
#pragma unroll
                    for (int j = 0; j < 4; ++j) { const f32x4 t = v[q][j] * gsv[j]; u32x2 w; w.x = cvtpk(t[0], t[1]); w.y = cvtpk(t[2], t[3]); o8[64 * j] = w; }
                    if (lane == 0) *(f32x4*)(SSQ + (size_t)(m + q) * 4) = (f32x4){sq[q], 0.f, 0.f, 0.f};
                }
            }
        }
      }
        for (int xb_ = 0; xb_ < PROBE_BAR; ++xb_) SEAM(1);
        SEAM(1);
    }
    for (int l = 0; l < NL; ++l) {
        const int p0 = 2 + 3 * l;
        if (((PH_MASK >> 2) & 1) && IN(p0)) {
            pg8::Gemm g{XS, WIN + (size_t)l * DIN * DM, M, DIN, DM}; pg8::StaticOrder S; S.init(M, DIN, G, bx);
            pg8::EpiProj E{PB, SSQ, BIAS + l * 2 * DIN, q_gain + l * 64, k_gain + l * 64};
            for (int rep_ = 0; rep_ < REPS(p0); ++rep_) pg8::gemm_phase<pg8::EpiProj, true>(lds, g, S, E);
            SEAM(p0);
        }
        if (((PH_MASK >> 3) & 3) && IN(p0 + 1)) {
            float aq = 0.f, ak = 0.f;
            { const float qv = __builtin_fabsf(q_gain[l * 64 + lane]), kv = __builtin_fabsf(k_gain[l * 64 + lane]); aq = qv; ak = kv;
#pragma unroll
              for (int o = 1; o < 64; o <<= 1) { aq = fmaxf(aq, __shfl_xor(aq, o)); ak = fmaxf(ak, __shfl_xor(ak, o)); } }
            const float sb2 = 8.f * aq * ak * LOG2E;
          for (int rep_ = 0; rep_ < REPS(p0 + 1); ++rep_) {
            if ((PH_MASK >> 3) & 1) for (int uidx = vcu; uidx < 256; uidx += G) mix::attn_unit(uidx >> 7, (uidx >> 6) & 1, uidx & 63, PB, Y, sink + l * 8, sb2, lds);
            if ((PH_MASK >> 4) & 1) for (int it = gw; it < 2048; it += NGW) mix::gmlp_half(it, PB, Y, WSB + (size_t)l * 8 * 128 * 128, b_s + l * 8 * 128, lds + wave * 16384);
            if (REPS(p0 + 1) > 1) __syncthreads();
          }
            SEAM(p0 + 1);
        }
        if (((PH_MASK >> 5) & 1) && IN(p0 + 2)) {
            pg8::Gemm g{Y, WOUT + (size_t)l * DM * DM, M, DM, DM}; pg8::StaticOrder S; S.init(M, DM, G, bx);
            const bool lastl = (l == NL - 1);
            pg8::EpiOut E{l == 0 ? x : out, out, ADA + l * 2 * 3 * DM, lastl ? nullptr : XS, GS + (lastl ? 0 : (l + 1) * 2 * DM), SSQ};
            for (int rep_ = 0; rep_ < REPS(p0 + 2); ++rep_) pg8::gemm_phase<pg8::EpiOut, false>(lds, g, S, E);
            SEAM(p0 + 2);
        }
    }
#undef IN
#undef SEAM
}

extern "C" void kernel_launch(void* const* d_in, const int* in_sizes, int n_in, void* d_out, int out_size, void* d_ws, size_t ws_size, hipStream_t stream) {
    static int grid = 0;
    if (grid == 0) {
        if (n_in != 12 || in_sizes[0] != M * DM || out_size != M * DM || ws_size < WS_END) { fprintf(stderr, "kernel_launch: unexpected shapes (n_in %d, in0 %d, out %d, ws %zu)\n", n_in, n_in > 0 ? in_sizes[0] : -1, out_size, ws_size); grid = -1; return; }
        int dev = 0, cus = 0, per_cu = 0;
        if (hipGetDevice(&dev) != hipSuccess || hipDeviceGetAttribute(&cus, hipDeviceAttributeMultiprocessorCount, dev) != hipSuccess) { grid = -1; return; }
        if (hipOccupancyMaxActiveBlocksPerMultiprocessor(&per_cu, (const void*)mk_fwd, NWAVES * 64, 0) != hipSuccess || per_cu < 1) { fprintf(stderr, "kernel_launch: occupancy query says %d\n", per_cu); per_cu = 1; }
        (void)hipGetLastError();
        grid = cus;
    }
    if (grid < 0) return;
    (void)hipMemsetAsync((char*)d_ws + WS_CTL, 0, CTL_ZERO_BYTES, stream);
    Args a{};
    for (int i = 0; i < 12; ++i) a.in[i] = (const float*)d_in[i];
    a.out = (float*)d_out; a.ws = (unsigned char*)d_ws;
#if MK_PER_PHASE
    for (int p = 0; p < 8; ++p) { a.ph_lo = p; a.ph_hi = p + 1; hipLaunchKernelGGL(mk_fwd, dim3(grid), dim3(NWAVES * 64), 0, stream, a); }
#else
    a.ph_lo = 0; a.ph_hi = 8;
    hipLaunchKernelGGL(mk_fwd, dim3(grid), dim3(NWAVES * 64), 0, stream, a);
#endif
}
```

```cpp
#include <hip/hip_runtime.h>
#include <cstdio>
#include <cstdint>

#ifndef PH_MASK
#define PH_MASK 0xff
#endif
#ifndef PROBE_REP
#define PROBE_REP -1
#endif
#ifndef PROBE_BAR
#define PROBE_BAR 0
#endif
#ifndef PROBE_PASSES
#define PROBE_PASSES 1
#endif
#ifndef MK_PER_PHASE
#define MK_PER_PHASE 0
#endif

constexpr int NB = 2, SEQ = 8192, DM = 1024, M = NB * SEQ, DIN = 2816, NL = 2;
constexpr int OFF_Q = 0, OFF_K = 512, OFF_V = 640, OFF_GA = 768, OFF_U = 1280, OFF_VG = 1792, OFF_GG = 2304;
constexpr float EPS = 1e-6f;
constexpr float LOG2E = 1.4426950408889634f;
constexpr float C2 = 0.125f * LOG2E;

#define LAS __attribute__((address_space(3)))
#define GAS __attribute__((address_space(1)))
typedef unsigned short bf16_t;
typedef short bf16x8 __attribute__((ext_vector_type(8)));
typedef short s16x4 __attribute__((ext_vector_type(4)));
typedef float f32x4 __attribute__((ext_vector_type(4)));
typedef float f32x16 __attribute__((ext_vector_type(16)));
typedef unsigned u32x4 __attribute__((ext_vector_type(4)));
typedef unsigned u32x2 __attribute__((ext_vector_type(2)));
typedef GAS unsigned gu32;

__device__ __forceinline__ unsigned f2bf(float f) { unsigned u = __builtin_bit_cast(unsigned, f); return (u + 0x7fffu + ((u >> 16) & 1u)) >> 16; }
__device__ __forceinline__ unsigned pk2(float lo, float hi) { return f2bf(lo) | (f2bf(hi) << 16); }
__device__ __forceinline__ float bf2f(unsigned short h) { return __builtin_bit_cast(float, (unsigned)h << 16); }
__device__ __forceinline__ float bflo(unsigned w) { return __builtin_bit_cast(float, w << 16); }
__device__ __forceinline__ float bfhi(unsigned w) { return __builtin_bit_cast(float, w & 0xffff0000u); }
typedef float f32x2_t __attribute__((ext_vector_type(2))); typedef __bf16 bf16x2_t __attribute__((ext_vector_type(2)));
__device__ __forceinline__ unsigned cvtpk(float lo, float hi) { f32x2_t v = {lo, hi}; bf16x2_t b = __builtin_convertvector(v, bf16x2_t); return __builtin_bit_cast(unsigned, b); }
__device__ __forceinline__ float fsilu(float v) { return v * __builtin_amdgcn_rcpf(1.f + __builtin_amdgcn_exp2f(-LOG2E * v)); }
__device__ __forceinline__ float wave_sum(float v) {
#pragma unroll
    for (int o = 1; o < 64; o <<= 1) v += __shfl_xor(v, o);
    return v;
}

namespace pg8 {
constexpr int BM = 256, BK = 64, HALF = 128, HTB = HALF * BK * 2, STAGE_BYTES = 8 * HTB, NXCD = 8, WGM = 8;
__host__ __device__ __forceinline__ int lds_byte(int r, int c) { const int st = (r >> 4) * 2 + (c >> 5), rr = r & 15, cc = c & 31, ob = rr * 64 + cc * 2; return st * 1024 + (ob ^ (((ob >> 9) & 1) << 5)); }
__host__ __device__ __forceinline__ void stage_rc(int b, int& R, int& C) { const int st = b / 1024, sb = b % 1024, swz = sb ^ (((sb >> 9) & 1) << 5); R = (st >> 1) * 16 + swz / 64; C = (st & 1) * 32 + (swz % 64) / 2; }
__host__ __device__ __forceinline__ int perm32(int rho) { const int n = rho >> 4, i = rho & 15; return 8 * (i >> 2) + 4 * n + (i & 3); }

struct Unit { int pm, pn; };
struct Gemm { const bf16_t* A; const bf16_t* Bt; int M, N, K; size_t bstride;
              const bf16_t* Ax; const bf16_t* Bx; int nxt; };

struct StaticOrder {
    int nM, nN, nwg, G, c;
    __host__ __device__ void init(int M_, int N_, int G_, int c_) { nM = M_ / BM; nN = N_ / BM; nwg = nM * nN; G = G_; c = c_; }
    __host__ __device__ bool next(int i, Unit& u) const {
        const long L = (long)i * G + c; if (L >= nwg) return false;
        int wgid = (int)L; { const int q = nwg / NXCD, r = nwg % NXCD, xcd = wgid % NXCD, off = wgid / NXCD; wgid = (xcd < r ? xcd * (q + 1) : r * (q + 1) + (xcd - r) * q) + off; }
        const int nig = WGM * nN, gid = wgid / nig, fm = gid * WGM, gsz = (nM - fm) < WGM ? (nM - fm) : WGM;
        u.pm = fm + ((wgid % nig) % gsz); u.pn = (wgid % nig) / gsz; return true;
    }
};

template <class Epi, bool ALIGN_EPI>
__device__ __forceinline__ void gemm_phase(LAS unsigned char* lds, const Gemm g, const StaticOrder& S, const Epi& E) {
    int tid = threadIdx.x; asm volatile("" : "+v"(tid));
    const int wid = __builtin_amdgcn_readfirstlane(tid >> 6), lane = tid & 63, wr = wid >> 2, wc = wid & 3, fr = lane & 15, fq = lane >> 4;
    const int K = g.K, nt = K / BK;
    unsigned voffA[2], voffB0[2], voffB1[2];
#pragma unroll
    for (int i = 0; i < 2; ++i) { int R, C; stage_rc(tid * 16 + i * 8192, R, C); const int cb = 64 * (R >> 5) + perm32(R & 31);
        voffA[i] = (unsigned)(R * K + C) * 2u; voffB0[i] = (unsigned)(cb * K + C) * 2u; voffB1[i] = (unsigned)((cb + 32) * K + C) * 2u; }
    const size_t kstep = (size_t)(BK * 2);
    const size_t hstep = (size_t)HALF * K * 2;
    const size_t tstep = 2 * hstep;
    const unsigned ldsw = (unsigned)wid * 1024u;
    const int aoff = lds_byte(wr * 64 + fr, fq * 8);
    int boffB = 4 * HTB + lds_byte(wc * 32 + fr, fq * 8); asm volatile("" : "+v"(boffB));
#define PG8_SA(b, h) (((b) * 2 + (h)) * HTB)
#define PG8_SB(b, h) ((4 + (b) * 2 + (h)) * HTB)
#define PG8_SBR(b, h) (((b) * 2 + (h)) * HTB)
#define PG8_STAGE(bufoff, gbase, voff) do { _Pragma("unroll") for (int _i = 0; _i < 2; ++_i) \
        __builtin_amdgcn_global_load_lds((const unsigned*)((const char*)(gbase) + (voff)[_i]), (LAS unsigned*)(lds + (bufoff) + ldsw + _i * 8192), 16, 0, 0); } while (0)
#define PG8_LDA(dst, b, h) do { _Pragma("unroll") for (int m = 0; m < 4; ++m) _Pragma("unroll") for (int k = 0; k < 2; ++k) dst[m][k] = *(const LAS bf16x8*)(lds + PG8_SA(b, h) + aoff + m * 2048 + k * 1024); } while (0)
#define PG8_LDB(dst, b, h) do { _Pragma("unroll") for (int n = 0; n < 2; ++n) _Pragma("unroll") for (int k = 0; k < 2; ++k) dst[n][k] = *(const LAS bf16x8*)(lds + boffB + (PG8_SBR(b, h) + n * 2048 + k * 1024)); } while (0)
#define PG8_MMA(ai, bj, At, Bt) do { __builtin_amdgcn_s_setprio(1); _Pragma("unroll") for (int m = 0; m < 4; ++m) _Pragma("unroll") for (int n = 0; n < 2; ++n) _Pragma("unroll") for (int k = 0; k < 2; ++k) \
        acc[ai][bj][m][n] = __builtin_amdgcn_mfma_f32_16x16x32_bf16(Bt[n][k], At[m][k], acc[ai][bj][m][n], 0, 0, 0); __builtin_amdgcn_s_setprio(0); } while (0)
#define PG8_WAIT_V(n) asm volatile("s_waitcnt vmcnt(" #n ")" ::: "memory")
#define PG8_WAIT_L(n) asm volatile("s_waitcnt lgkmcnt(" #n ")" ::: "memory")
#define PG8_BAR __builtin_amdgcn_s_barrier()
#define PG8_SCHED __builtin_amdgcn_sched_barrier(0)
    Unit cur, nxt; int ui = 0;
    if (!S.next(0, cur)) return;
    f32x4 acc[2][2][4][2];
#pragma unroll
    for (int a = 0; a < 2; ++a)
#pragma unroll
        for (int b = 0; b < 2; ++b)
#pragma unroll
            for (int m = 0; m < 4; ++m)
#pragma unroll
                for (int n = 0; n < 2; ++n) acc[a][b][m][n] = (f32x4){0.f, 0.f, 0.f, 0.f};
    bf16x8 At[4][2], B0[2][2], B1[2][2];
    const int ntot = nt + g.nxt;
#define PG8_UA(u_) ((const char*)g.A + (size_t)(u_).pm * tstep)
#define PG8_UB(u_) ((const char*)g.Bt + (size_t)((u_).pm >> 5) * g.bstride + (size_t)(u_).pn * tstep)
#define PG8_UX(u_) ((const char*)g.Ax + (size_t)(u_).pm * tstep + (size_t)(u_).pn * 512)
    const char* cA = PG8_UA(cur); const char* cB = PG8_UB(cur); const char* xA = PG8_UX(cur); const char* xB = (const char*)g.Bx;
    PG8_STAGE(PG8_SB(0, 0), cB, voffB0); PG8_STAGE(PG8_SB(0, 1), cB, voffB1); PG8_STAGE(PG8_SA(0, 0), cA, voffA); PG8_STAGE(PG8_SA(0, 1), cA + hstep, voffA);
    if (wr == 1) PG8_BAR;
    PG8_WAIT_V(2); PG8_BAR;
    PG8_STAGE(PG8_SB(1, 0), cB + kstep, voffB0); PG8_STAGE(PG8_SA(1, 0), cA + kstep, voffA); PG8_STAGE(PG8_SB(1, 1), cB + kstep, voffB1);
    PG8_WAIT_V(6); PG8_BAR;
    for (;;) {
        const bool has_next = S.next(ui + 1, nxt);
        const char* nA = has_next ? PG8_UA(nxt) : cA; const char* nB = has_next ? PG8_UB(nxt) : cB;
        for (int t = 0; t < ntot; t += 2) {
            const char* a1 = (t < nt ? cA + (size_t)(t + 1) * kstep : xA + (size_t)(t + 1 - nt) * kstep);
            const int t2 = t + 2;
            const char* a2 = t2 < nt ? cA + (size_t)t2 * kstep : (t2 < ntot ? xA + (size_t)(t2 - nt) * kstep : nA);
            const char* b2 = t2 < nt ? cB + (size_t)t2 * kstep : (t2 < ntot ? xB + (size_t)(t2 - nt) * kstep : nB);
            const char* a3 = a2 + kstep; const char* b3 = b2 + kstep;
            PG8_LDB(B0, 0, 0); PG8_LDB(B1, 0, 1); PG8_SCHED; PG8_LDA(At, 0, 0); PG8_STAGE(PG8_SA(1, 1), a1 + hstep, voffA);
            PG8_WAIT_V(8); PG8_WAIT_L(0); PG8_BAR; PG8_MMA(0, 0, At, B0); PG8_MMA(0, 1, At, B1); PG8_BAR; PG8_SCHED;
            PG8_LDA(At, 0, 1); PG8_STAGE(PG8_SB(0, 0), b2, voffB0); PG8_STAGE(PG8_SB(0, 1), b2, voffB1); PG8_STAGE(PG8_SA(0, 0), a2, voffA);
            PG8_WAIT_V(8); PG8_WAIT_L(0); PG8_BAR; PG8_MMA(1, 0, At, B0); PG8_MMA(1, 1, At, B1); PG8_BAR; PG8_SCHED;
            PG8_LDB(B0, 1, 0); PG8_LDB(B1, 1, 1); PG8_SCHED; PG8_LDA(At, 1, 0); PG8_STAGE(PG8_SA(0, 1), a2 + hstep, voffA);
            PG8_WAIT_V(8); PG8_WAIT_L(0); PG8_BAR; PG8_MMA(0, 0, At, B0); PG8_MMA(0, 1, At, B1); PG8_BAR; PG8_SCHED;
            PG8_LDA(At, 1, 1); PG8_STAGE(PG8_SB(1, 0), b3, voffB0); PG8_STAGE(PG8_SB(1, 1), b3, voffB1); PG8_STAGE(PG8_SA(1, 0), a3, voffA);
            PG8_WAIT_V(8); PG8_WAIT_L(0); PG8_BAR; PG8_MMA(1, 0, At, B0); PG8_MMA(1, 1, At, B1); PG8_BAR; PG8_SCHED;
        }
        if constexpr (ALIGN_EPI) { if (wr == 0) PG8_BAR; }
        if constexpr (!Epi::AFTER_DRAIN) { E(acc, cur, wr, wc, fr, fq); }
        if (!has_next) break;
#pragma unroll
        for (int a = 0; a < 2; ++a)
#pragma unroll
            for (int b = 0; b < 2; ++b)
#pragma unroll
                for (int m = 0; m < 4; ++m)
#pragma unroll
                    for (int n = 0; n < 2; ++n) acc[a][b][m][n] = (f32x4){0.f, 0.f, 0.f, 0.f};
        cur = nxt; cA = nA; cB = nB; xA = PG8_UX(cur); ++ui;
        if constexpr (ALIGN_EPI) { if (wr == 1) PG8_BAR; }
    }
    PG8_WAIT_V(0);
    if constexpr (!ALIGN_EPI) { if (wr == 0) PG8_BAR; }
    PG8_BAR;
    if constexpr (Epi::AFTER_DRAIN) { E.fused(acc, cur, wr, wc, fr, fq, lds, wid, lane); }
#undef PG8_UA
#undef PG8_UB
#undef PG8_UX
#undef PG8_SA
#undef PG8_SB
#undef PG8_SBR
#undef PG8_STAGE
#undef PG8_LDA
#undef PG8_LDB
#undef PG8_MMA
#undef PG8_WAIT_V
#undef PG8_WAIT_L
#undef PG8_BAR
#undef PG8_SCHED
}

struct EpiProj {
    static constexpr bool AFTER_DRAIN = false;
    bf16_t* PB; const float* ssq4; const float* bias; const float* qg; const float* kg;
    __device__ __forceinline__ void operator()(const f32x4 (&acc)[2][2][4][2], const Unit& u, int wr, int wc, int fr, int fq) const {
        const int b = u.pm >> 5;
        const int colw = u.pn * 256 + wc * 64 + 8 * fq;
        int type;
        if (u.pn < 2) type = 0; else if (u.pn == 2) type = (wc < 2) ? 1 : 2; else if (u.pn < 5) type = 3; else if (u.pn < 7) type = 2; else if (u.pn < 9) type = 4; else type = 3;
        const float* bp = bias + b * DIN + colw;
        f32x4 bv[2][2];
#pragma unroll
        for (int bj = 0; bj < 2; ++bj)
#pragma unroll
            for (int n = 0; n < 2; ++n) bv[bj][n] = *(const f32x4*)(bp + 32 * bj + 4 * n);
        float rstd[2][4];
        const float* sp = ssq4 + (size_t)(u.pm * 256 + wr * 64 + fr) * 4;
#pragma unroll
        for (int ai = 0; ai < 2; ++ai)
#pragma unroll
            for (int m = 0; m < 4; ++m) { const f32x4 s4 = *(const f32x4*)(sp + (size_t)(ai * 128 + m * 16) * 4); rstd[ai][m] = __builtin_amdgcn_rsqf(((s4[0] + s4[1]) + (s4[2] + s4[3])) * (1.f / DM) + EPS); }
        f32x4 gk[2][2];
        if (type == 1) {
#pragma unroll
            for (int bj = 0; bj < 2; ++bj)
#pragma unroll
                for (int n = 0; n < 2; ++n) gk[bj][n] = *(const f32x4*)(kg + 8 * fq + 32 * bj + 4 * n) * *(const f32x4*)(qg + 8 * fq + 32 * bj + 4 * n);
        }
        const float gsc = (type == 0) ? C2 : 1.f;
#pragma unroll
        for (int ai = 0; ai < 2; ++ai)
#pragma unroll
            for (int m = 0; m < 4; ++m) {
                const int row = u.pm * 256 + ai * 128 + wr * 64 + m * 16 + fr;
                f32x4 v[2][2];
#pragma unroll
                for (int bj = 0; bj < 2; ++bj)
#pragma unroll
                    for (int n = 0; n < 2; ++n) v[bj][n] = acc[ai][bj][m][n] * rstd[ai][m] + bv[bj][n];
                if (type == 0 || type == 1 || type == 4) {
                    float ss = 0.f;
#pragma unroll
                    for (int bj = 0; bj < 2; ++bj)
#pragma unroll
                        for (int n = 0; n < 2; ++n) ss += (v[bj][n][0] * v[bj][n][0] + v[bj][n][1] * v[bj][n][1]) + (v[bj][n][2] * v[bj][n][2] + v[bj][n][3] * v[bj][n][3]);
                    ss += __shfl_xor(ss, 16); ss += __shfl_xor(ss, 32);
                    const float rs = __builtin_amdgcn_rsqf(ss * (1.f / 64.f) + EPS) * gsc;
                    if (type == 1) {
#pragma unroll
                        for (int bj = 0; bj < 2; ++bj)
#pragma unroll
                            for (int n = 0; n < 2; ++n) v[bj][n] = v[bj][n] * rs * gk[bj][n];
                    } else {
#pragma unroll
                        for (int bj = 0; bj < 2; ++bj)
#pragma unroll
                            for (int n = 0; n < 2; ++n) v[bj][n] = v[bj][n] * rs;
                    }
                } else if (type == 3) {
#pragma unroll
                    for (int bj = 0; bj < 2; ++bj)
#pragma unroll
                        for (int n = 0; n < 2; ++n)
#pragma unroll
                            for (int e = 0; e < 4; ++e) v[bj][n][e] = fsilu(v[bj][n][e]);
                }
                bf16_t* rowp = PB + (size_t)row * DIN + colw;
#pragma unroll
                for (int bj = 0; bj < 2; ++bj) {
                    u32x4 w; w.x = cvtpk(v[bj][0][0], v[bj][0][1]); w.y = cvtpk(v[bj][0][2], v[bj][0][3]); w.z = cvtpk(v[bj][1][0], v[bj][1][1]); w.w = cvtpk(v[bj][1][2], v[bj][1][3]);
                    *(u32x4*)(rowp + 32 * bj) = w;
                }
            }
    }
};

struct EpiOut {
    static constexpr bool AFTER_DRAIN = true;
    bf16_t* xb; float* out; float* ssq4;
    __device__ __forceinline__ void fused(f32x4 (&acc)[2][2][4][2], const Unit& u, int wr, int wc, int fr, int fq, LAS unsigned char* lds, int wid, int lane) const {
        const int colw = u.pn * 256 + wc * 64 + 8 * fq;
        if (xb != nullptr) {
            LAS float* P = (LAS float*)lds;
#pragma unroll
            for (int ai = 0; ai < 2; ++ai)
#pragma unroll
                for (int m = 0; m < 4; ++m) {
                    const int rl = ai * 128 + wr * 64 + m * 16 + fr;
                    bf16_t* rowp = xb + (size_t)(u.pm * 256 + rl) * DM + colw;
                    float ss = 0.f;
#pragma unroll
                    for (int bj = 0; bj < 2; ++bj) {
                        const f32x4 a = acc[ai][bj][m][0], c = acc[ai][bj][m][1];
                        ss += (a[0] * a[0] + a[1] * a[1]) + (a[2] * a[2] + a[3] * a[3]) + (c[0] * c[0] + c[1] * c[1]) + (c[2] * c[2] + c[3] * c[3]);
                        u32x4 w; w.x = cvtpk(a[0], a[1]); w.y = cvtpk(a[2], a[3]); w.z = cvtpk(c[0], c[1]); w.w = cvtpk(c[2], c[3]);
                        *(u32x4*)(rowp + 32 * bj) = w;
                    }
                    ss += __shfl_xor(ss, 16); ss += __shfl_xor(ss, 32); if (fq == 0) P[rl * 4 + wc] = ss;
                }
            __syncthreads();
            if (threadIdx.x < 256) { const int rl = threadIdx.x; const float s = (P[rl * 4 + 0] + P[rl * 4 + 1]) + (P[rl * 4 + 2] + P[rl * 4 + 3]); ssq4[(size_t)(u.pm * 256 + rl) * 4 + u.pn] = s; }
            __syncthreads();
        } else {
#pragma unroll
            for (int ai = 0; ai < 2; ++ai)
#pragma unroll
                for (int m = 0; m < 4; ++m) {
                    float* rowp = out + (size_t)(u.pm * 256 + ai * 128 + wr * 64 + m * 16 + fr) * DM + colw;
#pragma unroll
                    for (int bj = 0; bj < 2; ++bj)
#pragma unroll
                        for (int n = 0; n < 2; ++n) *(f32x4*)(rowp + 32 * bj + 4 * n) = acc[ai][bj][m][n];
                }
        }
    }
};
}

namespace mix {
typedef LAS const char* lds_cptr;
constexpr int SLOTB = 8192, NSLOT = 6;
constexpr int L_K = 0, L_V = NSLOT * SLOTB, L_WS = 2 * NSLOT * SLOTB, L_OST = L_WS + 8 * 256, L_END = L_OST + 8 * 4096;
__device__ __forceinline__ int crow(int r, int hi) { return (r & 3) + 8 * (r >> 2) + 4 * hi; }
__device__ __forceinline__ void glds16(const void* gsrc, unsigned lds_dst) { unsigned keep;
    asm volatile("s_mov_b32 %0, m0\n\ts_mov_b32 m0, %2\n\ts_nop 0\n\tglobal_load_lds_dwordx4 %1, off\n\ts_mov_b32 m0, %0" : "=&s"(keep) : "v"(gsrc), "s"(lds_dst) : "memory"); }
__device__ __forceinline__ s16x4 vtr(lds_cptr p) { typedef short v4i16_t __attribute__((ext_vector_type(4))); return __builtin_bit_cast(s16x4, __builtin_amdgcn_ds_read_tr16_b64_v4i16((LAS v4i16_t*)p)); }

__device__ __forceinline__ void qkt(f32x16& p0, f32x16& p1, lds_cptr kslot, const bf16x8* qr, const f32x16& cinit, int r32, int hi) {
    lds_cptr kb = kslot + hi * 1024 + r32 * 16;
#pragma unroll
    for (int d0 = 0; d0 < 4; ++d0) {
        const bf16x8 b0 = *(const LAS bf16x8*)(kb + d0 * 2048);
        const bf16x8 b1 = *(const LAS bf16x8*)(kb + d0 * 2048 + 512);
        if (d0 == 0) { p0 = __builtin_amdgcn_mfma_f32_32x32x16_bf16(b0, qr[0], cinit, 0, 0, 0); p1 = __builtin_amdgcn_mfma_f32_32x32x16_bf16(b1, qr[0], cinit, 0, 0, 0); }
        else { p0 = __builtin_amdgcn_mfma_f32_32x32x16_bf16(b0, qr[d0], p0, 0, 0, 0); p1 = __builtin_amdgcn_mfma_f32_32x32x16_bf16(b1, qr[d0], p1, 0, 0, 0); }
    }
}
__device__ __forceinline__ void pv(f32x16* o, lds_cptr vp, bf16x8 pa0, bf16x8 pa1, bf16x8 pa2, bf16x8 pa3) {
#pragma unroll
    for (int d0 = 0; d0 < 2; ++d0) {
        s16x4 lo[4], hi[4];
#pragma unroll
        for (int ks = 0; ks < 4; ++ks) { lo[ks] = vtr(vp + d0 * 4096 + ks * 1024); hi[ks] = vtr(vp + d0 * 4096 + ks * 1024 + 512); }
#define MIX_PK(k) (bf16x8){lo[k][0], lo[k][1], lo[k][2], lo[k][3], hi[k][0], hi[k][1], hi[k][2], hi[k][3]}
        o[d0] = __builtin_amdgcn_mfma_f32_32x32x16_bf16(pa0, MIX_PK(0), o[d0], 0, 0, 0);
        o[d0] = __builtin_amdgcn_mfma_f32_32x32x16_bf16(pa1, MIX_PK(1), o[d0], 0, 0, 0);
        o[d0] = __builtin_amdgcn_mfma_f32_32x32x16_bf16(pa2, MIX_PK(2), o[d0], 0, 0, 0);
        o[d0] = __builtin_amdgcn_mfma_f32_32x32x16_bf16(pa3, MIX_PK(3), o[d0], 0, 0, 0);
#undef MIX_PK
    }
}

__device__ __forceinline__ void attn_unit(int b, int kvh, int qb, const bf16_t* PB, bf16_t* Y, const float* sink_l, float sb2, LAS unsigned char* shm) {
    int tid = threadIdx.x; asm volatile("" : "+v"(tid));
    const int lane = tid & 63, r32 = lane & 31, hi = lane >> 5; const int wid = __builtin_amdgcn_readfirstlane(tid >> 6);
    const int g = wid >> 1, jj = wid & 1, h = kvh * 4 + g;
    const long rowbase = (long)b * SEQ; const int q0 = qb * 128, kb0 = q0 - 128;
    const int t_lo = (qb == 0) ? 2 : 0, t_hi = (qb == SEQ / 128 - 1) ? 3 : 5;
    const unsigned lds0 = (unsigned)(uintptr_t)shm;
    const bf16_t* Kh = PB + rowbase * DIN + OFF_K + kvh * 64; const bf16_t* Vh = PB + rowbase * DIN + OFF_V + kvh * 64;
    for (int t = t_lo; t <= t_hi; ++t) {
        const long kr = kb0 + 64 * t;
        glds16(Kh + (kr + lane) * DIN + wid * 8, (unsigned)__builtin_amdgcn_readfirstlane(lds0 + L_K + t * SLOTB + wid * 1024));
        glds16(Vh + (kr + 16 * (wid & 3) + (lane >> 2)) * DIN + (wid >> 2) * 32 + (lane & 3) * 8, (unsigned)__builtin_amdgcn_readfirstlane(lds0 + L_V + t * SLOTB + wid * 1024));
    }
    const float slope2 = __builtin_amdgcn_exp2f(-(float)(h + 1)) * LOG2E;
    const float snk = __builtin_amdgcn_exp2f(sink_l[h] * LOG2E - sb2);
    LAS float* wsf = (LAS float*)(shm + L_WS) + wid * 64;
    const lds_cptr shm3 = (lds_cptr)shm;
    const lds_cptr vp0 = shm3 + L_V + ((lane >> 4) & 1) * 32 + (lane & 3) * 8 + (4 * hi + ((lane & 15) >> 2)) * 64;
    f32x16 cinit;
#pragma unroll
    for (int r = 0; r < 16; ++r) cinit[r] = -sb2;
    asm volatile("s_waitcnt vmcnt(0)" ::: "memory");
    __syncthreads();
    for (int i = 0; i < 2; ++i) {
        const int R0 = q0 + 64 * jj + 32 * i;
        const bf16_t* Qw = PB + (rowbase + R0 + r32) * DIN + OFF_Q + h * 64 + hi * 8;
        bf16x8 qr[4];
#pragma unroll
        for (int d0 = 0; d0 < 4; ++d0) qr[d0] = *(const bf16x8*)(Qw + d0 * 16);
        u32x4 gav[4];
#pragma unroll
        for (int it = 0; it < 4; ++it) gav[it] = *(const u32x4*)(PB + (rowbase + R0 + it * 8 + (lane >> 3)) * DIN + OFF_GA + h * 64 + (lane & 7) * 8);
        f32x16 o[2]; o[0] = f32x16{}; o[1] = f32x16{};
        float lsum = 0.f;
        const int ta = jj > t_lo ? jj : t_lo, tb = (jj + 4) < t_hi ? (jj + 4) : t_hi;
        for (int t = ta; t <= tb; ++t) {
            f32x16 p0, p1;
            qkt(p0, p1, shm3 + L_K + t * SLOTB, qr, cinit, r32, hi);
            const float Lf = (float)(kb0 + 64 * t + 4 * hi - (R0 + r32));
            const bool edge = (t == jj) || (t == jj + 4);
#pragma unroll
            for (int r = 0; r < 16; ++r) {
                const float c = (float)((r & 3) + 8 * (r >> 2));
                const float x0 = __builtin_fabsf(Lf + c), x1 = __builtin_fabsf(Lf + (c + 32.f));
                float a0 = p0[r] - slope2 * x0, a1 = p1[r] - slope2 * x1;
                if (edge) { a0 = (x0 > 128.f) ? -INFINITY : a0; a1 = (x1 > 128.f) ? -INFINITY : a1; }
                p0[r] = __builtin_amdgcn_exp2f(a0); p1[r] = __builtin_amdgcn_exp2f(a1);
            }
            float sacc = 0.f;
#pragma unroll
            for (int r = 0; r < 16; ++r) sacc += p0[r] + p1[r];
            lsum += sacc;
            u32x4 pw0, pw1, pw2, pw3;
            pw0 = (u32x4){cvtpk(p0[0], p0[1]), cvtpk(p0[2], p0[3]), cvtpk(p0[4], p0[5]), cvtpk(p0[6], p0[7])};
            pw1 = (u32x4){cvtpk(p0[8], p0[9]), cvtpk(p0[10], p0[11]), cvtpk(p0[12], p0[13]), cvtpk(p0[14], p0[15])};
            pw2 = (u32x4){cvtpk(p1[0], p1[1]), cvtpk(p1[2], p1[3]), cvtpk(p1[4], p1[5]), cvtpk(p1[6], p1[7])};
            pw3 = (u32x4){cvtpk(p1[8], p1[9]), cvtpk(p1[10], p1[11]), cvtpk(p1[12], p1[13]), cvtpk(p1[14], p1[15])};
            pv(o, vp0 + t * SLOTB, __builtin_bit_cast(bf16x8, pw0), __builtin_bit_cast(bf16x8, pw1), __builtin_bit_cast(bf16x8, pw2), __builtin_bit_cast(bf16x8, pw3));
        }
        lsum += __shfl_xor(lsum, 32);
        const float rl = __builtin_amdgcn_rcpf(lsum + snk);
        if (hi == 0) wsf[r32] = rl;
        asm volatile("s_waitcnt lgkmcnt(0)" ::: "memory");
        LAS bf16_t* stg = (LAS bf16_t*)(shm + L_OST) + wid * 2048;
#pragma unroll
        for (int r = 0; r < 16; ++r) { const int orow = crow(r, hi); const float rr = wsf[orow];
#pragma unroll
            for (int d0 = 0; d0 < 2; ++d0) stg[orow * 64 + d0 * 32 + r32] = (bf16_t)f2bf(o[d0][r] * rr); }
        asm volatile("s_waitcnt lgkmcnt(0)" ::: "memory");
#pragma unroll
        for (int it = 0; it < 4; ++it) {
            const int row = it * 8 + (lane >> 3), ch = lane & 7;
            const u32x4 ov = *(const LAS u32x4*)(stg + row * 64 + ch * 8);
            const u32x4 gv = gav[it];
            u32x4 w;
#pragma unroll
            for (int e = 0; e < 4; ++e) w[e] = cvtpk(bflo(ov[e]) * bflo(gv[e]), bfhi(ov[e]) * bfhi(gv[e]));
            *(u32x4*)(Y + (rowbase + R0 + row) * DM + h * 64 + ch * 8) = w;
        }
        asm volatile("s_waitcnt lgkmcnt(0)" ::: "memory");
    }
    __syncthreads();
}

__device__ __forceinline__ void gmlp_half(int item, const bf16_t* PB, bf16_t* Y, const bf16_t* Wsb, const float* bs_l, LAS unsigned char* shw  ) {
    int tid = threadIdx.x; asm volatile("" : "+v"(tid));
    const int lane = tid & 63, r32 = lane & 31, hi = lane >> 5;
    const int th = item & 1, g = (item >> 1) & 7, ch = item >> 4;
    const long row0 = (long)ch * 128;
    const unsigned ldsw = (unsigned)(uintptr_t)shw;
    u32x4 uv[8], gv[8];
    const bf16_t* pe = PB + (row0 + 64 * th + (lane >> 3)) * DIN + g * 64 + (lane & 7) * 8;
#pragma unroll
    for (int it = 0; it < 8; ++it) { uv[it] = *(const u32x4*)(pe + (size_t)it * 8 * DIN + OFF_U); gv[it] = *(const u32x4*)(pe + (size_t)it * 8 * DIN + OFF_GG); }
#pragma unroll
    for (int pc = 0; pc < 16; ++pc) { const int tt = pc >> 3, pw = pc & 7;
        glds16(PB + (row0 + 64 * tt + 16 * (pw & 3) + (lane >> 2)) * DIN + OFF_VG + g * 64 + (pw >> 2) * 32 + (lane & 3) * 8, (unsigned)__builtin_amdgcn_readfirstlane(ldsw + tt * 8192 + pw * 1024)); }
    float bsv[2][16];
#pragma unroll
    for (int tb = 0; tb < 2; ++tb)
#pragma unroll
        for (int r = 0; r < 16; ++r) bsv[tb][r] = bs_l[g * 128 + 64 * th + 32 * tb + crow(r, hi)];
    asm volatile("s_waitcnt vmcnt(0)" ::: "memory");
    const lds_cptr vp0 = (lds_cptr)shw + ((lane >> 4) & 1) * 32 + (lane & 3) * 8 + (4 * hi + ((lane & 15) >> 2)) * 64;
    f32x16 o[2][2];
#pragma unroll
    for (int tb = 0; tb < 2; ++tb) {
        const int tloc = 64 * th + 32 * tb;
        o[tb][0] = f32x16{}; o[tb][1] = f32x16{};
        const bf16_t* wrow = Wsb + ((size_t)g * 128 + tloc + r32) * 128 + 4 * hi;
#pragma unroll
        for (int ks = 0; ks < 8; ++ks) {
            const u32x2 wl = *(const u32x2*)(wrow + 16 * ks), wh = *(const u32x2*)(wrow + 16 * ks + 8);
            const u32x4 wa = (u32x4){wl.x, wl.y, wh.x, wh.y};
            const bf16x8 A = __builtin_bit_cast(bf16x8, wa);
#pragma unroll
            for (int d0 = 0; d0 < 2; ++d0) {
                const s16x4 lo = vtr(vp0 + (ks >> 2) * 8192 + d0 * 4096 + (ks & 3) * 1024), hh = vtr(vp0 + (ks >> 2) * 8192 + d0 * 4096 + (ks & 3) * 1024 + 512);
                const bf16x8 B = (bf16x8){lo[0], lo[1], lo[2], lo[3], hh[0], hh[1], hh[2], hh[3]};
                o[tb][d0] = __builtin_amdgcn_mfma_f32_32x32x16_bf16(A, B, o[tb][d0], 0, 0, 0);
            }
        }
    }
    asm volatile("s_waitcnt lgkmcnt(0)" ::: "memory");
    LAS float* sv = (LAS float*)shw;
#pragma unroll
    for (int tb = 0; tb < 2; ++tb)
#pragma unroll
        for (int r = 0; r < 16; ++r)
#pragma unroll
            for (int d0 = 0; d0 < 2; ++d0) sv[(32 * tb + crow(r, hi)) * 64 + 32 * d0 + r32] = o[tb][d0][r] + bsv[tb][r];
    asm volatile("s_waitcnt lgkmcnt(0)" ::: "memory");
    bf16_t* ye = Y + (row0 + 64 * th + (lane >> 3)) * DM + 512 + g * 64 + (lane & 7) * 8;
#pragma unroll
    for (int it = 0; it < 8; ++it) {
        const LAS float* sp = sv + (it * 8 + (lane >> 3)) * 64 + (lane & 7) * 8;
        const f32x4 s0 = *(const LAS f32x4*)sp, s1 = *(const LAS f32x4*)(sp + 4);
        u32x4 w;
        w.x = cvtpk(s0[0] * bflo(uv[it].x) * bflo(gv[it].x), s0[1] * bfhi(uv[it].x) * bfhi(gv[it].x));
        w.y = cvtpk(s0[2] * bflo(uv[it].y) * bflo(gv[it].y), s0[3] * bfhi(uv[it].y) * bfhi(gv[it].y));
        w.z = cvtpk(s1[0] * bflo(uv[it].z) * bflo(gv[it].z), s1[1] * bfhi(uv[it].z) * bfhi(gv[it].z));
        w.w = cvtpk(s1[2] * bflo(uv[it].w) * bflo(gv[it].w), s1[3] * bfhi(uv[it].w) * bfhi(gv[it].w));
        *(u32x4*)(ye + (size_t)it * 8 * DM) = w;
    }
    asm volatile("s_waitcnt lgkmcnt(0)" ::: "memory");
}
}

constexpr int NWAVES = 8;
constexpr size_t MiB = 1u << 20;
constexpr size_t WS_CTL = 0, CTL_ZERO_BYTES = 64 * 1024;
constexpr size_t WS_ADA = 1 * MiB;
constexpr size_t WS_BIAS = 1 * MiB + 128 * 1024;
constexpr size_t WS_SSQ = 1 * MiB + 256 * 1024;
constexpr size_t WS_WIN = 2 * MiB;
constexpr size_t WS_WOUT = 26 * MiB;
constexpr size_t WS_WS = 34 * MiB;
constexpr size_t WS_ID = 35 * MiB;
constexpr size_t WS_XB = 36 * MiB;
constexpr size_t WS_Y = 68 * MiB;
constexpr size_t WS_PB = 100 * MiB;
constexpr size_t WS_END = 192 * MiB;
static_assert(WS_WIN + (size_t)NL * 2 * DIN * DM * 2 <= WS_WOUT && WS_PB + (size_t)M * DIN * 2 <= WS_END, "ws map");
constexpr int CW_BAR = 1024;

constexpr int RING_BYTES = 136 * 1024;
constexpr int MISC_OFF = RING_BYTES;
constexpr int LDS_BYTES = 144 * 1024;
static_assert(mix::L_END <= RING_BYTES && pg8::STAGE_BYTES <= RING_BYTES && 8 * 16384 <= RING_BYTES, "LDS map");

#define XB_TMO      128
#define XB_XCNT(j)  (256  + 64 * (j))
#define XB_XSUB(j)  (1280 + 64 * (j))
#define XB_XGEN(j)  (2304 + 64 * (j))
#define XB_TOP      3328
#define XB_TOPGEN   3392
#define XCD_BAR_WORDS 3456
#define XB_SPIN_CAP (1u << 18)
static_assert((CW_BAR + XCD_BAR_WORDS) * 4 <= (int)CTL_ZERO_BYTES, "barrier words inside the memset region");

__device__ __forceinline__ unsigned xb_ld(unsigned* p)              { return __hip_atomic_load(p, __ATOMIC_RELAXED, __HIP_MEMORY_SCOPE_AGENT); }
__device__ __forceinline__ unsigned xb_add(unsigned* p, unsigned v) { return __hip_atomic_fetch_add(p, v, __ATOMIC_RELAXED, __HIP_MEMORY_SCOPE_AGENT); }
__device__ __forceinline__ unsigned xb_xcc_id() { return (unsigned)__builtin_amdgcn_s_getreg((3 << 11) | 20) & 0xFu; }
#define XB_SPIN(cond, bar) do { unsigned _sp = 0; while (cond) { __builtin_amdgcn_s_sleep(1); \
    if ((++_sp & 255u) == 0u) { if (xb_ld(&(bar)[XB_TMO])) break; if (_sp > XB_SPIN_CAP) { atomicAdd(&(bar)[XB_TMO], 1u); break; } } } } while (0)

struct XcdBarrier { unsigned* bar; unsigned x; volatile LAS unsigned* st; };
__device__ __forceinline__ XcdBarrier xcd_barrier_post(unsigned* bar, volatile LAS unsigned* st) {
    XcdBarrier b; b.bar = bar; b.x = xb_xcc_id(); b.st = st;
    if (threadIdx.x == 0) (void)xb_add(&bar[XB_XCNT(b.x)], 1u);
    return b;
}
__device__ __forceinline__ void xcd_barrier_complete(unsigned* bar, unsigned x, unsigned& nloc, unsigned& nx) {
    const unsigned G = gridDim.x * gridDim.y * gridDim.z;
    unsigned sum, cnt, mine, sp = 0u;
    for (;;) {
        sum = 0u; cnt = 0u; mine = 0u;
#pragma unroll
        for (unsigned j = 0; j < 16; ++j) { const unsigned c = xb_ld(&bar[XB_XCNT(j)]); sum += c; cnt += (c > 0u) ? 1u : 0u; mine = (j == x) ? c : mine; }
        if (sum == G) break;
        __builtin_amdgcn_s_sleep(1);
        if ((++sp & 255u) == 0u) { if (xb_ld(&bar[XB_TMO])) break; if (sp > XB_SPIN_CAP) { atomicAdd(&bar[XB_TMO], 1u); break; } }
    }
    nloc = mine > 0u ? mine : 1u; nx = cnt > 0u ? cnt : 1u;
}
__device__ __forceinline__ void xcd_barrier(const XcdBarrier& b) {
    asm volatile("s_waitcnt vmcnt(0)" ::: "memory");
    __syncthreads();
    if (threadIdx.x == 0) {
        unsigned* bar = b.bar;
        __builtin_amdgcn_s_waitcnt(0);
        unsigned nloc = b.st[0], nx = b.st[1];
        if (nloc == 0u) { xcd_barrier_complete(bar, b.x, nloc, nx); b.st[0] = nloc; b.st[1] = nx; }
        const unsigned old = xb_add(&bar[XB_XSUB(b.x)], 1u);
        const unsigned gen = old / nloc;
        if (old + 1u == (gen + 1u) * nloc) {
            __builtin_amdgcn_fence(__ATOMIC_RELEASE, "agent");
            asm volatile("s_waitcnt vmcnt(0)" ::: "memory");
            const unsigned og = xb_add(&bar[XB_TOP], 1u);
            const unsigned tg = og / nx;
            if (og + 1u == (tg + 1u) * nx) xb_add(&bar[XB_TOPGEN], 1u);
            else XB_SPIN(xb_ld(&bar[XB_TOPGEN]) == tg, bar);
            __builtin_amdgcn_fence(__ATOMIC_ACQUIRE, "agent");
            xb_add(&bar[XB_XGEN(b.x)], 1u);
            asm volatile("s_waitcnt vmcnt(0)" ::: "memory");
        } else {
            XB_SPIN(xb_ld(&bar[XB_XGEN(b.x)]) == gen, bar);
            __builtin_amdgcn_fence(__ATOMIC_ACQUIRE, "agent");
            asm volatile("s_waitcnt vmcnt(0)" ::: "memory");
        }
    }
    __syncthreads();
}

struct Args { const float* in[12]; float* out; unsigned char* ws; int ph_lo, ph_hi; };
static_assert(sizeof(Args) == 14 * 8 + 8, "Args has no padding");

template <int MODE>
__device__ __forceinline__ void transpose_item(const float* W, int K, int N, bf16_t* WT, size_t bstride_el, const float* gain, const float* sc, int scs, LAS float* scr, int item, int lane) {
    const int nblk = N / 32, kb = item / nblk, nb = item % nblk, k0 = 64 * kb, n0 = 32 * nb;
#pragma unroll
    for (int i = 0; i < 32; ++i) { const int kk = 2 * i + (lane >> 5); scr[kk * 33 + (lane & 31)] = W[(size_t)(k0 + kk) * N + n0 + (lane & 31)]; }
    asm volatile("s_waitcnt lgkmcnt(0)" ::: "memory");
    const int c = lane & 7;
    float f[2][8];
    if (MODE == 0) {
#pragma unroll
        for (int e = 0; e < 8; ++e) { const float gn = gain[k0 + 8 * c + e]; f[0][e] = gn * (1.f + sc[k0 + 8 * c + e]); f[1][e] = gn * (1.f + sc[scs + k0 + 8 * c + e]); }
    }
#pragma unroll
    for (int j = 0; j < 4; ++j) { const int n = (lane >> 3) + 8 * j; const LAS float* sp = scr + (8 * c) * 33 + n;
        float v[8];
#pragma unroll
        for (int e = 0; e < 8; ++e) v[e] = sp[e * 33];
#pragma unroll
        for (int bb = 0; bb < 2; ++bb) {
            float g[8];
            if (MODE == 0) {
#pragma unroll
                for (int e = 0; e < 8; ++e) g[e] = f[bb][e];
            } else { const float gt = sc[bb * scs + n0 + n];
#pragma unroll
                for (int e = 0; e < 8; ++e) g[e] = gt; }
            u32x4 o; o.x = pk2(v[0] * g[0], v[1] * g[1]); o.y = pk2(v[2] * g[2], v[3] * g[3]); o.z = pk2(v[4] * g[4], v[5] * g[5]); o.w = pk2(v[6] * g[6], v[7] * g[7]);
            *(u32x4*)(WT + (size_t)bb * bstride_el + (size_t)(n0 + n) * K + k0 + 8 * c) = o; } }
    asm volatile("s_waitcnt lgkmcnt(0)" ::: "memory");
}

template <bool SILU>
__device__ __forceinline__ void gemv32(const float* W, int N, int n0, const float* vec  , int vstride, const float* addb, float* out  , int ostride, LAS float* red  ) {
    const int tid = threadIdx.x, lane = tid & 63, w = tid >> 6, cg = lane & 7, rg = lane >> 3;
    f32x4 a0 = {0.f, 0.f, 0.f, 0.f}, a1 = {0.f, 0.f, 0.f, 0.f};
#pragma unroll
    for (int it = 0; it < 16; ++it) {
        const int k = 128 * w + 8 * it + rg;
        const f32x4 wv = *(const f32x4*)(W + (size_t)k * N + n0 + 4 * cg);
        float s0 = vec[k], s1 = vec[vstride + k];
        if (SILU) { s0 = fsilu(s0); s1 = fsilu(s1); }
        a0 += wv * s0; a1 += wv * s1;
    }
#pragma unroll
    for (int e = 0; e < 4; ++e) {
        a0[e] += __shfl_xor(a0[e], 8); a0[e] += __shfl_xor(a0[e], 16); a0[e] += __shfl_xor(a0[e], 32);
        a1[e] += __shfl_xor(a1[e], 8); a1[e] += __shfl_xor(a1[e], 16); a1[e] += __shfl_xor(a1[e], 32);
    }
    if (rg == 0) {
#pragma unroll
        for (int e = 0; e < 4; ++e) { red[(w * 2 + 0) * 32 + 4 * cg + e] = a0[e]; red[(w * 2 + 1) * 32 + 4 * cg + e] = a1[e]; }
    }
    __syncthreads();
    if (tid < 64) { const int bb = tid >> 5, col = tid & 31; float s = addb ? addb[n0 + col] : 0.f;
#pragma unroll
        for (int ww = 0; ww < 8; ++ww) s += red[(ww * 2 + bb) * 32 + col];
        out[bb * ostride + n0 + col] = s; }
    __syncthreads();
}

__global__ void __launch_bounds__(NWAVES * 64, 2) mk_fwd(Args args) {
    __shared__ __attribute__((aligned(16))) unsigned char lds_raw[LDS_BYTES];
    LAS unsigned char* lds = (LAS unsigned char*)lds_raw;
    volatile LAS unsigned* MISC = (volatile LAS unsigned*)(lds + MISC_OFF);
    const int tid0 = threadIdx.x;
    const int G = gridDim.x; const int bx = blockIdx.x; const int vcu = (G % 8 == 0) ? (bx % 8) * (G / 8) + bx / 8 : bx;
    unsigned char* ws = args.ws;
    const float* x = args.in[0]; const float* cvec = args.in[1]; const float* w_ada = args.in[2]; const float* b_ada = args.in[3]; const float* norm_gain = args.in[4]; const float* w_in = args.in[5];
    const float* q_gain = args.in[6]; const float* k_gain = args.in[7]; const float* sink = args.in[8]; const float* w_s = args.in[9]; const float* b_s = args.in[10]; const float* w_out = args.in[11];
    float* out = args.out;
    float* ADA = (float*)(ws + WS_ADA); float* BIAS = (float*)(ws + WS_BIAS); float* SSQ = (float*)(ws + WS_SSQ);
    bf16_t* WIN = (bf16_t*)(ws + WS_WIN); bf16_t* WOUT = (bf16_t*)(ws + WS_WOUT); bf16_t* WSB = (bf16_t*)(ws + WS_WS); bf16_t* IDN = (bf16_t*)(ws + WS_ID);
    bf16_t* XB = (bf16_t*)(ws + WS_XB); bf16_t* Y = (bf16_t*)(ws + WS_Y); bf16_t* PB = (bf16_t*)(ws + WS_PB);
    if (tid0 < 64) MISC[tid0] = 0u;
    __syncthreads();
    const int lo = args.ph_lo, hi = args.ph_hi;
    XcdBarrier bar; bar.bar = (unsigned*)(ws + WS_CTL) + CW_BAR; bar.x = 0; bar.st = MISC + 8;
    if (hi - lo > 1) bar = xcd_barrier_post((unsigned*)(ws + WS_CTL) + CW_BAR, MISC + 8);
#define IN(k) (lo <= (k) && (k) < hi)
#define SEAM(k) do { if ((k) + 1 < hi) xcd_barrier(bar); } while (0)
#define REPS(k) (((k) == PROBE_REP) ? 2 : 1)

  for (int pass_ = 0; pass_ < PROBE_PASSES; ++pass_) {
    int tid = threadIdx.x; asm volatile("" : "+v"(tid));
    const int lane = tid & 63, wave = __builtin_amdgcn_readfirstlane(tid >> 6);
    const int gw = vcu * NWAVES + wave, NGW = G * NWAVES;
    if (((PH_MASK >> 0) & 1) && IN(0)) {
      for (int rep_ = 0; rep_ < REPS(0); ++rep_) {
        if (vcu < 192) { const int l = vcu / 96, cb = vcu % 96;
            gemv32<true>(w_ada + (size_t)l * DM * 3 * DM, 3 * DM, 32 * cb, cvec, DM, b_ada + l * 3 * DM, ADA + l * 2 * 3 * DM, 3 * DM, (LAS float*)lds); }
        for (int it = gw; it < NL * 8 * 128 * 128 / 512; it += NGW) {
            const float* sp = w_s + (size_t)it * 512 + lane * 8; const f32x4 a = *(const f32x4*)sp, b2 = *(const f32x4*)(sp + 4);
            u32x4 o; o.x = pk2(a[0], a[1]); o.y = pk2(a[2], a[3]); o.z = pk2(b2[0], b2[1]); o.w = pk2(b2[2], b2[3]);
            *(u32x4*)(WSB + (size_t)it * 512 + lane * 8) = o; }
        for (int it = gw; it < 256 * DM / 512; it += NGW) {
            const int e0 = it * 512 + lane * 8, n = e0 >> 10, k = e0 & 1023; u32x4 o = {0u, 0u, 0u, 0u};
            if (n >= k && n < k + 8) { const unsigned one = 0x3F80u << (16 * ((n - k) & 1)); const int wsel = (n - k) >> 1; o.x = wsel == 0 ? one : 0u; o.y = wsel == 1 ? one : 0u; o.z = wsel == 2 ? one : 0u; o.w = wsel == 3 ? one : 0u; }
            *(u32x4*)(IDN + e0) = o; }
        {
            const int r0 = gw * (M / NGW);
            for (int rr = 0; rr < M / NGW; rr += 2) {
                const int m = r0 + rr;
                const f32x4* xr = (const f32x4*)(x + (size_t)m * DM) + lane;
                f32x4 v[2][4]; float sq[2] = {0.f, 0.f};
#pragma unroll
                for (int q = 0; q < 2; ++q)
#pragma unroll
                    for (int j = 0; j < 4; ++j) v[q][j] = xr[q * (DM / 4) + 64 * j];
#pragma unroll
                for (int q = 0; q < 2; ++q) {
#pragma unroll
                    for (int j = 0; j < 4; ++j) sq[q] += (v[q][j][0] * v[q][j][0] + v[q][j][1] * v[q][j][1]) + (v[q][j][2] * v[q][j][2] + v[q][j][3] * v[q][j][3]);
                    sq[q] = wave_sum(sq[q]);
                    u32x2* o8 = (u32x2*)(XB + (size_t)(m + q) * DM) + lane;
#pragma unroll
                    for (int j = 0; j < 4; ++j) { u32x2 w; w.x = cvtpk(v[q][j][0], v[q][j][1]); w.y = cvtpk(v[q][j][2], v[q][j][3]); o8[64 * j] = w; }
                    if (lane == 0) *(f32x4*)(SSQ + (size_t)(m + q) * 4) = (f32x4){sq[q], 0.f, 0.f, 0.f};
                }
            }
        }
      }
        SEAM(0);
    }
    if (((PH_MASK >> 1) & 1) && IN(1)) {
      for (int rep_ = 0; rep_ < REPS(1); ++rep_) {
        if (vcu < 176) { const int l = vcu / 88, nb = vcu % 88;
            gemv32<false>(w_in + (size_t)l * DM * DIN, DIN, 32 * nb, ADA + l * 2 * 3 * DM  , 3 * DM, nullptr, BIAS + l * 2 * DIN, DIN, (LAS float*)lds); }
        LAS float* scr = (LAS float*)(lds + wave * 16384);
        constexpr int I_IN = (DM / 64) * (DIN / 32), I_OUT = (DM / 64) * (DM / 32), NIT = NL * (I_IN + I_OUT);
        for (int it = gw; it < NIT; it += NGW) {
            int r = it; const int l = r / (I_IN + I_OUT); r -= l * (I_IN + I_OUT);
            if (r < I_IN) transpose_item<0>(w_in + (size_t)l * DM * DIN, DM, DIN, WIN + (size_t)l * 2 * DIN * DM, (size_t)DIN * DM, norm_gain + l * DM, ADA + l * 2 * 3 * DM + DM, 3 * DM, scr, r, lane);
            else transpose_item<1>(w_out + (size_t)l * DM * DM, DM, DM, WOUT + (size_t)l * 2 * DM * DM, (size_t)DM * DM, nullptr, ADA + l * 2 * 3 * DM + 2 * DM, 3 * DM, scr, r - I_IN, lane);
        }
      }
        for (int xb_ = 0; xb_ < PROBE_BAR; ++xb_) SEAM(1);
        SEAM(1);
    }
    for (int l = 0; l < NL; ++l) {
        const int p0 = 2 + 3 * l;
        if (((PH_MASK >> 2) & 1) && IN(p0)) {
            pg8::Gemm g{XB, WIN + (size_t)l * 2 * DIN * DM, M, DIN, DM, (size_t)DIN * DM * 2, nullptr, nullptr, 0}; pg8::StaticOrder S; S.init(M, DIN, G, bx);
            pg8::EpiProj E{PB, SSQ, BIAS + l * 2 * DIN, q_gain + l * 64, k_gain + l * 64};
            for (int rep_ = 0; rep_ < REPS(p0); ++rep_) pg8::gemm_phase<pg8::EpiProj, true>(lds, g, S, E);
            SEAM(p0);
        }
        if (((PH_MASK >> 3) & 3) && IN(p0 + 1)) {
            float aq = 0.f, ak = 0.f;
            { const float qv = __builtin_fabsf(q_gain[l * 64 + lane]), kv = __builtin_fabsf(k_gain[l * 64 + lane]); aq = qv; ak = kv;
#pragma unroll
              for (int o = 1; o < 64; o <<= 1) { aq = fmaxf(aq, __shfl_xor(aq, o)); ak = fmaxf(ak, __shfl_xor(ak, o)); } }
            const float sb2 = 8.f * aq * ak * LOG2E;
          for (int rep_ = 0; rep_ < REPS(p0 + 1); ++rep_) {
            for (int ra_ = 0; ra_ < ((PROBE_REP == 31 && l == 0) ? 2 : 1); ++ra_)
            if ((PH_MASK >> 3) & 1) for (int uidx = vcu; uidx < 256; uidx += G) mix::attn_unit(uidx >> 7, (uidx >> 6) & 1, uidx & 63, PB, Y, sink + l * 8, sb2, lds);
            for (int rg_ = 0; rg_ < ((PROBE_REP == 32 && l == 0) ? 2 : 1); ++rg_)
            if ((PH_MASK >> 4) & 1) for (int it = gw; it < 2048; it += NGW) mix::gmlp_half(it, PB, Y, WSB + (size_t)l * 8 * 128 * 128, b_s + l * 8 * 128, lds + wave * 16384);
            if (REPS(p0 + 1) > 1) __syncthreads();
          }
            SEAM(p0 + 1);
        }
        if (((PH_MASK >> 5) & 1) && IN(p0 + 2)) {
            pg8::Gemm g{Y, WOUT + (size_t)l * 2 * DM * DM, M, DM, DM, (size_t)DM * DM * 2, XB, IDN, 4}; pg8::StaticOrder S; S.init(M, DM, G, bx);
            const bool lastl = (l == NL - 1);
            pg8::EpiOut E{lastl ? nullptr : XB, out, SSQ};
            for (int rep_ = 0; rep_ < REPS(p0 + 2); ++rep_) pg8::gemm_phase<pg8::EpiOut, false>(lds, g, S, E);
            SEAM(p0 + 2);
        }
    }
    if (pass_ + 1 < PROBE_PASSES) xcd_barrier(bar);
  }
#undef IN
#undef SEAM
}

extern "C" void kernel_launch(void* const* d_in, const int* in_sizes, int n_in, void* d_out, int out_size, void* d_ws, size_t ws_size, hipStream_t stream) {
    static int grid = 0;
    if (grid == 0) {
        if (n_in != 12 || in_sizes[0] != M * DM || out_size != M * DM || ws_size < WS_END) { fprintf(stderr, "kernel_launch: unexpected shapes (n_in %d, in0 %d, out %d, ws %zu)\n", n_in, n_in > 0 ? in_sizes[0] : -1, out_size, ws_size); grid = -1; return; }
        int dev = 0, cus = 0, per_cu = 0;
        if (hipGetDevice(&dev) != hipSuccess || hipDeviceGetAttribute(&cus, hipDeviceAttributeMultiprocessorCount, dev) != hipSuccess) { grid = -1; return; }
        if (hipOccupancyMaxActiveBlocksPerMultiprocessor(&per_cu, (const void*)mk_fwd, NWAVES * 64, 0) != hipSuccess || per_cu < 1) { fprintf(stderr, "kernel_launch: occupancy query says %d\n", per_cu); per_cu = 1; }
        (void)hipGetLastError();
        grid = cus;
    }
    if (grid < 0) return;
    (void)hipMemsetAsync((char*)d_ws + WS_CTL, 0, CTL_ZERO_BYTES, stream);
    Args a{};
    for (int i = 0; i < 12; ++i) a.in[i] = (const float*)d_in[i];
    a.out = (float*)d_out; a.ws = (unsigned char*)d_ws;
#if MK_PER_PHASE
    for (int p = 0; p < 8; ++p) { a.ph_lo = p; a.ph_hi = p + 1; hipLaunchKernelGGL(mk_fwd, dim3(grid), dim3(NWAVES * 64), 0, stream, a); }
#else
    a.ph_lo = 0; a.ph_hi = 8;
    hipLaunchKernelGGL(mk_fwd, dim3(grid), dim3(NWAVES * 64), 0, stream, a);
#endif
}
```

```cpp
#include <hip/hip_runtime.h>
#include <cstdio>
#include <cstdint>

#ifndef PH_MASK
#define PH_MASK 0xff
#endif
#ifndef PROBE_REP
#define PROBE_REP -1
#endif
#ifndef PROBE_BAR
#define PROBE_BAR 0
#endif
#ifndef PROBE_PASSES
#define PROBE_PASSES 1
#endif
#ifndef PROBE_VCU
#define PROBE_VCU 0
#endif
#ifndef DESYNC_TICKS
#define DESYNC_TICKS 0
#endif
#define PROBE_TS_OFF 0.0f
#ifndef PROBE_TS_SCALE
#define PROBE_TS_SCALE 0.05f
#endif
#ifndef PROBE_TS
#define PROBE_TS -1
#endif
#ifndef MK_PER_PHASE
#define MK_PER_PHASE 0
#endif

constexpr int NB = 2, SEQ = 8192, DM = 1024, M = NB * SEQ, DIN = 2816, NL = 2;
constexpr int OFF_Q = 0, OFF_K = 512, OFF_V = 640, OFF_GA = 768, OFF_U = 1280, OFF_VG = 1792, OFF_GG = 2304;
constexpr float EPS = 1e-6f;
constexpr float LOG2E = 1.4426950408889634f;
constexpr float C2 = 0.125f * LOG2E;

#define LAS __attribute__((address_space(3)))
#define GAS __attribute__((address_space(1)))
typedef unsigned short bf16_t;
typedef short bf16x8 __attribute__((ext_vector_type(8)));
typedef short s16x4 __attribute__((ext_vector_type(4)));
typedef float f32x4 __attribute__((ext_vector_type(4)));
typedef float f32x16 __attribute__((ext_vector_type(16)));
typedef unsigned u32x4 __attribute__((ext_vector_type(4)));
typedef unsigned u32x2 __attribute__((ext_vector_type(2)));
typedef GAS unsigned gu32;

__device__ __forceinline__ unsigned f2bf(float f) { unsigned u = __builtin_bit_cast(unsigned, f); return (u + 0x7fffu + ((u >> 16) & 1u)) >> 16; }
__device__ __forceinline__ unsigned pk2(float lo, float hi) { return f2bf(lo) | (f2bf(hi) << 16); }
__device__ __forceinline__ float bf2f(unsigned short h) { return __builtin_bit_cast(float, (unsigned)h << 16); }
__device__ __forceinline__ float bflo(unsigned w) { return __builtin_bit_cast(float, w << 16); }
__device__ __forceinline__ float bfhi(unsigned w) { return __builtin_bit_cast(float, w & 0xffff0000u); }
typedef float f32x2_t __attribute__((ext_vector_type(2))); typedef __bf16 bf16x2_t __attribute__((ext_vector_type(2)));
__device__ __forceinline__ unsigned cvtpk(float lo, float hi) { f32x2_t v = {lo, hi}; bf16x2_t b = __builtin_convertvector(v, bf16x2_t); return __builtin_bit_cast(unsigned, b); }
__device__ __forceinline__ float fsilu(float v) { return v * __builtin_amdgcn_rcpf(1.f + __builtin_amdgcn_exp2f(-LOG2E * v)); }
__device__ __forceinline__ float wave_sum(float v) {
#pragma unroll
    for (int o = 1; o < 64; o <<= 1) v += __shfl_xor(v, o);
    return v;
}

#ifndef MK_BAR_EVERY_WG_RELEASES
#define MK_BAR_EVERY_WG_RELEASES 0
#endif
#ifndef MK_WT
#define MK_WT 0
#endif
__device__ __forceinline__ void st16(void* p, u32x4 v) {
#if MK_WT
    asm volatile("global_store_dwordx4 %0, %1, off sc1\n\ts_nop 1" :: "v"(p), "v"(v) : "memory");
#else
    *(u32x4*)p = v;
#endif
}
__device__ __forceinline__ void st8wt(void* p, u32x2 v) { asm volatile("global_store_dwordx2 %0, %1, off sc1\n\ts_nop 1" :: "v"(p), "v"(v) : "memory"); }
__device__ __forceinline__ void st16wt(void* p, u32x4 v) { asm volatile("global_store_dwordx4 %0, %1, off sc1\n\ts_nop 1" :: "v"(p), "v"(v) : "memory"); }
__device__ __forceinline__ void st8(void* p, u32x2 v) {
#if MK_WT
    asm volatile("global_store_dwordx2 %0, %1, off sc1\n\ts_nop 1" :: "v"(p), "v"(v) : "memory");
#else
    *(u32x2*)p = v;
#endif
}
__device__ __forceinline__ void glds16s(const void* sbase, unsigned voff, unsigned lds_dst) { unsigned keep;
    asm volatile("s_nop 4\n\ts_mov_b32 %0, m0\n\ts_mov_b32 m0, %3\n\ts_nop 0\n\tglobal_load_lds_dwordx4 %1, %2\n\ts_mov_b32 m0, %0" : "=&s"(keep) : "v"(voff), "s"(sbase), "s"(lds_dst) : "memory"); }
__device__ __forceinline__ void glds16k(const void* sbase, unsigned voff, unsigned lds_dst) {
    asm volatile("s_mov_b32 m0, %2\n\ts_nop 0\n\tglobal_load_lds_dwordx4 %0, %1" :: "v"(voff), "s"(sbase), "s"(lds_dst) : "memory"); }

namespace pg8 {
constexpr int BM = 256, BK = 64, HALF = 128, HTB = HALF * BK * 2, STAGE_BYTES = 8 * HTB, NXCD = 8, WGM = 8;
__host__ __device__ __forceinline__ int lds_byte(int r, int c) { const int st = (r >> 4) * 2 + (c >> 5), rr = r & 15, cc = c & 31, ob = rr * 64 + cc * 2; return st * 1024 + (ob ^ (((ob >> 9) & 1) << 5)); }
__host__ __device__ __forceinline__ void stage_rc(int b, int& R, int& C) { const int st = b / 1024, sb = b % 1024, swz = sb ^ (((sb >> 9) & 1) << 5); R = (st >> 1) * 16 + swz / 64; C = (st & 1) * 32 + (swz % 64) / 2; }
__host__ __device__ __forceinline__ int perm32(int rho) { const int n = rho >> 4, i = rho & 15; return 8 * (i >> 2) + 4 * n + (i & 3); }

struct Unit { int pm, pn; };
struct Gemm { const bf16_t* A; const bf16_t* Bt; int M, N, K; size_t bstride;
              const bf16_t* Ax; const bf16_t* Bx; int nxt; };

struct StaticOrder {
    int nM, nN, nwg, G, c;
    __host__ __device__ void init(int M_, int N_, int G_, int c_) { nM = M_ / BM; nN = N_ / BM; nwg = nM * nN; G = G_; c = c_; }
    __host__ __device__ bool next(int i, Unit& u) const {
        const long L = (long)i * G + c; if (L >= nwg) return false;
        int wgid = (int)L; { const int q = nwg / NXCD, r = nwg % NXCD, xcd = wgid % NXCD, off = wgid / NXCD; wgid = (xcd < r ? xcd * (q + 1) : r * (q + 1) + (xcd - r) * q) + off; }
        const int nig = WGM * nN, gid = wgid / nig, fm = gid * WGM, gsz = (nM - fm) < WGM ? (nM - fm) : WGM;
        u.pm = fm + ((wgid % nig) % gsz); u.pn = (wgid % nig) / gsz; return true;
    }
};

#define STAMPG(i_) do { const unsigned long long t_ = __builtin_amdgcn_s_memrealtime(); if (threadIdx.x == 0) { volatile LAS unsigned* M_ = (volatile LAS unsigned*)(lds + 136 * 1024); M_[16 + 2 * (i_)] = (unsigned)t_; M_[17 + 2 * (i_)] = (unsigned)(t_ >> 32); } } while (0)
struct NoWait { __device__ __forceinline__ void operator()() const {} };
struct PanelWait { unsigned* cnt; unsigned target; bool active;
    __device__ __forceinline__ void operator()() const {
        if (!active) return;
        if (threadIdx.x == 0) { unsigned sp_ = 0; while (__hip_atomic_load(cnt, __ATOMIC_RELAXED, __HIP_MEMORY_SCOPE_AGENT) < target) { if (++sp_ > (1u << 22)) break; }
            __builtin_amdgcn_fence(__ATOMIC_ACQUIRE, "agent"); asm volatile("s_waitcnt vmcnt(0)" ::: "memory"); }
        __syncthreads();
    } };
template <class Epi, bool ALIGN_EPI, class Wait = NoWait>
__device__ __forceinline__ void gemm_phase(LAS unsigned char* lds, const Gemm g, const StaticOrder& S, const Epi& E, const int probe = 0, const Wait& W = Wait()) {
    int tid = threadIdx.x; asm volatile("" : "+v"(tid));
    const int wid = __builtin_amdgcn_readfirstlane(tid >> 6), lane = tid & 63, wr = wid >> 2, wc = wid & 3, fr = lane & 15, fq = lane >> 4;
    const int K = g.K, nt = K / BK;
    unsigned voffA[2], voffB0[2], voffB1[2];
#pragma unroll
    for (int i = 0; i < 2; ++i) { int R, C; stage_rc(tid * 16 + i * 8192, R, C); const int cb = 64 * (R >> 5) + perm32(R & 31);
        voffA[i] = (unsigned)(R * K + C) * 2u; voffB0[i] = (unsigned)(cb * K + C) * 2u; voffB1[i] = (unsigned)((cb + 32) * K + C) * 2u; }
    const size_t kstep = (size_t)(BK * 2);
    const size_t hstep = (size_t)HALF * K * 2;
    const size_t tstep = 2 * hstep;
    const unsigned ldsw = (unsigned)wid * 1024u;
    const unsigned lds0 = (unsigned)(uintptr_t)lds;
    const int aoff = lds_byte(wr * 64 + fr, fq * 8);
    int boffB = 4 * HTB + lds_byte(wc * 32 + fr, fq * 8); asm volatile("" : "+v"(boffB));
#define PG8_SA(b, h) (((b) * 2 + (h)) * HTB)
#define PG8_SB(b, h) ((4 + (b) * 2 + (h)) * HTB)
#define PG8_SBR(b, h) (((b) * 2 + (h)) * HTB)
#define PG8_STAGE(bufoff, gbase, voff) do { _Pragma("unroll") for (int _i = 0; _i < 2; ++_i) \
        glds16s((const void*)(gbase), (voff)[_i], (unsigned)__builtin_amdgcn_readfirstlane((int)(lds0 + (unsigned)(bufoff) + ldsw + (unsigned)_i * 8192u))); } while (0)
#define PG8_STAGEK(bufoff, gbase, voff) do { _Pragma("unroll") for (int _i = 0; _i < 2; ++_i) \
        glds16k((const void*)(gbase), (voff)[_i], (unsigned)__builtin_amdgcn_readfirstlane((int)(lds0 + (unsigned)(bufoff) + ldsw + (unsigned)_i * 8192u))); } while (0)
#define PG8_LDA(dst, b, h) do { _Pragma("unroll") for (int m = 0; m < 4; ++m) _Pragma("unroll") for (int k = 0; k < 2; ++k) dst[m][k] = *(const LAS bf16x8*)(lds + PG8_SA(b, h) + aoff + m * 2048 + k * 1024); } while (0)
#define PG8_LDB(dst, b, h) do { _Pragma("unroll") for (int n = 0; n < 2; ++n) _Pragma("unroll") for (int k = 0; k < 2; ++k) dst[n][k] = *(const LAS bf16x8*)(lds + boffB + (PG8_SBR(b, h) + n * 2048 + k * 1024)); } while (0)
#define PG8_MMA(ai, bj, At, Bt) do { __builtin_amdgcn_s_setprio(1); _Pragma("unroll") for (int m = 0; m < 4; ++m) _Pragma("unroll") for (int n = 0; n < 2; ++n) _Pragma("unroll") for (int k = 0; k < 2; ++k) \
        acc[ai][bj][m][n] = __builtin_amdgcn_mfma_f32_16x16x32_bf16(Bt[n][k], At[m][k], acc[ai][bj][m][n], 0, 0, 0); __builtin_amdgcn_s_setprio(0); } while (0)
#define PG8_WAIT_V(n) asm volatile("s_waitcnt vmcnt(" #n ")" ::: "memory")
#define PG8_WAIT_L(n) asm volatile("s_waitcnt lgkmcnt(" #n ")" ::: "memory")
#define PG8_BAR __builtin_amdgcn_s_barrier()
#define PG8_SCHED __builtin_amdgcn_sched_barrier(0)
    Unit cur, nxt; int ui = 0;
    if (!S.next(0, cur)) return;
    f32x4 acc[2][2][4][2];
    u32x4 ini[2][4][2];
    if constexpr (Epi::ACC_INIT) E.load_init(ini, cur, wr, wc, fr, fq);
    W();
    if constexpr (Epi::ACC_INIT) {
#pragma unroll
        for (int a = 0; a < 2; ++a)
#pragma unroll
            for (int m = 0; m < 4; ++m)
#pragma unroll
                for (int b = 0; b < 2; ++b) asm volatile("" : "+v"(ini[a][m][b]));
    }
    bf16x8 At[4][2], B0[2][2], B1[2][2];
    const int ntot = nt + g.nxt;
#define PG8_UA(u_) ((const char*)g.A + (size_t)(u_).pm * tstep)
#define PG8_UB(u_) ((const char*)g.Bt + (size_t)((u_).pm >> 5) * g.bstride + (size_t)(u_).pn * tstep)
#define PG8_UX(u_) ((const char*)g.Ax + (size_t)(u_).pm * tstep + (size_t)(u_).pn * 512)
    const char* cA = PG8_UA(cur); const char* cB = PG8_UB(cur); const char* xA = PG8_UX(cur); const char* xB = (const char*)g.Bx;
    PG8_STAGE(PG8_SB(0, 0), cB, voffB0); PG8_STAGE(PG8_SB(0, 1), cB, voffB1); PG8_STAGE(PG8_SA(0, 0), cA, voffA); PG8_STAGE(PG8_SA(0, 1), cA + hstep, voffA);
    if (wr == 1) PG8_BAR;
    PG8_WAIT_V(2); PG8_BAR;
    PG8_STAGE(PG8_SB(1, 0), cB + kstep, voffB0); PG8_STAGE(PG8_SA(1, 0), cA + kstep, voffA); PG8_STAGE(PG8_SB(1, 1), cB + kstep, voffB1);
    if constexpr (Epi::ACC_INIT) {
#pragma unroll
        for (int a = 0; a < 2; ++a)
#pragma unroll
            for (int m = 0; m < 4; ++m)
#pragma unroll
                for (int b = 0; b < 2; ++b) { const u32x4 t = ini[a][m][b]; acc[a][b][m][0] = (f32x4){bflo(t.x), bfhi(t.x), bflo(t.y), bfhi(t.y)}; acc[a][b][m][1] = (f32x4){bflo(t.z), bfhi(t.z), bflo(t.w), bfhi(t.w)}; }
    } else {
#pragma unroll
        for (int a = 0; a < 2; ++a)
#pragma unroll
            for (int b = 0; b < 2; ++b)
#pragma unroll
                for (int m = 0; m < 4; ++m)
#pragma unroll
                    for (int n = 0; n < 2; ++n) acc[a][b][m][n] = (f32x4){0.f, 0.f, 0.f, 0.f};
    }
    PG8_WAIT_V(6); PG8_BAR;
    for (;;) {
        const bool has_next = S.next(ui + 1, nxt);
        const char* nA = has_next ? PG8_UA(nxt) : cA; const char* nB = has_next ? PG8_UB(nxt) : cB;
        for (int t = 0; t < ntot; t += 2) {
            const char* a1 = (t < nt ? cA + (size_t)(t + 1) * kstep : xA + (size_t)(t + 1 - nt) * kstep);
            const int t2 = t + 2;
            const char* a2 = t2 < nt ? cA + (size_t)t2 * kstep : (t2 < ntot ? xA + (size_t)(t2 - nt) * kstep : nA);
            const char* b2 = t2 < nt ? cB + (size_t)t2 * kstep : (t2 < ntot ? xB + (size_t)(t2 - nt) * kstep : nB);
            const char* a3 = a2 + kstep; const char* b3 = b2 + kstep;
            PG8_LDB(B0, 0, 0); PG8_LDB(B1, 0, 1); PG8_SCHED; PG8_LDA(At, 0, 0); PG8_STAGEK(PG8_SA(1, 1), a1 + hstep, voffA);
            PG8_WAIT_V(8); PG8_WAIT_L(0); PG8_BAR; PG8_MMA(0, 0, At, B0); PG8_MMA(0, 1, At, B1); PG8_BAR; PG8_SCHED;
            PG8_LDA(At, 0, 1); PG8_STAGEK(PG8_SB(0, 0), b2, voffB0); PG8_STAGEK(PG8_SB(0, 1), b2, voffB1); PG8_STAGEK(PG8_SA(0, 0), a2, voffA);
            PG8_WAIT_V(8); PG8_WAIT_L(0); PG8_BAR; PG8_MMA(1, 0, At, B0); PG8_MMA(1, 1, At, B1); PG8_BAR; PG8_SCHED;
            PG8_LDB(B0, 1, 0); PG8_LDB(B1, 1, 1); PG8_SCHED; PG8_LDA(At, 1, 0); PG8_STAGEK(PG8_SA(0, 1), a2 + hstep, voffA);
            PG8_WAIT_V(8); PG8_WAIT_L(0); PG8_BAR; PG8_MMA(0, 0, At, B0); PG8_MMA(0, 1, At, B1); PG8_BAR; PG8_SCHED;
            PG8_LDA(At, 1, 1); PG8_STAGEK(PG8_SB(1, 0), b3, voffB0); PG8_STAGEK(PG8_SB(1, 1), b3, voffB1); PG8_STAGEK(PG8_SA(1, 0), a3, voffA);
            PG8_WAIT_V(8); PG8_WAIT_L(0); PG8_BAR; PG8_MMA(1, 0, At, B0); PG8_MMA(1, 1, At, B1); PG8_BAR; PG8_SCHED;
        }
        if constexpr (ALIGN_EPI) { if (wr == 0) PG8_BAR; }
        if (PROBE_TS == 120 && probe && ui == 0) STAMPG(1);
        if (PROBE_TS == 122 && probe && ui == 1) STAMPG(1);
        if (PROBE_TS == 124 && probe && ui == 2) STAMPG(1);
        if constexpr (!Epi::AFTER_DRAIN) { E(acc, cur, wr, wc, fr, fq); }
        if (PROBE_TS == 121 && probe && ui == 0) STAMPG(1);
        if (PROBE_TS == 123 && probe && ui == 1) STAMPG(1);
        if (PROBE_TS == 125 && probe && ui == 2) STAMPG(1);
        if (!has_next) break;
#pragma unroll
        for (int a = 0; a < 2; ++a)
#pragma unroll
            for (int b = 0; b < 2; ++b)
#pragma unroll
                for (int m = 0; m < 4; ++m)
#pragma unroll
                    for (int n = 0; n < 2; ++n) acc[a][b][m][n] = (f32x4){0.f, 0.f, 0.f, 0.f};
        cur = nxt; cA = nA; cB = nB; xA = PG8_UX(cur); ++ui;
        if constexpr (ALIGN_EPI) { if (wr == 1) PG8_BAR; }
    }
    PG8_WAIT_V(0);
    if constexpr (!ALIGN_EPI) { if (wr == 0) PG8_BAR; }
    PG8_BAR;
    if constexpr (Epi::AFTER_DRAIN) { E.fused(acc, cur, wr, wc, fr, fq, lds, wid, lane); }
#undef PG8_UA
#undef PG8_UB
#undef PG8_UX
#undef PG8_SA
#undef PG8_SB
#undef PG8_SBR
#undef PG8_STAGE
#undef PG8_STAGEK
#undef PG8_LDA
#undef PG8_LDB
#undef PG8_MMA
#undef PG8_WAIT_V
#undef PG8_WAIT_L
#undef PG8_BAR
#undef PG8_SCHED
}

struct EpiProj {
    static constexpr bool AFTER_DRAIN = false, ACC_INIT = false;
    __device__ __forceinline__ void load_init(u32x4 (&)[2][4][2], const Unit&, int, int, int, int) const {}
    bf16_t* PB; const float* ssq4; const float* bias; const float* qg; const float* kg;
    __device__ __forceinline__ void operator()(const f32x4 (&acc)[2][2][4][2], const Unit& u, int wr, int wc, int fr, int fq) const {
        const int b = u.pm >> 5;
        const int colw = u.pn * 256 + wc * 64 + 8 * fq;
        int type;
        if (u.pn < 2) type = 0; else if (u.pn == 2) type = (wc < 2) ? 1 : 2; else if (u.pn < 5) type = 3; else if (u.pn < 9) type = 5; else type = 4;
        const int cst = (type == 5) ? OFF_U + 128 * (u.pn - 5) + 32 * wc + 8 * fq : (type == 4 ? colw - 512 : colw);
        const float* bp = bias + b * DIN + colw;
        f32x4 bv[2][2];
#pragma unroll
        for (int bj = 0; bj < 2; ++bj)
#pragma unroll
            for (int n = 0; n < 2; ++n) bv[bj][n] = *(const f32x4*)(bp + 32 * bj + 4 * n);
        float rstd[2][4];
        const float* sp = ssq4 + (size_t)(u.pm * 256 + wr * 64 + fr) * 4;
#pragma unroll
        for (int ai = 0; ai < 2; ++ai)
#pragma unroll
            for (int m = 0; m < 4; ++m) { const f32x4 s4 = *(const f32x4*)(sp + (size_t)(ai * 128 + m * 16) * 4); rstd[ai][m] = __builtin_amdgcn_rsqf(((s4[0] + s4[1]) + (s4[2] + s4[3])) * (1.f / DM) + EPS); }
        f32x4 gk[2][2];
        if (type == 1) {
#pragma unroll
            for (int bj = 0; bj < 2; ++bj)
#pragma unroll
                for (int n = 0; n < 2; ++n) gk[bj][n] = *(const f32x4*)(kg + 8 * fq + 32 * bj + 4 * n) * *(const f32x4*)(qg + 8 * fq + 32 * bj + 4 * n);
        }
        const float gsc = (type == 0) ? C2 : 1.f;
#pragma unroll
        for (int ai = 0; ai < 2; ++ai)
#pragma unroll
            for (int m = 0; m < 4; ++m) asm volatile("" : "+v"(rstd[ai][m]));
#pragma unroll
        for (int bj = 0; bj < 2; ++bj)
#pragma unroll
            for (int n = 0; n < 2; ++n) { asm volatile("" : "+v"(bv[bj][n])); if (type == 1) asm volatile("" : "+v"(gk[bj][n])); }
#pragma unroll
        for (int ai = 0; ai < 2; ++ai)
#pragma unroll
            for (int m = 0; m < 4; ++m) {
                const int row = u.pm * 256 + ai * 128 + wr * 64 + m * 16 + fr;
                f32x4 v[2][2];
#pragma unroll
                for (int bj = 0; bj < 2; ++bj)
#pragma unroll
                    for (int n = 0; n < 2; ++n) v[bj][n] = acc[ai][bj][m][n] * rstd[ai][m] + bv[bj][n];
                bf16_t* rowp = PB + (size_t)row * DIN + cst;
                if (type == 5) {
#pragma unroll
                    for (int n = 0; n < 2; ++n)
#pragma unroll
                        for (int e = 0; e < 4; ++e) v[0][n][e] = v[0][n][e] * fsilu(v[1][n][e]);
                    u32x4 w; w.x = cvtpk(v[0][0][0], v[0][0][1]); w.y = cvtpk(v[0][0][2], v[0][0][3]); w.z = cvtpk(v[0][1][0], v[0][1][1]); w.w = cvtpk(v[0][1][2], v[0][1][3]);
                    st16wt(rowp, w);
                    continue;
                }
                if (type == 0 || type == 1 || type == 4) {
                    float ss = 0.f;
#pragma unroll
                    for (int bj = 0; bj < 2; ++bj)
#pragma unroll
                        for (int n = 0; n < 2; ++n) ss += (v[bj][n][0] * v[bj][n][0] + v[bj][n][1] * v[bj][n][1]) + (v[bj][n][2] * v[bj][n][2] + v[bj][n][3] * v[bj][n][3]);
                    ss += __shfl_xor(ss, 16); ss += __shfl_xor(ss, 32);
                    const float rs = __builtin_amdgcn_rsqf(ss * (1.f / 64.f) + EPS) * gsc;
                    if (type == 1) {
#pragma unroll
                        for (int bj = 0; bj < 2; ++bj)
#pragma unroll
                            for (int n = 0; n < 2; ++n) v[bj][n] = v[bj][n] * rs * gk[bj][n];
                    } else {
#pragma unroll
                        for (int bj = 0; bj < 2; ++bj)
#pragma unroll
                            for (int n = 0; n < 2; ++n) v[bj][n] = v[bj][n] * rs;
                    }
                } else if (type == 3) {
#pragma unroll
                    for (int bj = 0; bj < 2; ++bj)
#pragma unroll
                        for (int n = 0; n < 2; ++n)
#pragma unroll
                            for (int e = 0; e < 4; ++e) v[bj][n][e] = fsilu(v[bj][n][e]);
                }
#pragma unroll
                for (int bj = 0; bj < 2; ++bj) {
                    u32x4 w; w.x = cvtpk(v[bj][0][0], v[bj][0][1]); w.y = cvtpk(v[bj][0][2], v[bj][0][3]); w.z = cvtpk(v[bj][1][0], v[bj][1][1]); w.w = cvtpk(v[bj][1][2], v[bj][1][3]);
                    st16wt(rowp + 32 * bj, w);
                }
            }
    }
};

struct EpiOut {
    static constexpr bool AFTER_DRAIN = true, ACC_INIT = true;
    bf16_t* xb; float* out; float* ssq4; const bf16_t* xres;
    __device__ __forceinline__ void load_init(u32x4 (&ini)[2][4][2], const Unit& u, int wr, int wc, int fr, int fq) const {
        const bf16_t* p = xres + (size_t)(u.pm * 256 + wr * 64 + fr) * DM + u.pn * 256 + wc * 64 + 8 * fq;
#pragma unroll
        for (int a = 0; a < 2; ++a)
#pragma unroll
            for (int m = 0; m < 4; ++m)
#pragma unroll
                for (int b = 0; b < 2; ++b) ini[a][m][b] = *(const u32x4*)(p + (size_t)(a * 128 + m * 16) * DM + 32 * b);
    }
    __device__ __forceinline__ void fused(f32x4 (&acc)[2][2][4][2], const Unit& u, int wr, int wc, int fr, int fq, LAS unsigned char* lds, int wid, int lane) const {
        const int colw = u.pn * 256 + wc * 64 + 8 * fq;
        if (xb != nullptr) {
            LAS float* P = (LAS float*)lds;
#pragma unroll
            for (int ai = 0; ai < 2; ++ai)
#pragma unroll
                for (int m = 0; m < 4; ++m) {
                    const int rl = ai * 128 + wr * 64 + m * 16 + fr;
                    bf16_t* rowp = xb + (size_t)(u.pm * 256 + rl) * DM + colw;
                    float ss = 0.f;
#pragma unroll
                    for (int bj = 0; bj < 2; ++bj) {
                        const f32x4 a = acc[ai][bj][m][0], c = acc[ai][bj][m][1];
                        ss += (a[0] * a[0] + a[1] * a[1]) + (a[2] * a[2] + a[3] * a[3]) + (c[0] * c[0] + c[1] * c[1]) + (c[2] * c[2] + c[3] * c[3]);
                        u32x4 w; w.x = cvtpk(a[0], a[1]); w.y = cvtpk(a[2], a[3]); w.z = cvtpk(c[0], c[1]); w.w = cvtpk(c[2], c[3]);
                        st16wt(rowp + 32 * bj, w);
                    }
                    ss += __shfl_xor(ss, 16); ss += __shfl_xor(ss, 32); if (fq == 0) P[rl * 4 + wc] = ss;
                }
            __syncthreads();
            if (threadIdx.x < 256) { const int rl = threadIdx.x; const float s = (P[rl * 4 + 0] + P[rl * 4 + 1]) + (P[rl * 4 + 2] + P[rl * 4 + 3]); __hip_atomic_store(ssq4 + (size_t)(u.pm * 256 + rl) * 4 + u.pn, s, __ATOMIC_RELAXED, __HIP_MEMORY_SCOPE_AGENT); }
            __syncthreads();
        } else {
#pragma unroll
            for (int ai = 0; ai < 2; ++ai)
#pragma unroll
                for (int m = 0; m < 4; ++m) {
                    float* rowp = out + (size_t)(u.pm * 256 + ai * 128 + wr * 64 + m * 16 + fr) * DM + colw;
#pragma unroll
                    for (int bj = 0; bj < 2; ++bj)
#pragma unroll
                        for (int n = 0; n < 2; ++n) __builtin_nontemporal_store(acc[ai][bj][m][n], (f32x4*)(rowp + 32 * bj + 4 * n));
                }
        }
    }
};
}

namespace mix {
typedef LAS const char* lds_cptr;
constexpr int SLOTB = 8192, NSLOT = 6;
constexpr int L_K = 0, L_V = NSLOT * SLOTB, L_WS = 2 * NSLOT * SLOTB, L_OST = L_WS + 8 * 256, L_END = L_OST + 8 * 4096;
__device__ __forceinline__ int crow(int r, int hi) { return (r & 3) + 8 * (r >> 2) + 4 * hi; }
__device__ __forceinline__ void glds16(const void* gsrc, unsigned lds_dst) { unsigned keep;
    asm volatile("s_mov_b32 %0, m0\n\ts_mov_b32 m0, %2\n\ts_nop 0\n\tglobal_load_lds_dwordx4 %1, off\n\ts_mov_b32 m0, %0" : "=&s"(keep) : "v"(gsrc), "s"(lds_dst) : "memory"); }
__device__ __forceinline__ s16x4 vtr(lds_cptr p) { typedef short v4i16_t __attribute__((ext_vector_type(4))); return __builtin_bit_cast(s16x4, __builtin_amdgcn_ds_read_tr16_b64_v4i16((LAS v4i16_t*)p)); }

__device__ __forceinline__ void qkt(f32x16& p0, f32x16& p1, lds_cptr kslot, const int (&koff)[4], const bf16x8* qr, const f32x16& cinit) {
#pragma unroll
    for (int d0 = 0; d0 < 4; ++d0) {
        const bf16x8 b0 = *(const LAS bf16x8*)(kslot + koff[d0]);
        const bf16x8 b1 = *(const LAS bf16x8*)(kslot + koff[d0] + 4096);
        if (d0 == 0) { p0 = __builtin_amdgcn_mfma_f32_32x32x16_bf16(b0, qr[0], cinit, 0, 0, 0); p1 = __builtin_amdgcn_mfma_f32_32x32x16_bf16(b1, qr[0], cinit, 0, 0, 0); }
        else { p0 = __builtin_amdgcn_mfma_f32_32x32x16_bf16(b0, qr[d0], p0, 0, 0, 0); p1 = __builtin_amdgcn_mfma_f32_32x32x16_bf16(b1, qr[d0], p1, 0, 0, 0); }
    }
}
__device__ __forceinline__ void pv(f32x16* o, lds_cptr vp, bf16x8 pa0, bf16x8 pa1, bf16x8 pa2, bf16x8 pa3) {
#pragma unroll
    for (int d0 = 0; d0 < 2; ++d0) {
        s16x4 lo[4], hi[4];
#pragma unroll
        for (int ks = 0; ks < 4; ++ks) { lo[ks] = vtr(vp + d0 * 4096 + ks * 1024); hi[ks] = vtr(vp + d0 * 4096 + ks * 1024 + 512); }
#define MIX_PK(k) (bf16x8){lo[k][0], lo[k][1], lo[k][2], lo[k][3], hi[k][0], hi[k][1], hi[k][2], hi[k][3]}
        o[d0] = __builtin_amdgcn_mfma_f32_32x32x16_bf16(pa0, MIX_PK(0), o[d0], 0, 0, 0);
        o[d0] = __builtin_amdgcn_mfma_f32_32x32x16_bf16(pa1, MIX_PK(1), o[d0], 0, 0, 0);
        o[d0] = __builtin_amdgcn_mfma_f32_32x32x16_bf16(pa2, MIX_PK(2), o[d0], 0, 0, 0);
        o[d0] = __builtin_amdgcn_mfma_f32_32x32x16_bf16(pa3, MIX_PK(3), o[d0], 0, 0, 0);
#undef MIX_PK
    }
}

__device__ __forceinline__ void attn_unit(int b, int kvh, int qb, const bf16_t* PB, bf16_t* Y, const float* sink_l, float sb2, LAS unsigned char* shm, const int probe = 0) {
    LAS unsigned char* lds = shm;
    int tid = threadIdx.x; asm volatile("" : "+v"(tid));
    const int lane = tid & 63, r32 = lane & 31, hi = lane >> 5; const int wid = __builtin_amdgcn_readfirstlane(tid >> 6);
    const int g = wid >> 1, jj = wid & 1, h = kvh * 4 + g;
    const long rowbase = (long)b * SEQ; const int q0 = qb * 128, kb0 = q0 - 128;
    const int t_lo = (qb == 0) ? 2 : 0, t_hi = (qb == SEQ / 128 - 1) ? 3 : 5;
    const unsigned lds0 = (unsigned)(uintptr_t)shm;
    const bf16_t* Kh = PB + rowbase * DIN + OFF_K + kvh * 64; const bf16_t* Vh = PB + rowbase * DIN + OFF_V + kvh * 64;
    for (int t = t_lo; t <= t_hi; ++t) {
        const long kr = kb0 + 64 * t;
        glds16(Kh + (kr + 8 * wid + (lane >> 3)) * DIN + 8 * ((lane & 7) ^ ((4 * wid + (lane >> 4)) & 7)), (unsigned)__builtin_amdgcn_readfirstlane(lds0 + L_K + t * SLOTB + wid * 1024));
        glds16(Vh + (kr + 16 * (wid & 3) + (lane >> 2)) * DIN + (wid >> 2) * 32 + (lane & 3) * 8, (unsigned)__builtin_amdgcn_readfirstlane(lds0 + L_V + t * SLOTB + wid * 1024));
    }
    const float slope2 = __builtin_amdgcn_exp2f(-(float)(h + 1)) * LOG2E;
    const float snk = __builtin_amdgcn_exp2f(sink_l[h] * LOG2E - sb2);
    LAS float* wsf = (LAS float*)(shm + L_WS) + wid * 64;
    const lds_cptr shm3 = (lds_cptr)shm;
    const lds_cptr vp0 = shm3 + L_V + ((lane >> 4) & 1) * 32 + (lane & 3) * 8 + (4 * hi + ((lane & 15) >> 2)) * 64;
    int koff[4];
#pragma unroll
    for (int d0 = 0; d0 < 4; ++d0) koff[d0] = r32 * 128 + (((2 * d0 + hi) ^ ((r32 >> 1) & 7)) << 4);
    f32x16 cinit;
#pragma unroll
    for (int r = 0; r < 16; ++r) cinit[r] = -sb2;
    bf16x8 qr2[2][4]; u32x4 gav2[2][4];
    {
        const bf16_t* Qw = PB + (rowbase + q0 + 64 * jj + r32) * DIN + OFF_Q + h * 64 + hi * 8;
#pragma unroll
        for (int d0 = 0; d0 < 4; ++d0) qr2[0][d0] = *(const bf16x8*)(Qw + d0 * 16);
    }
    asm volatile("s_waitcnt vmcnt(0)" ::: "memory");
    __syncthreads();
    {
        const bf16_t* Qw = PB + (rowbase + q0 + 64 * jj + 32 + r32) * DIN + OFF_Q + h * 64 + hi * 8;
#pragma unroll
        for (int d0 = 0; d0 < 4; ++d0) qr2[1][d0] = *(const bf16x8*)(Qw + d0 * 16);
    }
#pragma unroll
    for (int i = 0; i < 2; ++i) {
        const int R0 = q0 + 64 * jj + 32 * i;
#pragma unroll
        for (int it = 0; it < 4; ++it) gav2[i][it] = *(const u32x4*)(PB + (rowbase + R0 + it * 8 + (lane >> 3)) * DIN + OFF_GA + h * 64 + (lane & 7) * 8);
    }
    if (PROBE_TS == 130 && probe) STAMPG(1);
#pragma unroll
    for (int i = 0; i < 2; ++i) {
        if (PROBE_TS == 131 && probe && i == 1) STAMPG(1);
        const int R0 = q0 + 64 * jj + 32 * i;
        bf16x8 qr[4];
#pragma unroll
        for (int d0 = 0; d0 < 4; ++d0) qr[d0] = qr2[i][d0];
        f32x16 o[2]; o[0] = f32x16{}; o[1] = f32x16{};
        float lsum = 0.f;
        const int ta = jj > t_lo ? jj : t_lo, tb = (jj + 4) < t_hi ? (jj + 4) : t_hi;
        for (int t = ta; t <= tb; ++t) {
            f32x16 p0, p1;
            qkt(p0, p1, shm3 + L_K + t * SLOTB, koff, qr, cinit);
            const float Lf = (float)(kb0 + 64 * t + 4 * hi - (R0 + r32));
            const bool edge = (t == jj) || (t == jj + 4);
            if (edge) {
#pragma unroll
                for (int r = 0; r < 16; ++r) {
                    const float c = (float)((r & 3) + 8 * (r >> 2));
                    const float x0 = __builtin_fabsf(Lf + c), x1 = __builtin_fabsf(Lf + (c + 32.f));
                    const float a0 = (x0 > 128.f) ? -INFINITY : p0[r] - slope2 * x0, a1 = (x1 > 128.f) ? -INFINITY : p1[r] - slope2 * x1;
                    p0[r] = __builtin_amdgcn_exp2f(a0); p1[r] = __builtin_amdgcn_exp2f(a1);
                }
            } else {
#pragma unroll
                for (int r = 0; r < 16; ++r) {
                    const float c = (float)((r & 3) + 8 * (r >> 2));
                    const float x0 = __builtin_fabsf(Lf + c), x1 = __builtin_fabsf(Lf + (c + 32.f));
                    p0[r] = __builtin_amdgcn_exp2f(p0[r] - slope2 * x0); p1[r] = __builtin_amdgcn_exp2f(p1[r] - slope2 * x1);
                }
            }
            float sacc = 0.f;
#pragma unroll
            for (int r = 0; r < 16; ++r) sacc += p0[r] + p1[r];
            lsum += sacc;
            u32x4 pw0, pw1, pw2, pw3;
            pw0 = (u32x4){cvtpk(p0[0], p0[1]), cvtpk(p0[2], p0[3]), cvtpk(p0[4], p0[5]), cvtpk(p0[6], p0[7])};
            pw1 = (u32x4){cvtpk(p0[8], p0[9]), cvtpk(p0[10], p0[11]), cvtpk(p0[12], p0[13]), cvtpk(p0[14], p0[15])};
            pw2 = (u32x4){cvtpk(p1[0], p1[1]), cvtpk(p1[2], p1[3]), cvtpk(p1[4], p1[5]), cvtpk(p1[6], p1[7])};
            pw3 = (u32x4){cvtpk(p1[8], p1[9]), cvtpk(p1[10], p1[11]), cvtpk(p1[12], p1[13]), cvtpk(p1[14], p1[15])};
            pv(o, vp0 + t * SLOTB, __builtin_bit_cast(bf16x8, pw0), __builtin_bit_cast(bf16x8, pw1), __builtin_bit_cast(bf16x8, pw2), __builtin_bit_cast(bf16x8, pw3));
        }
        if (i == 0) {
#pragma unroll
            for (int i2 = 0; i2 < 2; ++i2)
#pragma unroll
                for (int it = 0; it < 4; ++it) asm volatile("" : "+v"(gav2[i2][it]));
#pragma unroll
            for (int d0 = 0; d0 < 4; ++d0) asm volatile("" : "+v"(qr2[1][d0]));
        }
        lsum += __shfl_xor(lsum, 32);
        const float rl = __builtin_amdgcn_rcpf(lsum + snk);
        if (hi == 0) wsf[r32] = rl;
        asm volatile("s_waitcnt lgkmcnt(0)" ::: "memory");
        LAS bf16_t* stg = (LAS bf16_t*)(shm + L_OST) + wid * 2048;
#pragma unroll
        for (int r = 0; r < 16; ++r) { const int orow = crow(r, hi); const float rr = wsf[orow];
#pragma unroll
            for (int d0 = 0; d0 < 2; ++d0) stg[orow * 64 + d0 * 32 + r32] = (bf16_t)cvtpk(o[d0][r] * rr, 0.f); }
        asm volatile("s_waitcnt lgkmcnt(0)" ::: "memory");
#pragma unroll
        for (int it = 0; it < 4; ++it) {
            const int row = it * 8 + (lane >> 3), ch = lane & 7;
            const u32x4 ov = *(const LAS u32x4*)(stg + row * 64 + ch * 8);
            const u32x4 gv = gav2[i][it];
            u32x4 w;
#pragma unroll
            for (int e = 0; e < 4; ++e) w[e] = cvtpk(bflo(ov[e]) * bflo(gv[e]), bfhi(ov[e]) * bfhi(gv[e]));
            st16wt(Y + (rowbase + R0 + row) * DM + h * 64 + ch * 8, w);
        }
        asm volatile("s_waitcnt lgkmcnt(0)" ::: "memory");
    }
    if (PROBE_TS == 132 && probe) STAMPG(1);
    __syncthreads();
    if (PROBE_TS == 133 && probe) STAMPG(1);
}

__device__ __forceinline__ void gmlp_half(int item, const bf16_t* PB, bf16_t* Y, const bf16_t* Wsb, const float* bs_l, LAS unsigned char* shw  ) {
    int tid = threadIdx.x; asm volatile("" : "+v"(tid));
    const int lane = tid & 63, r32 = lane & 31, hi = lane >> 5;
    const int th = item & 1, g = (item >> 1) & 7, ch = item >> 4;
    const long row0 = (long)ch * 128;
    const unsigned ldsw = (unsigned)(uintptr_t)shw;
#pragma unroll
    for (int pc = 0; pc < 16; ++pc) { const int tt = pc >> 3, pw = pc & 7;
        glds16(PB + (row0 + 64 * tt + 16 * (pw & 3) + (lane >> 2)) * DIN + OFF_VG + g * 64 + (pw >> 2) * 32 + (lane & 3) * 8, (unsigned)__builtin_amdgcn_readfirstlane(ldsw + tt * 8192 + pw * 1024)); }
    u32x4 wq[2][8];
#pragma unroll
    for (int tb = 0; tb < 2; ++tb) {
        const bf16_t* wrow = Wsb + ((size_t)g * 128 + 64 * th + 32 * tb + r32) * 128 + 8 * hi;
#pragma unroll
        for (int ks = 0; ks < 8; ++ks) wq[tb][ks] = *(const u32x4*)(wrow + 16 * ks);
    }
    float bsr[8];
#pragma unroll
    for (int it = 0; it < 8; ++it) bsr[it] = bs_l[g * 128 + 64 * th + it * 8 + (lane >> 3)];
    asm volatile("s_waitcnt vmcnt(0)" ::: "memory");
    const lds_cptr vp0 = (lds_cptr)shw + ((lane >> 4) & 1) * 32 + (lane & 3) * 8 + (4 * hi + ((lane & 15) >> 2)) * 64;
    f32x16 o[2][2];
#pragma unroll
    for (int tb = 0; tb < 2; ++tb) {
        o[tb][0] = f32x16{}; o[tb][1] = f32x16{};
#pragma unroll
        for (int ks = 0; ks < 8; ++ks) {
            const auto s0_ = __builtin_amdgcn_permlane32_swap(wq[tb][ks].x, wq[tb][ks].z, false, false), s1_ = __builtin_amdgcn_permlane32_swap(wq[tb][ks].y, wq[tb][ks].w, false, false);
            const u32x4 wa = (u32x4){s0_[0], s1_[0], s0_[1], s1_[1]};
            const bf16x8 A = __builtin_bit_cast(bf16x8, wa);
#pragma unroll
            for (int d0 = 0; d0 < 2; ++d0) {
                const s16x4 lo = vtr(vp0 + (ks >> 2) * 8192 + d0 * 4096 + (ks & 3) * 1024), hh = vtr(vp0 + (ks >> 2) * 8192 + d0 * 4096 + (ks & 3) * 1024 + 512);
                const bf16x8 B = (bf16x8){lo[0], lo[1], lo[2], lo[3], hh[0], hh[1], hh[2], hh[3]};
                o[tb][d0] = __builtin_amdgcn_mfma_f32_32x32x16_bf16(A, B, o[tb][d0], 0, 0, 0);
            }
        }
    }
    u32x4 uv[8];
    const bf16_t* pe = PB + (row0 + 64 * th + (lane >> 3)) * DIN + g * 64 + (lane & 7) * 8;
#pragma unroll
    for (int it = 0; it < 8; ++it) uv[it] = *(const u32x4*)(pe + (size_t)it * 8 * DIN + OFF_U);
    asm volatile("s_waitcnt lgkmcnt(0)" ::: "memory");
    LAS float* sv = (LAS float*)shw;
#pragma unroll
    for (int tb = 0; tb < 2; ++tb)
#pragma unroll
        for (int r = 0; r < 16; ++r)
#pragma unroll
            for (int d0 = 0; d0 < 2; ++d0) sv[(32 * tb + crow(r, hi)) * 64 + 32 * d0 + r32] = o[tb][d0][r];
    asm volatile("s_waitcnt lgkmcnt(0)" ::: "memory");
    bf16_t* ye = Y + (row0 + 64 * th + (lane >> 3)) * DM + 512 + g * 64 + (lane & 7) * 8;
#pragma unroll
    for (int it = 0; it < 8; ++it) asm volatile("" : "+v"(uv[it]));
#pragma unroll
    for (int it = 0; it < 8; ++it) {
        const LAS float* sp = sv + (it * 8 + (lane >> 3)) * 64 + (lane & 7) * 8;
        const f32x4 s0 = *(const LAS f32x4*)sp + bsr[it], s1 = *(const LAS f32x4*)(sp + 4) + bsr[it];
        u32x4 w;
        w.x = cvtpk(s0[0] * bflo(uv[it].x), s0[1] * bfhi(uv[it].x));
        w.y = cvtpk(s0[2] * bflo(uv[it].y), s0[3] * bfhi(uv[it].y));
        w.z = cvtpk(s1[0] * bflo(uv[it].z), s1[1] * bfhi(uv[it].z));
        w.w = cvtpk(s1[2] * bflo(uv[it].w), s1[3] * bfhi(uv[it].w));
        st16wt(ye + (size_t)it * 8 * DM, w);
    }
    asm volatile("s_waitcnt lgkmcnt(0)" ::: "memory");
}
}

constexpr int NWAVES = 8;
constexpr size_t MiB = 1u << 20;
constexpr size_t WS_CTL = 0, CTL_ZERO_BYTES = 192 * 1024;
constexpr size_t WS_ADA = 64 * 1024;
constexpr size_t WS_BIAS = 128 * 1024;
constexpr size_t WS_SSQ = 1 * MiB + 256 * 1024;
constexpr size_t WS_WIN = 2 * MiB;
constexpr size_t WS_WOUT = 26 * MiB;
constexpr size_t WS_WS = 34 * MiB;
constexpr size_t WS_XB = 36 * MiB;
constexpr size_t WS_Y = 68 * MiB;
constexpr size_t WS_PB = 100 * MiB;
constexpr size_t WS_END = 192 * MiB;
static_assert(WS_WIN + (size_t)NL * 2 * DIN * DM * 2 <= WS_WOUT && WS_PB + (size_t)M * DIN * 2 <= WS_END, "ws map");
constexpr int CW_PANEL = 256;
constexpr int CW_PANEL2 = 2304;
constexpr int CW_PANEL0 = 3968;
constexpr int CW_CONV0 = 3360;
constexpr int CW_MIXDONE = 3328;
constexpr int CW_CONVDONE = 3392;
constexpr int CW_PANEL3 = 3456;
constexpr int CW_BAR = 4096;

constexpr int RING_BYTES = 136 * 1024;
constexpr int MISC_OFF = RING_BYTES;
constexpr int LDS_BYTES = 144 * 1024;
static_assert(mix::L_END <= RING_BYTES && pg8::STAGE_BYTES <= RING_BYTES && 8 * 16384 <= RING_BYTES, "LDS map");

#define XB_TMO      128
#define XB_XCNT(j)  (256  + 64 * (j))
#define XB_XSUB(j)  (1280 + 64 * (j))
#define XB_XGEN(j)  (2304 + 64 * (j))
#define XB_TOP      3328
#define XB_TOPGEN   3392
#define XCD_BAR_WORDS 3456
#define XB_SPIN_CAP (1u << 18)
static_assert(CW_PANEL + 2 * 64 * 16 <= CW_PANEL2 && CW_PANEL2 + 64 * 16 <= CW_MIXDONE && CW_MIXDONE < CW_CONVDONE && CW_CONVDONE < CW_PANEL3 && CW_PANEL3 + 2 * 64 * 4 <= CW_BAR && (CW_BAR + XCD_BAR_WORDS) * 4 <= 64 * 1024, "control words inside the memset region, below the ada table");

__device__ __forceinline__ void poll3(unsigned* a, unsigned ta, unsigned* b, unsigned tb, unsigned* c, unsigned tc) {
    unsigned sp_ = 0;
    for (;;) {
        const unsigned va = __hip_atomic_load(a, __ATOMIC_RELAXED, __HIP_MEMORY_SCOPE_AGENT), vb = __hip_atomic_load(b, __ATOMIC_RELAXED, __HIP_MEMORY_SCOPE_AGENT), vc = __hip_atomic_load(c, __ATOMIC_RELAXED, __HIP_MEMORY_SCOPE_AGENT);
        if (va >= ta && vb >= tb && vc >= tc) break;
        if (++sp_ > (1u << 22)) break;
    }
}
__device__ __forceinline__ unsigned xb_ld(unsigned* p)              { return __hip_atomic_load(p, __ATOMIC_RELAXED, __HIP_MEMORY_SCOPE_AGENT); }
__device__ __forceinline__ unsigned xb_add(unsigned* p, unsigned v) { return __hip_atomic_fetch_add(p, v, __ATOMIC_RELAXED, __HIP_MEMORY_SCOPE_AGENT); }
__device__ __forceinline__ unsigned xb_xcc_id() { return (unsigned)__builtin_amdgcn_s_getreg((3 << 11) | 20) & 0xFu; }
#define XB_SPIN(cond, bar) do { unsigned _sp = 0; while (cond) { __builtin_amdgcn_s_sleep(1); \
    if ((++_sp & 255u) == 0u) { if (xb_ld(&(bar)[XB_TMO])) break; if (_sp > XB_SPIN_CAP) { atomicAdd(&(bar)[XB_TMO], 1u); break; } } } } while (0)

struct XcdBarrier { unsigned* bar; unsigned x; volatile LAS unsigned* st; };
__device__ __forceinline__ XcdBarrier xcd_barrier_post(unsigned* bar, volatile LAS unsigned* st) {
    XcdBarrier b; b.bar = bar; b.x = xb_xcc_id(); b.st = st;
    if (threadIdx.x == 0) (void)xb_add(&bar[XB_XCNT(b.x)], 1u);
    return b;
}
__device__ __forceinline__ void xcd_barrier_complete(unsigned* bar, unsigned x, unsigned& nloc, unsigned& nx) {
    const unsigned G = gridDim.x * gridDim.y * gridDim.z;
    unsigned sum, cnt, mine, sp = 0u;
    for (;;) {
        sum = 0u; cnt = 0u; mine = 0u;
#pragma unroll
        for (unsigned j = 0; j < 16; ++j) { const unsigned c = xb_ld(&bar[XB_XCNT(j)]); sum += c; cnt += (c > 0u) ? 1u : 0u; mine = (j == x) ? c : mine; }
        if (sum == G) break;
        __builtin_amdgcn_s_sleep(1);
        if ((++sp & 255u) == 0u) { if (xb_ld(&bar[XB_TMO])) break; if (sp > XB_SPIN_CAP) { atomicAdd(&bar[XB_TMO], 1u); break; } }
    }
    nloc = mine > 0u ? mine : 1u; nx = cnt > 0u ? cnt : 1u;
}
__device__ __forceinline__ void xcd_barrier(const XcdBarrier& b) {
    asm volatile("s_waitcnt vmcnt(0)" ::: "memory");
    __syncthreads();
    if (threadIdx.x == 0) {
        unsigned* bar = b.bar;
        __builtin_amdgcn_s_waitcnt(0);
        unsigned nloc = b.st[0], nx = b.st[1];
        if (nloc == 0u) { xcd_barrier_complete(bar, b.x, nloc, nx); b.st[0] = nloc; b.st[1] = nx; }
#if MK_BAR_EVERY_WG_RELEASES
        __builtin_amdgcn_fence(__ATOMIC_RELEASE, "agent");
        asm volatile("s_waitcnt vmcnt(0)" ::: "memory");
#endif
        const unsigned old = xb_add(&bar[XB_XSUB(b.x)], 1u);
        const unsigned gen = old / nloc;
        if (old + 1u == (gen + 1u) * nloc) {
#if !MK_BAR_EVERY_WG_RELEASES
            __builtin_amdgcn_fence(__ATOMIC_RELEASE, "agent");
            asm volatile("s_waitcnt vmcnt(0)" ::: "memory");
#endif
            const unsigned og = xb_add(&bar[XB_TOP], 1u);
            const unsigned tg = og / nx;
            if (og + 1u == (tg + 1u) * nx) xb_add(&bar[XB_TOPGEN], 1u);
            else { unsigned _sp = 0; while (xb_ld(&bar[XB_TOPGEN]) == tg) { if ((++_sp & 255u) == 0u) { if (xb_ld(&bar[XB_TMO])) break; if (_sp > XB_SPIN_CAP) { atomicAdd(&bar[XB_TMO], 1u); break; } } } }
            __builtin_amdgcn_fence(__ATOMIC_ACQUIRE, "agent");
            xb_add(&bar[XB_XGEN(b.x)], 1u);
            asm volatile("s_waitcnt vmcnt(0)" ::: "memory");
        } else {
            XB_SPIN(xb_ld(&bar[XB_XGEN(b.x)]) == gen, bar);
            __builtin_amdgcn_fence(__ATOMIC_ACQUIRE, "agent");
            asm volatile("s_waitcnt vmcnt(0)" ::: "memory");
        }
    }
    __syncthreads();
}

struct Args { const float* in[12]; float* out; unsigned char* ws; int ph_lo, ph_hi; };
static_assert(sizeof(Args) == 14 * 8 + 8, "Args has no padding");

__host__ __device__ __forceinline__ int permcol(int n) {
    if (n < OFF_U) return n;
    if (n < OFF_VG) { const int c = n - OFF_U; return OFF_U + 256 * (c >> 7) + 64 * ((c >> 5) & 3) + (c & 31); }
    if (n < OFF_GG) return n + 512;
    const int c = n - OFF_GG; return OFF_U + 256 * (c >> 7) + 64 * ((c >> 5) & 3) + 32 + (c & 31);
}
struct TrItem { const float* W; int N; bf16_t* WT; size_t bstride_el; const float* gain; const float* sc; const float* shift; float* bias_acc; int item; int mode; };
__device__ __forceinline__ void tr_load(const TrItem& I, int lane, float (&wv)[32], float (&shv)[2]) {
    const int nblk = I.N / 32, kb = I.item / nblk, nb = I.item % nblk, k0 = 64 * kb, n0 = 32 * nb;
#pragma unroll
    for (int i = 0; i < 32; ++i) wv[i] = __builtin_nontemporal_load(&I.W[(size_t)(k0 + 2 * i + (lane >> 5)) * I.N + n0 + (lane & 31)]);
    shv[0] = 0.f; shv[1] = 0.f;
    if (I.mode == 0) { shv[0] = I.shift[(lane >> 5) * 3 * DM + k0 + (lane & 31)]; shv[1] = I.shift[(lane >> 5) * 3 * DM + k0 + 32 + (lane & 31)]; }
}
template <int MODE>
__device__ __forceinline__ void tr_finish(const TrItem& I, int lane, const float (&wv)[32], const float (&shv)[2], LAS float* scr) {
    constexpr int K = DM, scs = 3 * DM;
    const int N = I.N, nblk = N / 32, kb = I.item / nblk, nb = I.item % nblk, k0 = 64 * kb, n0 = 32 * nb;
    const int c = lane & 7;
    float f[2][8], gtv[2][4];
    if (MODE == 0) {
#pragma unroll
        for (int e = 0; e < 8; ++e) { const float gn = I.gain[k0 + 8 * c + e]; f[0][e] = gn * (1.f + I.sc[k0 + 8 * c + e]); f[1][e] = gn * (1.f + I.sc[scs + k0 + 8 * c + e]); }
    } else {
#pragma unroll
        for (int bb = 0; bb < 2; ++bb)
#pragma unroll
            for (int j = 0; j < 4; ++j) gtv[bb][j] = I.sc[bb * scs + n0 + (lane >> 3) + 8 * j];
    }
#pragma unroll
    for (int i = 0; i < 32; ++i) scr[(2 * i + (lane >> 5)) * 33 + (lane & 31)] = wv[i];
    LAS float* shl = scr + 64 * 33;
    if (MODE == 0) { shl[(lane >> 5) * 64 + (lane & 31)] = shv[0]; shl[(lane >> 5) * 64 + 32 + (lane & 31)] = shv[1]; }
    asm volatile("s_waitcnt lgkmcnt(0)" ::: "memory");
    if (MODE == 0) {
        const int bb = lane >> 5, n = lane & 31; float a = 0.f;
#pragma unroll 16
        for (int kk = 0; kk < 64; ++kk) a += shl[bb * 64 + kk] * scr[kk * 33 + n];
        atomicAdd(I.bias_acc + bb * N + permcol(n0) + n, a);
    }
    if (MODE == 0) {
#pragma unroll
        for (int bb = 0; bb < 2; ++bb)
#pragma unroll
            for (int e = 0; e < 8; ++e) asm volatile("" : "+v"(f[bb][e]));
    } else {
#pragma unroll
        for (int bb = 0; bb < 2; ++bb)
#pragma unroll
            for (int j = 0; j < 4; ++j) asm volatile("" : "+v"(gtv[bb][j]));
    }
#pragma unroll
    for (int j = 0; j < 4; ++j) { const int n = (lane >> 3) + 8 * j; const LAS float* sp = scr + (8 * c) * 33 + n;
        float v[8];
#pragma unroll
        for (int e = 0; e < 8; ++e) v[e] = sp[e * 33];
#pragma unroll
        for (int bb = 0; bb < 2; ++bb) {
            float g[8];
            if (MODE == 0) {
#pragma unroll
                for (int e = 0; e < 8; ++e) g[e] = f[bb][e];
            } else { const float gt = gtv[bb][j];
#pragma unroll
                for (int e = 0; e < 8; ++e) g[e] = gt; }
            u32x4 o; o.x = pk2(v[0] * g[0], v[1] * g[1]); o.y = pk2(v[2] * g[2], v[3] * g[3]); o.z = pk2(v[4] * g[4], v[5] * g[5]); o.w = pk2(v[6] * g[6], v[7] * g[7]);
            st16wt(I.WT + (size_t)bb * I.bstride_el + (size_t)((MODE == 0 ? permcol(n0) : n0) + n) * K + k0 + 8 * c, o); } }
    asm volatile("s_waitcnt lgkmcnt(0)" ::: "memory");
}
constexpr int TR_I_IN = (DM / 64) * (DIN / 32), TR_I_OUT = (DM / 64) * (DM / 32), TR_TOTAL = 2 * (TR_I_IN + TR_I_OUT);
__device__ __forceinline__ TrItem tr_make(int id, const float* w_in, const float* w_out, const float* norm_gain, const float* ADA, float* BIAS, bf16_t* WIN, bf16_t* WOUT) {
    TrItem I; int l, r;
    if (id < TR_I_IN) { l = 0; r = id; I.mode = 0; } else if (id < TR_I_IN + TR_I_OUT) { l = 0; r = id - TR_I_IN; I.mode = 1; }
    else if (id < 2 * TR_I_IN + TR_I_OUT) { l = 1; r = id - TR_I_IN - TR_I_OUT; I.mode = 0; } else { l = 1; r = id - 2 * TR_I_IN - TR_I_OUT; I.mode = 1; }
    I.item = r;
    if (I.mode == 0) { I.W = w_in + (size_t)l * DM * DIN; I.N = DIN; I.WT = WIN + (size_t)l * 2 * DIN * DM; I.bstride_el = (size_t)DIN * DM; I.gain = norm_gain + l * DM; I.sc = ADA + l * 2 * 3 * DM + DM; I.shift = ADA + l * 2 * 3 * DM; I.bias_acc = BIAS + l * 2 * DIN; }
    else { I.W = w_out + (size_t)l * DM * DM; I.N = DM; I.WT = WOUT + (size_t)l * 2 * DM * DM; I.bstride_el = (size_t)DM * DM; I.gain = nullptr; I.sc = ADA + l * 2 * 3 * DM + 2 * DM; I.shift = nullptr; I.bias_acc = nullptr; }
    return I;
}
__device__ __forceinline__ void tr_run(int first, int last, int stride, int lane, LAS float* scr, const float* w_in, const float* w_out, const float* norm_gain, const float* ADA, float* BIAS, bf16_t* WIN, bf16_t* WOUT) {
    for (int id = first; id < last; id += 2 * stride) {
        const bool two = (id + stride < last);
        const TrItem I0 = tr_make(id, w_in, w_out, norm_gain, ADA, BIAS, WIN, WOUT), I1 = tr_make(two ? id + stride : id, w_in, w_out, norm_gain, ADA, BIAS, WIN, WOUT);
        float wa[32], wb[32], sa[2], sb[2];
        tr_load(I0, lane, wa, sa);
        if (two) tr_load(I1, lane, wb, sb);
        if (two) {
#pragma unroll
            for (int i = 0; i < 32; ++i) asm volatile("" : "+v"(wb[i]));
            asm volatile("" : "+v"(sb[0]), "+v"(sb[1]));
        }
        if (I0.mode == 0) tr_finish<0>(I0, lane, wa, sa, scr); else tr_finish<1>(I0, lane, wa, sa, scr);
        if (two) { if (I1.mode == 0) tr_finish<0>(I1, lane, wb, sb, scr); else tr_finish<1>(I1, lane, wb, sb, scr); }
    }
}

template <bool SILU>
__device__ __forceinline__ void gemv32(const float* W, int N, int n0, const float* vec  , int vstride, const float* addb, float* out  , int ostride, LAS float* red  ) {
    const int tid = threadIdx.x, lane = tid & 63, w = tid >> 6, cg = lane & 7, rg = lane >> 3;
    f32x4 a0 = {0.f, 0.f, 0.f, 0.f}, a1 = {0.f, 0.f, 0.f, 0.f};
#pragma unroll
    for (int it = 0; it < 16; ++it) {
        const int k = 128 * w + 8 * it + rg;
        const f32x4 wv = *(const f32x4*)(W + (size_t)k * N + n0 + 4 * cg);
        float s0 = vec[k], s1 = vec[vstride + k];
        if (SILU) { s0 = fsilu(s0); s1 = fsilu(s1); }
        a0 += wv * s0; a1 += wv * s1;
    }
#pragma unroll
    for (int e = 0; e < 4; ++e) {
        a0[e] += __shfl_xor(a0[e], 8); a0[e] += __shfl_xor(a0[e], 16); a0[e] += __shfl_xor(a0[e], 32);
        a1[e] += __shfl_xor(a1[e], 8); a1[e] += __shfl_xor(a1[e], 16); a1[e] += __shfl_xor(a1[e], 32);
    }
    if (rg == 0) {
#pragma unroll
        for (int e = 0; e < 4; ++e) { red[(w * 2 + 0) * 32 + 4 * cg + e] = a0[e]; red[(w * 2 + 1) * 32 + 4 * cg + e] = a1[e]; }
    }
    __syncthreads();
    if (tid < 64) { const int bb = tid >> 5, col = tid & 31; float s = addb ? addb[n0 + col] : 0.f;
#pragma unroll
        for (int ww = 0; ww < 8; ++ww) s += red[(ww * 2 + bb) * 32 + col];
        out[bb * ostride + n0 + col] = s; }
    __syncthreads();
}

#define XROWS(R0_, CNT_, WT_) do { \
            const int r0 = (R0_); \
            const f32x4* xr = (const f32x4*)(x + (size_t)r0 * DM) + lane; \
            f32x4 v[CNT_][4]; \
            _Pragma("unroll") for (int q = 0; q < (CNT_); ++q) _Pragma("unroll") for (int j = 0; j < 4; ++j) v[q][j] = __builtin_nontemporal_load(&xr[q * (DM / 4) + 64 * j]); \
            if (WT_) { _Pragma("unroll") for (int q = 0; q < (CNT_); ++q) _Pragma("unroll") for (int j = 0; j < 4; ++j) asm volatile("" : "+v"(v[q][j])); }     \
            _Pragma("unroll") for (int q = 0; q < (CNT_); ++q) { \
                float sq = 0.f; \
                _Pragma("unroll") for (int j = 0; j < 4; ++j) sq += (v[q][j][0] * v[q][j][0] + v[q][j][1] * v[q][j][1]) + (v[q][j][2] * v[q][j][2] + v[q][j][3] * v[q][j][3]); \
                sq = wave_sum(sq); \
                u32x2* o8 = (u32x2*)(XB + (size_t)(r0 + q) * DM) + lane; \
                _Pragma("unroll") for (int j = 0; j < 4; ++j) { u32x2 w; w.x = cvtpk(v[q][j][0], v[q][j][1]); w.y = cvtpk(v[q][j][2], v[q][j][3]); if (WT_) st8wt(o8 + 64 * j, w); else st8(o8 + 64 * j, w); } \
                if (lane == 0) { const f32x4 s4 = (f32x4){sq, 0.f, 0.f, 0.f}; if (WT_) st16wt(SSQ + (size_t)(r0 + q) * 4, __builtin_bit_cast(u32x4, s4)); else *(f32x4*)(SSQ + (size_t)(r0 + q) * 4) = s4; } \
            } } while (0)

__global__ void __launch_bounds__(NWAVES * 64, 2) mk_fwd(Args args) {
    __shared__ __attribute__((aligned(16))) unsigned char lds_raw[LDS_BYTES];
    LAS unsigned char* lds = (LAS unsigned char*)lds_raw;
    volatile LAS unsigned* MISC = (volatile LAS unsigned*)(lds + MISC_OFF);
    const int tid0 = threadIdx.x;
    const int G = gridDim.x; const int bx = blockIdx.x; const int vcu = (G % 8 == 0) ? (bx % 8) * (G / 8) + bx / 8 : bx;
    unsigned char* ws = args.ws;
    const float* x = args.in[0]; const float* cvec = args.in[1]; const float* w_ada = args.in[2]; const float* b_ada = args.in[3]; const float* norm_gain = args.in[4]; const float* w_in = args.in[5];
    const float* q_gain = args.in[6]; const float* k_gain = args.in[7]; const float* sink = args.in[8]; const float* w_s = args.in[9]; const float* b_s = args.in[10]; const float* w_out = args.in[11];
    float* out = args.out;
    float* ADA = (float*)(ws + WS_ADA); float* BIAS = (float*)(ws + WS_BIAS); float* SSQ = (float*)(ws + WS_SSQ);
    bf16_t* WIN = (bf16_t*)(ws + WS_WIN); bf16_t* WOUT = (bf16_t*)(ws + WS_WOUT); bf16_t* WSB = (bf16_t*)(ws + WS_WS);
    bf16_t* XB = (bf16_t*)(ws + WS_XB); bf16_t* Y = (bf16_t*)(ws + WS_Y); bf16_t* PB = (bf16_t*)(ws + WS_PB);
    if (tid0 < 64) MISC[tid0] = 0u;
    __syncthreads();
    const int lo = args.ph_lo, hi = args.ph_hi;
#define STAMP(i_) do { const unsigned long long t_ = __builtin_amdgcn_s_memrealtime(); if (threadIdx.x == 0) { MISC[16 + 2 * (i_)] = (unsigned)t_; MISC[17 + 2 * (i_)] = (unsigned)(t_ >> 32); } } while (0)
    if (PROBE_TS >= 0) STAMP(0);
    XcdBarrier bar; bar.bar = (unsigned*)(ws + WS_CTL) + CW_BAR; bar.x = 0; bar.st = MISC + 8;
    if (hi - lo > 1) bar = xcd_barrier_post((unsigned*)(ws + WS_CTL) + CW_BAR, MISC + 8);
#define IN(k) (lo <= (k) && (k) < hi)
#define SEAM(k) do { if ((k) + 1 < hi) xcd_barrier(bar); if (PROBE_TS == (k)) STAMP(1); } while (0)
#define REPS(k) (((k) == PROBE_REP) ? 2 : 1)

  for (int pass_ = 0; pass_ < PROBE_PASSES; ++pass_) {
    int tid = threadIdx.x; asm volatile("" : "+v"(tid));
    const int lane = tid & 63, wave = __builtin_amdgcn_readfirstlane(tid >> 6);
    const int gw = vcu * NWAVES + wave, NGW = G * NWAVES;
    if (((PH_MASK >> 0) & 1) && IN(0)) {
      for (int rep_ = 0; rep_ < REPS(0); ++rep_) {
        if (bx < NL * 2 * 48) {
            const int l = bx / 96, r = bx % 96, kh = r / 48, cb = r % 48, cg = lane & 15, rg = lane >> 4;
            const int k0 = 512 * kh + 64 * wave + 16 * rg;
            const float* wp = w_ada + ((size_t)l * DM + k0) * 3 * DM + 64 * cb + 4 * cg;
            f32x4 wr_[16];
#pragma unroll
            for (int i = 0; i < 16; ++i) wr_[i] = __builtin_nontemporal_load((const f32x4*)(wp + (size_t)i * 3 * DM));
            f32x4 a0 = {0.f, 0.f, 0.f, 0.f}, a1 = {0.f, 0.f, 0.f, 0.f};
#pragma unroll
            for (int i = 0; i < 16; ++i) { const float s0 = fsilu(cvec[k0 + i]), s1 = fsilu(cvec[DM + k0 + i]); a0 += wr_[i] * s0; a1 += wr_[i] * s1; }
#pragma unroll
            for (int e = 0; e < 4; ++e) { a0[e] += __shfl_xor(a0[e], 16); a0[e] += __shfl_xor(a0[e], 32); a1[e] += __shfl_xor(a1[e], 16); a1[e] += __shfl_xor(a1[e], 32); }
            LAS float* red = (LAS float*)lds;
            if (rg == 0) { *(LAS f32x4*)(red + (wave * 2 + 0) * 64 + 4 * cg) = a0; *(LAS f32x4*)(red + (wave * 2 + 1) * 64 + 4 * cg) = a1; }
            __syncthreads();
            if (tid < 128) {
                const int b = tid >> 6, n = tid & 63;
                float sum = (kh == 0) ? b_ada[l * 3 * DM + 64 * cb + n] : 0.f;
#pragma unroll
                for (int w = 0; w < 8; ++w) sum += red[(w * 2 + b) * 64 + n];
                atomicAdd(ADA + (size_t)(l * 2 + b) * 3 * DM + 64 * cb + n, sum);
            }
            __syncthreads();
        }
        if (PROBE_TS == 100) STAMP(1);
        for (int it = gw; it < NL * 8 * 128 * 128 / 512; it += NGW) {
            const float* sp = w_s + (size_t)it * 512 + lane * 8; const f32x4 a = *(const f32x4*)sp, b2 = *(const f32x4*)(sp + 4);
            u32x4 o; o.x = pk2(a[0], a[1]); o.y = pk2(a[2], a[3]); o.z = pk2(b2[0], b2[1]); o.w = pk2(b2[2], b2[3]);
            *(u32x4*)(WSB + (size_t)it * 512 + lane * 8) = o; }
        XROWS(gw * 4, 4, 0);
      }
        if (PROBE_TS == 101) STAMP(1);
        SEAM(0);
    }
    if (((PH_MASK >> 1) & 1) && IN(1)) {
      for (int rep_ = 0; rep_ < REPS(1); ++rep_) {
        tr_run(gw, TR_I_IN, NGW, lane, (LAS float*)(lds + wave * 16384), w_in, w_out, norm_gain, ADA, BIAS, WIN, WOUT);
      }
        if (PROBE_TS == 111) STAMP(1);
        for (int xb_ = 0; xb_ < PROBE_BAR; ++xb_) SEAM(1);
        SEAM(1);
        if (lo < 2 && (bx % 8) >= 4) {
            int tid3 = threadIdx.x; asm volatile("" : "+v"(tid3));
            const int lane3 = tid3 & 63, wave3 = __builtin_amdgcn_readfirstlane(tid3 >> 6);
            const int pmb = 8 * (bx % 8) + (bx / 8) % 8, qb3 = (bx / 64) & 3;
            { const int lane = lane3; XROWS(256 * pmb + 64 * qb3 + 8 * wave3, 8, 1); }
            asm volatile("s_waitcnt vmcnt(0)" ::: "memory");
            __syncthreads();
            if (tid3 == 0) __hip_atomic_fetch_add((unsigned*)(ws + WS_CTL) + CW_PANEL0 + pmb * 2, 1u, __ATOMIC_RELAXED, __HIP_MEMORY_SCOPE_AGENT);
            const int gwB = (((bx % 8) - 4) * 32 + bx / 8) * NWAVES + wave3;
            tr_run(TR_I_IN + gwB, TR_I_IN + TR_I_OUT, (G / 2) * NWAVES, lane3, (LAS float*)(lds + wave3 * 16384), w_in, w_out, norm_gain, ADA, BIAS, WIN, WOUT);
            asm volatile("s_waitcnt vmcnt(0)" ::: "memory");
            __syncthreads();
            if (tid3 == 0) __hip_atomic_fetch_add((unsigned*)(ws + WS_CTL) + CW_CONV0, 1u, __ATOMIC_RELAXED, __HIP_MEMORY_SCOPE_AGENT);
        }
    }
    for (int l = 0; l < NL; ++l) {
        const int p0 = 2 + 3 * l;
        if (((PH_MASK >> 2) & 1) && IN(p0)) {
            if (l == 0 && lo < 2 && (bx % 8) >= 4) {
                if (tid == 0) { unsigned sp_ = 0;
                    while (__hip_atomic_load((unsigned*)(ws + WS_CTL) + CW_PANEL0 + (8 * (bx % 8) + (bx / 8) % 8) * 2, __ATOMIC_RELAXED, __HIP_MEMORY_SCOPE_AGENT) < 4u) { if (++sp_ > (1u << 22)) break; }
                    __builtin_amdgcn_fence(__ATOMIC_ACQUIRE, "agent"); asm volatile("s_waitcnt vmcnt(0)" ::: "memory"); }
                __syncthreads();
            }
            if (l == 1 && lo < 3 && 5 < hi) {
                if (tid == 0) { unsigned sp_ = 0;
                    poll3((unsigned*)(ws + WS_CTL) + CW_PANEL2 + (8 * (bx % 8) + (bx / 8) % 8) * 16, 4u,
                          (unsigned*)(ws + WS_CTL) + CW_MIXDONE + 16 * ((bx % 8) >= 4 ? 1 : 0), (unsigned)(G / 2),
                          (unsigned*)(ws + WS_CTL) + CW_CONVDONE, (unsigned)(3 * G - (M / 256) * (DIN / 256)));
                    __builtin_amdgcn_fence(__ATOMIC_ACQUIRE, "agent"); asm volatile("s_waitcnt vmcnt(0)" ::: "memory"); }
                __syncthreads();
            }
            if (DESYNC_TICKS > 0 && l == 0 && lo < 2 && (bx % 8) >= 4) { const unsigned long long t0_ = __builtin_amdgcn_s_memrealtime(); while (__builtin_amdgcn_s_memrealtime() - t0_ < (unsigned long long)DESYNC_TICKS) __builtin_amdgcn_s_sleep(8); }
            pg8::Gemm g{XB, WIN + (size_t)l * 2 * DIN * DM, M, DIN, DM, (size_t)DIN * DM * 2, nullptr, nullptr, 0}; pg8::StaticOrder S; S.init(M, DIN, G, bx);
            pg8::EpiProj E{PB, SSQ, BIAS + l * 2 * DIN, q_gain + l * 64, k_gain + l * 64};
            for (int rep_ = 0; rep_ < REPS(p0); ++rep_) pg8::gemm_phase<pg8::EpiProj, true>(lds, g, S, E, l == 0);
            if (l == 0 && bx >= (M / 256) * (DIN / 256) - 2 * G) {
                __syncthreads();
                int tid2 = threadIdx.x; asm volatile("" : "+v"(tid2));
                const int lane2 = tid2 & 63, wave2 = __builtin_amdgcn_readfirstlane(tid2 >> 6);
                const int nidle = G - ((M / 256) * (DIN / 256) - 2 * G), dw = (bx - (G - nidle)) * NWAVES + wave2;
                tr_run(TR_I_IN + TR_I_OUT + dw, TR_TOTAL, nidle * NWAVES, lane2, (LAS float*)(lds + wave2 * 16384), w_in, w_out, norm_gain, ADA, BIAS, WIN, WOUT);
                if (PROBE_TS == 126) STAMP(1);
            }
            if (PROBE_TS == 127 && l == 0) STAMP(1);
            if (lo < 2 && p0 + 1 < hi) {
                asm volatile("s_waitcnt vmcnt(0)" ::: "memory");
                __syncthreads();
                if (tid == 0) { __hip_atomic_fetch_add((unsigned*)(ws + WS_CTL) + CW_PANEL3 + (l * 64 + 8 * (bx % 8) + (bx / 8) % 8) * 4, 1u, __ATOMIC_RELAXED, __HIP_MEMORY_SCOPE_AGENT);
                    if (l == 0 && bx >= (M / 256) * (DIN / 256) - 2 * G) __hip_atomic_fetch_add((unsigned*)(ws + WS_CTL) + CW_CONVDONE, 1u, __ATOMIC_RELAXED, __HIP_MEMORY_SCOPE_AGENT); }
            } else SEAM(p0);
        }
        if (((PH_MASK >> 3) & 3) && IN(p0 + 1)) {
            const float qv_pre = __builtin_fabsf(q_gain[l * 64 + lane]), kv_pre = __builtin_fabsf(k_gain[l * 64 + lane]);
            if (lo < 2 && p0 + 1 < hi) {
                const int pmw = 8 * (bx % 8) + (bx / 8) % 8, qw = (bx / 64) & 3;
                const int nbw = (qw & 1) ? ((pmw & 31) < 31 ? pmw + 1 : pmw) : ((pmw & 31) > 0 ? pmw - 1 : pmw);
                if (tid == 0) { unsigned sp_ = 0;
                    poll3((unsigned*)(ws + WS_CTL) + CW_PANEL3 + (l * 64 + pmw) * 4, 4u, (unsigned*)(ws + WS_CTL) + CW_PANEL3 + (l * 64 + nbw) * 4, 4u,
                          (unsigned*)(ws + WS_CTL) + CW_CONV0, l == 0 ? (unsigned)(G / 2) : 0u);
                    __builtin_amdgcn_fence(__ATOMIC_ACQUIRE, "agent"); asm volatile("s_waitcnt vmcnt(0)" ::: "memory"); }
                __syncthreads();
            }
            float aq = qv_pre, ak = kv_pre;
            {
#pragma unroll
              for (int o = 1; o < 64; o <<= 1) { aq = fmaxf(aq, __shfl_xor(aq, o)); ak = fmaxf(ak, __shfl_xor(ak, o)); } }
            const float sb2 = 8.f * aq * ak * LOG2E;
          for (int rep_ = 0; rep_ < REPS(p0 + 1); ++rep_) {
            const int pmx = 8 * (bx % 8) + (bx / 8) % 8, qx = (bx / 64) & 3;
            if ((PH_MASK >> 3) & 1) mix::attn_unit(pmx >> 5, qx >> 1, 2 * (pmx & 31) + (qx & 1), PB, Y, sink + l * 8, sb2, lds);
            if ((PH_MASK >> 4) & 1) mix::gmlp_half(((2 * pmx + (qx >> 1)) << 4) | ((4 * (qx & 1) + (wave >> 1)) << 1) | (wave & 1), PB, Y, WSB + (size_t)l * 8 * 128 * 128, b_s + l * 8 * 128, lds + wave * 16384);
            if (REPS(p0 + 1) > 1) __syncthreads();
          }
            if (PROBE_TS == 134 && l == 0) STAMP(1);
            if (p0 + 2 < hi) {
                asm volatile("s_waitcnt vmcnt(0)" ::: "memory");
                __syncthreads();
                if (tid == 0) { __hip_atomic_fetch_add((unsigned*)(ws + WS_CTL) + CW_PANEL + (l * 64 + 8 * (bx % 8) + (bx / 8) % 8) * 16, 1u, __ATOMIC_RELAXED, __HIP_MEMORY_SCOPE_AGENT);
                    if (l == 0) __hip_atomic_fetch_add((unsigned*)(ws + WS_CTL) + CW_MIXDONE + 16 * ((bx % 8) >= 4 ? 1 : 0), 1u, __ATOMIC_RELAXED, __HIP_MEMORY_SCOPE_AGENT); }
            }
        }
        if (((PH_MASK >> 5) & 1) && IN(p0 + 2)) {
            pg8::Gemm g{Y, WOUT + (size_t)l * 2 * DM * DM, M, DM, DM, (size_t)DM * DM * 2, nullptr, nullptr, 0}; pg8::StaticOrder S; S.init(M, DM, G, bx);
            const bool lastl = (l == NL - 1);
            pg8::EpiOut E{lastl ? nullptr : XB, out, SSQ, XB};
            const pg8::PanelWait PW{(unsigned*)(ws + WS_CTL) + CW_PANEL + (l * 64 + 8 * (bx % 8) + (bx / 8) % 8) * 16, 4u, lo < p0 + 2};
            for (int rep_ = 0; rep_ < REPS(p0 + 2); ++rep_) pg8::gemm_phase<pg8::EpiOut, false, pg8::PanelWait>(lds, g, S, E, 0, PW);
            if (l == 0 && lo < p0 + 1 && p0 + 3 < hi) {
                asm volatile("s_waitcnt vmcnt(0)" ::: "memory");
                __syncthreads();
                if (tid == 0) __hip_atomic_fetch_add((unsigned*)(ws + WS_CTL) + CW_PANEL2 + (8 * (bx % 8) + (bx / 8) % 8) * 16, 1u, __ATOMIC_RELAXED, __HIP_MEMORY_SCOPE_AGENT);
            } else SEAM(p0 + 2);
        }
    }
    if (pass_ + 1 < PROBE_PASSES) xcd_barrier(bar);
  }
    if (PROBE_TS >= 0) { xcd_barrier(bar); if (vcu == PROBE_VCU && threadIdx.x == 0) { const unsigned long long a_ = ((unsigned long long)MISC[19] << 32) | MISC[18], b_ = ((unsigned long long)MISC[17] << 32) | MISC[16]; out[0] += ((float)(a_ - b_) * 0.01f - PROBE_TS_OFF) * PROBE_TS_SCALE; } }
#undef IN
#undef SEAM
}

extern "C" void kernel_launch(void* const* d_in, const int* in_sizes, int n_in, void* d_out, int out_size, void* d_ws, size_t ws_size, hipStream_t stream) {
    static int grid = 0;
    if (grid == 0) {
        if (n_in != 12 || in_sizes[0] != M * DM || out_size != M * DM || ws_size < WS_END) { fprintf(stderr, "kernel_launch: unexpected shapes (n_in %d, in0 %d, out %d, ws %zu)\n", n_in, n_in > 0 ? in_sizes[0] : -1, out_size, ws_size); grid = -1; return; }
        int dev = 0, cus = 0, per_cu = 0;
        if (hipGetDevice(&dev) != hipSuccess || hipDeviceGetAttribute(&cus, hipDeviceAttributeMultiprocessorCount, dev) != hipSuccess) { grid = -1; return; }
        if (hipOccupancyMaxActiveBlocksPerMultiprocessor(&per_cu, (const void*)mk_fwd, NWAVES * 64, 0) != hipSuccess || per_cu < 1) { fprintf(stderr, "kernel_launch: occupancy query says %d\n", per_cu); per_cu = 1; }
        (void)hipGetLastError();
        grid = cus;
    }
    if (grid < 0) return;
    (void)hipMemsetAsync((char*)d_ws + WS_CTL, 0, CTL_ZERO_BYTES, stream);
    Args a{};
    for (int i = 0; i < 12; ++i) a.in[i] = (const float*)d_in[i];
    a.out = (float*)d_out; a.ws = (unsigned char*)d_ws;
#if MK_PER_PHASE
    for (int p = 0; p < 8; ++p) { a.ph_lo = p; a.ph_hi = p + 1; hipLaunchKernelGGL(mk_fwd, dim3(grid), dim3(NWAVES * 64), 0, stream, a); }
#else
    a.ph_lo = 0; a.ph_hi = 8;
    hipLaunchKernelGGL(mk_fwd, dim3(grid), dim3(NWAVES * 64), 0, stream, a);
#endif
}
```

```cpp
#include <hip/hip_runtime.h>
#include <cstdio>
#include <cstdint>

#ifndef PH_MASK
#define PH_MASK 0xff
#endif
#ifndef PROBE_REP
#define PROBE_REP -1
#endif
#ifndef PROBE_BAR
#define PROBE_BAR 0
#endif
#ifndef PROBE_PASSES
#define PROBE_PASSES 1
#endif
#ifndef PROBE_VCU
#define PROBE_VCU 0
#endif
#ifndef DESYNC_TICKS
#define DESYNC_TICKS 0
#endif
#define PROBE_TS_OFF 0.0f
#ifndef PROBE_TS_SCALE
#define PROBE_TS_SCALE 0.05f
#endif
#ifndef PROBE_TS
#define PROBE_TS -1
#endif
#ifndef MK_PER_PHASE
#define MK_PER_PHASE 0
#endif

constexpr int NB = 2, SEQ = 8192, DM = 1024, M = NB * SEQ, DIN = 2816, NL = 2;
constexpr int OFF_Q = 0, OFF_K = 512, OFF_V = 640, OFF_GA = 768, OFF_U = 1280, OFF_VG = 1792, OFF_GG = 2304;
constexpr float EPS = 1e-6f;
constexpr float LOG2E = 1.4426950408889634f;
constexpr float C2 = 0.125f * LOG2E;

#define LAS __attribute__((address_space(3)))
#define GAS __attribute__((address_space(1)))
typedef unsigned short bf16_t;
typedef short bf16x8 __attribute__((ext_vector_type(8)));
typedef short s16x4 __attribute__((ext_vector_type(4)));
typedef float f32x4 __attribute__((ext_vector_type(4)));
typedef float f32x16 __attribute__((ext_vector_type(16)));
typedef unsigned u32x4 __attribute__((ext_vector_type(4)));
typedef unsigned u32x2 __attribute__((ext_vector_type(2)));
typedef GAS unsigned gu32;

__device__ __forceinline__ unsigned f2bf(float f) { unsigned u = __builtin_bit_cast(unsigned, f); return (u + 0x7fffu + ((u >> 16) & 1u)) >> 16; }
__device__ __forceinline__ unsigned pk2(float lo, float hi) { return f2bf(lo) | (f2bf(hi) << 16); }
__device__ __forceinline__ float bf2f(unsigned short h) { return __builtin_bit_cast(float, (unsigned)h << 16); }
__device__ __forceinline__ float bflo(unsigned w) { return __builtin_bit_cast(float, w << 16); }
__device__ __forceinline__ float bfhi(unsigned w) { return __builtin_bit_cast(float, w & 0xffff0000u); }
typedef float f32x2_t __attribute__((ext_vector_type(2))); typedef __bf16 bf16x2_t __attribute__((ext_vector_type(2)));
__device__ __forceinline__ unsigned cvtpk(float lo, float hi) { f32x2_t v = {lo, hi}; bf16x2_t b = __builtin_convertvector(v, bf16x2_t); return __builtin_bit_cast(unsigned, b); }
__device__ __forceinline__ float fsilu(float v) { return v * __builtin_amdgcn_rcpf(1.f + __builtin_amdgcn_exp2f(-LOG2E * v)); }
__device__ __forceinline__ float wave_sum(float v) {
#pragma unroll
    for (int o = 1; o < 64; o <<= 1) v += __shfl_xor(v, o);
    return v;
}

#ifndef MK_BAR_EVERY_WG_RELEASES
#define MK_BAR_EVERY_WG_RELEASES 0
#endif
#ifndef MK_WT
#define MK_WT 0
#endif
__device__ __forceinline__ void st16(void* p, u32x4 v) {
#if MK_WT
    asm volatile("global_store_dwordx4 %0, %1, off sc1\n\ts_nop 1" :: "v"(p), "v"(v) : "memory");
#else
    *(u32x4*)p = v;
#endif
}
__device__ __forceinline__ void st8wt(void* p, u32x2 v) { asm volatile("global_store_dwordx2 %0, %1, off sc1\n\ts_nop 1" :: "v"(p), "v"(v) : "memory"); }
__device__ __forceinline__ void st16wt(void* p, u32x4 v) { asm volatile("global_store_dwordx4 %0, %1, off sc1\n\ts_nop 1" :: "v"(p), "v"(v) : "memory"); }
__device__ __forceinline__ void st8(void* p, u32x2 v) {
#if MK_WT
    asm volatile("global_store_dwordx2 %0, %1, off sc1\n\ts_nop 1" :: "v"(p), "v"(v) : "memory");
#else
    *(u32x2*)p = v;
#endif
}
__device__ __forceinline__ void glds16s(const void* sbase, unsigned voff, unsigned lds_dst) { unsigned keep;
    asm volatile("s_nop 4\n\ts_mov_b32 %0, m0\n\ts_mov_b32 m0, %3\n\ts_nop 0\n\tglobal_load_lds_dwordx4 %1, %2\n\ts_mov_b32 m0, %0" : "=&s"(keep) : "v"(voff), "s"(sbase), "s"(lds_dst) : "memory"); }
__device__ __forceinline__ void glds16k(const void* sbase, unsigned voff, unsigned lds_dst) {
    asm volatile("s_mov_b32 m0, %2\n\ts_nop 0\n\tglobal_load_lds_dwordx4 %0, %1" :: "v"(voff), "s"(sbase), "s"(lds_dst) : "memory"); }

namespace pg8 {
constexpr int BM = 256, BK = 64, HALF = 128, HTB = HALF * BK * 2, STAGE_BYTES = 8 * HTB, NXCD = 8, WGM = 8;
__host__ __device__ __forceinline__ int lds_byte(int r, int c) { const int st = (r >> 4) * 2 + (c >> 5), rr = r & 15, cc = c & 31, ob = rr * 64 + cc * 2; return st * 1024 + (ob ^ (((ob >> 9) & 1) << 5)); }
__host__ __device__ __forceinline__ void stage_rc(int b, int& R, int& C) { const int st = b / 1024, sb = b % 1024, swz = sb ^ (((sb >> 9) & 1) << 5); R = (st >> 1) * 16 + swz / 64; C = (st & 1) * 32 + (swz % 64) / 2; }
__host__ __device__ __forceinline__ int perm32(int rho) { const int n = rho >> 4, i = rho & 15; return 8 * (i >> 2) + 4 * n + (i & 3); }

struct Unit { int pm, pn; };
struct Gemm { const bf16_t* A; const bf16_t* Bt; int M, N, K; size_t bstride;
              const bf16_t* Ax; const bf16_t* Bx; int nxt; };

struct StaticOrder {
    int nM, nN, nwg, G, c;
    __host__ __device__ void init(int M_, int N_, int G_, int c_) { nM = M_ / BM; nN = N_ / BM; nwg = nM * nN; G = G_; c = c_; }
    __host__ __device__ bool next(int i, Unit& u) const {
        const long L = (long)i * G + c; if (L >= nwg) return false;
        int wgid = (int)L; { const int q = nwg / NXCD, r = nwg % NXCD, xcd = wgid % NXCD, off = wgid / NXCD; wgid = (xcd < r ? xcd * (q + 1) : r * (q + 1) + (xcd - r) * q) + off; }
        const int nig = WGM * nN, gid = wgid / nig, fm = gid * WGM, gsz = (nM - fm) < WGM ? (nM - fm) : WGM;
        u.pm = fm + ((wgid % nig) % gsz); u.pn = (wgid % nig) / gsz; return true;
    }
};

#define STAMPG(i_) do { const unsigned long long t_ = __builtin_amdgcn_s_memrealtime(); if (threadIdx.x == 0) { volatile LAS unsigned* M_ = (volatile LAS unsigned*)(lds + 136 * 1024); M_[16 + 2 * (i_)] = (unsigned)t_; M_[17 + 2 * (i_)] = (unsigned)(t_ >> 32); } } while (0)
struct NoWait { __device__ __forceinline__ void operator()() const {} };
struct PanelWait { unsigned* cnt; unsigned target; bool active;
    __device__ __forceinline__ void operator()() const {
        if (!active) return;
        if (threadIdx.x == 0) { unsigned sp_ = 0; while (__hip_atomic_load(cnt, __ATOMIC_RELAXED, __HIP_MEMORY_SCOPE_AGENT) < target) { if (++sp_ > (1u << 22)) break; }
            __builtin_amdgcn_fence(__ATOMIC_ACQUIRE, "agent"); asm volatile("s_waitcnt vmcnt(0)" ::: "memory"); }
        __syncthreads();
    } };
template <class Epi, bool ALIGN_EPI, class Wait = NoWait>
__device__ __forceinline__ void gemm_phase(LAS unsigned char* lds, const Gemm g, const StaticOrder& S, const Epi& E, const int probe = 0, const Wait& W = Wait()) {
    int tid = threadIdx.x; asm volatile("" : "+v"(tid));
    const int wid = __builtin_amdgcn_readfirstlane(tid >> 6), lane = tid & 63, wr = wid >> 2, wc = wid & 3, fr = lane & 15, fq = lane >> 4;
    const int K = g.K, nt = K / BK;
    unsigned voffA[2], voffB0[2], voffB1[2];
#pragma unroll
    for (int i = 0; i < 2; ++i) { int R, C; stage_rc(tid * 16 + i * 8192, R, C); const int cb = 64 * (R >> 5) + perm32(R & 31);
        voffA[i] = (unsigned)(R * K + C) * 2u; voffB0[i] = (unsigned)(cb * K + C) * 2u; voffB1[i] = (unsigned)((cb + 32) * K + C) * 2u; }
    const size_t kstep = (size_t)(BK * 2);
    const size_t hstep = (size_t)HALF * K * 2;
    const size_t tstep = 2 * hstep;
    const unsigned ldsw = (unsigned)wid * 1024u;
    const unsigned lds0 = (unsigned)(uintptr_t)lds;
    const int aoff = lds_byte(wr * 64 + fr, fq * 8);
    int boffB = 4 * HTB + lds_byte(wc * 32 + fr, fq * 8); asm volatile("" : "+v"(boffB));
#define PG8_SA(b, h) (((b) * 2 + (h)) * HTB)
#define PG8_SB(b, h) ((4 + (b) * 2 + (h)) * HTB)
#define PG8_SBR(b, h) (((b) * 2 + (h)) * HTB)
#define PG8_STAGE(bufoff, gbase, voff) do { _Pragma("unroll") for (int _i = 0; _i < 2; ++_i) \
        glds16s((const void*)(gbase), (voff)[_i], (unsigned)__builtin_amdgcn_readfirstlane((int)(lds0 + (unsigned)(bufoff) + ldsw + (unsigned)_i * 8192u))); } while (0)
#define PG8_STAGEK(bufoff, gbase, voff) do { _Pragma("unroll") for (int _i = 0; _i < 2; ++_i) \
        glds16k((const void*)(gbase), (voff)[_i], (unsigned)__builtin_amdgcn_readfirstlane((int)(lds0 + (unsigned)(bufoff) + ldsw + (unsigned)_i * 8192u))); } while (0)
#define PG8_LDA(dst, b, h) do { _Pragma("unroll") for (int m = 0; m < 4; ++m) _Pragma("unroll") for (int k = 0; k < 2; ++k) dst[m][k] = *(const LAS bf16x8*)(lds + PG8_SA(b, h) + aoff + m * 2048 + k * 1024); } while (0)
#define PG8_LDB(dst, b, h) do { _Pragma("unroll") for (int n = 0; n < 2; ++n) _Pragma("unroll") for (int k = 0; k < 2; ++k) dst[n][k] = *(const LAS bf16x8*)(lds + boffB + (PG8_SBR(b, h) + n * 2048 + k * 1024)); } while (0)
#define PG8_MMA(ai, bj, At, Bt) do { __builtin_amdgcn_s_setprio(1); _Pragma("unroll") for (int m = 0; m < 4; ++m) _Pragma("unroll") for (int n = 0; n < 2; ++n) _Pragma("unroll") for (int k = 0; k < 2; ++k) \
        acc[ai][bj][m][n] = __builtin_amdgcn_mfma_f32_16x16x32_bf16(Bt[n][k], At[m][k], acc[ai][bj][m][n], 0, 0, 0); __builtin_amdgcn_s_setprio(0); } while (0)
#define PG8_WAIT_V(n) asm volatile("s_waitcnt vmcnt(" #n ")" ::: "memory")
#define PG8_WAIT_L(n) asm volatile("s_waitcnt lgkmcnt(" #n ")" ::: "memory")
#define PG8_BAR __builtin_amdgcn_s_barrier()
#define PG8_SCHED __builtin_amdgcn_sched_barrier(0)
    Unit cur, nxt; int ui = 0;
    if (!S.next(0, cur)) return;
    f32x4 acc[2][2][4][2];
    u32x4 ini[2][4][2];
    if constexpr (Epi::ACC_INIT) E.load_init(ini, cur, wr, wc, fr, fq);
    W();
    if constexpr (Epi::ACC_INIT) {
#pragma unroll
        for (int a = 0; a < 2; ++a)
#pragma unroll
            for (int m = 0; m < 4; ++m)
#pragma unroll
                for (int b = 0; b < 2; ++b) asm volatile("" : "+v"(ini[a][m][b]));
    }
    bf16x8 At[4][2], B0[2][2], B1[2][2];
    const int ntot = nt + g.nxt;
#define PG8_UA(u_) ((const char*)g.A + (size_t)(u_).pm * tstep)
#define PG8_UB(u_) ((const char*)g.Bt + (size_t)((u_).pm >> 5) * g.bstride + (size_t)(u_).pn * tstep)
#define PG8_UX(u_) ((const char*)g.Ax + (size_t)(u_).pm * tstep + (size_t)(u_).pn * 512)
    const char* cA = PG8_UA(cur); const char* cB = PG8_UB(cur); const char* xA = PG8_UX(cur); const char* xB = (const char*)g.Bx;
    PG8_STAGE(PG8_SB(0, 0), cB, voffB0); PG8_STAGE(PG8_SB(0, 1), cB, voffB1); PG8_STAGE(PG8_SA(0, 0), cA, voffA); PG8_STAGE(PG8_SA(0, 1), cA + hstep, voffA);
    if (wr == 1) PG8_BAR;
    PG8_WAIT_V(2); PG8_BAR;
    PG8_STAGE(PG8_SB(1, 0), cB + kstep, voffB0); PG8_STAGE(PG8_SA(1, 0), cA + kstep, voffA); PG8_STAGE(PG8_SB(1, 1), cB + kstep, voffB1);
    if constexpr (Epi::ACC_INIT) {
#pragma unroll
        for (int a = 0; a < 2; ++a)
#pragma unroll
            for (int m = 0; m < 4; ++m)
#pragma unroll
                for (int b = 0; b < 2; ++b) { const u32x4 t = ini[a][m][b]; acc[a][b][m][0] = (f32x4){bflo(t.x), bfhi(t.x), bflo(t.y), bfhi(t.y)}; acc[a][b][m][1] = (f32x4){bflo(t.z), bfhi(t.z), bflo(t.w), bfhi(t.w)}; }
    } else {
#pragma unroll
        for (int a = 0; a < 2; ++a)
#pragma unroll
            for (int b = 0; b < 2; ++b)
#pragma unroll
                for (int m = 0; m < 4; ++m)
#pragma unroll
                    for (int n = 0; n < 2; ++n) acc[a][b][m][n] = (f32x4){0.f, 0.f, 0.f, 0.f};
    }
    PG8_WAIT_V(6); PG8_BAR;
    for (;;) {
        const bool has_next = S.next(ui + 1, nxt);
        const char* nA = has_next ? PG8_UA(nxt) : cA; const char* nB = has_next ? PG8_UB(nxt) : cB;
        for (int t = 0; t < ntot; t += 2) {
            const char* a1 = (t < nt ? cA + (size_t)(t + 1) * kstep : xA + (size_t)(t + 1 - nt) * kstep);
            const int t2 = t + 2;
            const char* a2 = t2 < nt ? cA + (size_t)t2 * kstep : (t2 < ntot ? xA + (size_t)(t2 - nt) * kstep : nA);
            const char* b2 = t2 < nt ? cB + (size_t)t2 * kstep : (t2 < ntot ? xB + (size_t)(t2 - nt) * kstep : nB);
            const char* a3 = a2 + kstep; const char* b3 = b2 + kstep;
            PG8_LDB(B0, 0, 0); PG8_LDB(B1, 0, 1); PG8_SCHED; PG8_LDA(At, 0, 0); PG8_STAGEK(PG8_SA(1, 1), a1 + hstep, voffA);
            PG8_WAIT_V(8); PG8_WAIT_L(0); PG8_BAR; PG8_MMA(0, 0, At, B0); PG8_MMA(0, 1, At, B1); PG8_BAR; PG8_SCHED;
            PG8_LDA(At, 0, 1); PG8_STAGEK(PG8_SB(0, 0), b2, voffB0); PG8_STAGEK(PG8_SB(0, 1), b2, voffB1); PG8_STAGEK(PG8_SA(0, 0), a2, voffA);
            PG8_WAIT_V(8); PG8_WAIT_L(0); PG8_BAR; PG8_MMA(1, 0, At, B0); PG8_MMA(1, 1, At, B1); PG8_BAR; PG8_SCHED;
            PG8_LDB(B0, 1, 0); PG8_LDB(B1, 1, 1); PG8_SCHED; PG8_LDA(At, 1, 0); PG8_STAGEK(PG8_SA(0, 1), a2 + hstep, voffA);
            PG8_WAIT_V(8); PG8_WAIT_L(0); PG8_BAR; PG8_MMA(0, 0, At, B0); PG8_MMA(0, 1, At, B1); PG8_BAR; PG8_SCHED;
            PG8_LDA(At, 1, 1); PG8_STAGEK(PG8_SB(1, 0), b3, voffB0); PG8_STAGEK(PG8_SB(1, 1), b3, voffB1); PG8_STAGEK(PG8_SA(1, 0), a3, voffA);
            PG8_WAIT_V(8); PG8_WAIT_L(0); PG8_BAR; PG8_MMA(1, 0, At, B0); PG8_MMA(1, 1, At, B1); PG8_BAR; PG8_SCHED;
        }
        if constexpr (ALIGN_EPI) { if (wr == 0) PG8_BAR; }
        if (PROBE_TS == 120 && probe && ui == 0) STAMPG(1);
        if (PROBE_TS == 122 && probe && ui == 1) STAMPG(1);
        if (PROBE_TS == 124 && probe && ui == 2) STAMPG(1);
        if constexpr (!Epi::AFTER_DRAIN) { E(acc, cur, wr, wc, fr, fq); }
        if (PROBE_TS == 121 && probe && ui == 0) STAMPG(1);
        if (PROBE_TS == 123 && probe && ui == 1) STAMPG(1);
        if (PROBE_TS == 125 && probe && ui == 2) STAMPG(1);
        if (!has_next) break;
#pragma unroll
        for (int a = 0; a < 2; ++a)
#pragma unroll
            for (int b = 0; b < 2; ++b)
#pragma unroll
                for (int m = 0; m < 4; ++m)
#pragma unroll
                    for (int n = 0; n < 2; ++n) acc[a][b][m][n] = (f32x4){0.f, 0.f, 0.f, 0.f};
        cur = nxt; cA = nA; cB = nB; xA = PG8_UX(cur); ++ui;
        if constexpr (ALIGN_EPI) { if (wr == 1) PG8_BAR; }
    }
    PG8_WAIT_V(0);
    if constexpr (!ALIGN_EPI) { if (wr == 0) PG8_BAR; }
    PG8_BAR;
    if constexpr (Epi::AFTER_DRAIN) { E.fused(acc, cur, wr, wc, fr, fq, lds, wid, lane); }
#undef PG8_UA
#undef PG8_UB
#undef PG8_UX
#undef PG8_SA
#undef PG8_SB
#undef PG8_SBR
#undef PG8_STAGE
#undef PG8_STAGEK
#undef PG8_LDA
#undef PG8_LDB
#undef PG8_MMA
#undef PG8_WAIT_V
#undef PG8_WAIT_L
#undef PG8_BAR
#undef PG8_SCHED
}

struct EpiProj {
    static constexpr bool AFTER_DRAIN = false, ACC_INIT = false;
    __device__ __forceinline__ void load_init(u32x4 (&)[2][4][2], const Unit&, int, int, int, int) const {}
    bf16_t* PB; const float* ssq4; const float* bias; const float* qg; const float* kg;
    __device__ __forceinline__ void operator()(const f32x4 (&acc)[2][2][4][2], const Unit& u, int wr, int wc, int fr, int fq) const {
        const int b = u.pm >> 5;
        const int colw = u.pn * 256 + wc * 64 + 8 * fq;
        int type;
        if (u.pn < 2) type = 0; else if (u.pn == 2) type = (wc < 2) ? 1 : 2; else if (u.pn < 5) type = 3; else if (u.pn < 9) type = 5; else type = 4;
        const int cst = (type == 5) ? OFF_U + 128 * (u.pn - 5) + 32 * wc + 8 * fq : (type == 4 ? colw - 512 : colw);
        const float* bp = bias + b * DIN + colw;
        f32x4 bv[2][2];
#pragma unroll
        for (int bj = 0; bj < 2; ++bj)
#pragma unroll
            for (int n = 0; n < 2; ++n) bv[bj][n] = *(const f32x4*)(bp + 32 * bj + 4 * n);
        float rstd[2][4];
        const float* sp = ssq4 + (size_t)(u.pm * 256 + wr * 64 + fr) * 4;
#pragma unroll
        for (int ai = 0; ai < 2; ++ai)
#pragma unroll
            for (int m = 0; m < 4; ++m) { const f32x4 s4 = *(const f32x4*)(sp + (size_t)(ai * 128 + m * 16) * 4); rstd[ai][m] = __builtin_amdgcn_rsqf(((s4[0] + s4[1]) + (s4[2] + s4[3])) * (1.f / DM) + EPS); }
        f32x4 gk[2][2];
        if (type == 1) {
#pragma unroll
            for (int bj = 0; bj < 2; ++bj)
#pragma unroll
                for (int n = 0; n < 2; ++n) gk[bj][n] = *(const f32x4*)(kg + 8 * fq + 32 * bj + 4 * n) * *(const f32x4*)(qg + 8 * fq + 32 * bj + 4 * n);
        }
        const float gsc = (type == 0) ? C2 : 1.f;
#pragma unroll
        for (int ai = 0; ai < 2; ++ai)
#pragma unroll
            for (int m = 0; m < 4; ++m) asm volatile("" : "+v"(rstd[ai][m]));
#pragma unroll
        for (int bj = 0; bj < 2; ++bj)
#pragma unroll
            for (int n = 0; n < 2; ++n) { asm volatile("" : "+v"(bv[bj][n])); if (type == 1) asm volatile("" : "+v"(gk[bj][n])); }
#pragma unroll
        for (int ai = 0; ai < 2; ++ai)
#pragma unroll
            for (int m = 0; m < 4; ++m) {
                const int row = u.pm * 256 + ai * 128 + wr * 64 + m * 16 + fr;
                f32x4 v[2][2];
#pragma unroll
                for (int bj = 0; bj < 2; ++bj)
#pragma unroll
                    for (int n = 0; n < 2; ++n) v[bj][n] = acc[ai][bj][m][n] * rstd[ai][m] + bv[bj][n];
                bf16_t* rowp = PB + (size_t)row * DIN + cst;
                if (type == 5) {
#pragma unroll
                    for (int n = 0; n < 2; ++n)
#pragma unroll
                        for (int e = 0; e < 4; ++e) v[0][n][e] = v[0][n][e] * fsilu(v[1][n][e]);
                    u32x4 w; w.x = cvtpk(v[0][0][0], v[0][0][1]); w.y = cvtpk(v[0][0][2], v[0][0][3]); w.z = cvtpk(v[0][1][0], v[0][1][1]); w.w = cvtpk(v[0][1][2], v[0][1][3]);
                    st16wt(rowp, w);
                    continue;
                }
                if (type == 0 || type == 1 || type == 4) {
                    float ss = 0.f;
#pragma unroll
                    for (int bj = 0; bj < 2; ++bj)
#pragma unroll
                        for (int n = 0; n < 2; ++n) ss += (v[bj][n][0] * v[bj][n][0] + v[bj][n][1] * v[bj][n][1]) + (v[bj][n][2] * v[bj][n][2] + v[bj][n][3] * v[bj][n][3]);
                    ss += __shfl_xor(ss, 16); ss += __shfl_xor(ss, 32);
                    const float rs = __builtin_amdgcn_rsqf(ss * (1.f / 64.f) + EPS) * gsc;
                    if (type == 1) {
#pragma unroll
                        for (int bj = 0; bj < 2; ++bj)
#pragma unroll
                            for (int n = 0; n < 2; ++n) v[bj][n] = v[bj][n] * rs * gk[bj][n];
                    } else {
#pragma unroll
                        for (int bj = 0; bj < 2; ++bj)
#pragma unroll
                            for (int n = 0; n < 2; ++n) v[bj][n] = v[bj][n] * rs;
                    }
                } else if (type == 3) {
#pragma unroll
                    for (int bj = 0; bj < 2; ++bj)
#pragma unroll
                        for (int n = 0; n < 2; ++n)
#pragma unroll
                            for (int e = 0; e < 4; ++e) v[bj][n][e] = fsilu(v[bj][n][e]);
                }
#pragma unroll
                for (int bj = 0; bj < 2; ++bj) {
                    u32x4 w; w.x = cvtpk(v[bj][0][0], v[bj][0][1]); w.y = cvtpk(v[bj][0][2], v[bj][0][3]); w.z = cvtpk(v[bj][1][0], v[bj][1][1]); w.w = cvtpk(v[bj][1][2], v[bj][1][3]);
                    st16wt(rowp + 32 * bj, w);
                }
            }
    }
};

struct EpiOut {
    static constexpr bool AFTER_DRAIN = true, ACC_INIT = true;
    bf16_t* xb; float* out; float* ssq4; const bf16_t* xres;
    __device__ __forceinline__ void load_init(u32x4 (&ini)[2][4][2], const Unit& u, int wr, int wc, int fr, int fq) const {
        const bf16_t* p = xres + (size_t)(u.pm * 256 + wr * 64 + fr) * DM + u.pn * 256 + wc * 64 + 8 * fq;
#pragma unroll
        for (int a = 0; a < 2; ++a)
#pragma unroll
            for (int m = 0; m < 4; ++m)
#pragma unroll
                for (int b = 0; b < 2; ++b) ini[a][m][b] = *(const u32x4*)(p + (size_t)(a * 128 + m * 16) * DM + 32 * b);
    }
    __device__ __forceinline__ void fused(f32x4 (&acc)[2][2][4][2], const Unit& u, int wr, int wc, int fr, int fq, LAS unsigned char* lds, int wid, int lane) const {
        const int colw = u.pn * 256 + wc * 64 + 8 * fq;
        if (xb != nullptr) {
            LAS float* P = (LAS float*)lds;
#pragma unroll
            for (int ai = 0; ai < 2; ++ai)
#pragma unroll
                for (int m = 0; m < 4; ++m) {
                    const int rl = ai * 128 + wr * 64 + m * 16 + fr;
                    bf16_t* rowp = xb + (size_t)(u.pm * 256 + rl) * DM + colw;
                    float ss = 0.f;
#pragma unroll
                    for (int bj = 0; bj < 2; ++bj) {
                        const f32x4 a = acc[ai][bj][m][0], c = acc[ai][bj][m][1];
                        ss += (a[0] * a[0] + a[1] * a[1]) + (a[2] * a[2] + a[3] * a[3]) + (c[0] * c[0] + c[1] * c[1]) + (c[2] * c[2] + c[3] * c[3]);
                        u32x4 w; w.x = cvtpk(a[0], a[1]); w.y = cvtpk(a[2], a[3]); w.z = cvtpk(c[0], c[1]); w.w = cvtpk(c[2], c[3]);
                        st16wt(rowp + 32 * bj, w);
                    }
                    ss += __shfl_xor(ss, 16); ss += __shfl_xor(ss, 32); if (fq == 0) P[rl * 4 + wc] = ss;
                }
            __syncthreads();
            if (threadIdx.x < 256) { const int rl = threadIdx.x; const float s = (P[rl * 4 + 0] + P[rl * 4 + 1]) + (P[rl * 4 + 2] + P[rl * 4 + 3]); __hip_atomic_store(ssq4 + (size_t)(u.pm * 256 + rl) * 4 + u.pn, s, __ATOMIC_RELAXED, __HIP_MEMORY_SCOPE_AGENT); }
            __syncthreads();
        } else {
#pragma unroll
            for (int ai = 0; ai < 2; ++ai)
#pragma unroll
                for (int m = 0; m < 4; ++m) {
                    float* rowp = out + (size_t)(u.pm * 256 + ai * 128 + wr * 64 + m * 16 + fr) * DM + colw;
#pragma unroll
                    for (int bj = 0; bj < 2; ++bj)
#pragma unroll
                        for (int n = 0; n < 2; ++n) __builtin_nontemporal_store(acc[ai][bj][m][n], (f32x4*)(rowp + 32 * bj + 4 * n));
                }
        }
    }
};
}

namespace mix {
typedef LAS const char* lds_cptr;
constexpr int SLOTB = 8192, NSLOT = 6;
constexpr int L_K = 0, L_V = NSLOT * SLOTB, L_WS = 2 * NSLOT * SLOTB, L_OST = L_WS + 8 * 256, L_END = L_OST + 8 * 4096;
__device__ __forceinline__ int crow(int r, int hi) { return (r & 3) + 8 * (r >> 2) + 4 * hi; }
__device__ __forceinline__ void glds16(const void* gsrc, unsigned lds_dst) { unsigned keep;
    asm volatile("s_mov_b32 %0, m0\n\ts_mov_b32 m0, %2\n\ts_nop 0\n\tglobal_load_lds_dwordx4 %1, off\n\ts_mov_b32 m0, %0" : "=&s"(keep) : "v"(gsrc), "s"(lds_dst) : "memory"); }
__device__ __forceinline__ s16x4 vtr(lds_cptr p) { typedef short v4i16_t __attribute__((ext_vector_type(4))); return __builtin_bit_cast(s16x4, __builtin_amdgcn_ds_read_tr16_b64_v4i16((LAS v4i16_t*)p)); }

__device__ __forceinline__ void qkt(f32x16& p0, f32x16& p1, lds_cptr kslot, const int (&koff)[4], const bf16x8* qr, const f32x16& cinit) {
#pragma unroll
    for (int d0 = 0; d0 < 4; ++d0) {
        const bf16x8 b0 = *(const LAS bf16x8*)(kslot + koff[d0]);
        const bf16x8 b1 = *(const LAS bf16x8*)(kslot + koff[d0] + 4096);
        if (d0 == 0) { p0 = __builtin_amdgcn_mfma_f32_32x32x16_bf16(b0, qr[0], cinit, 0, 0, 0); p1 = __builtin_amdgcn_mfma_f32_32x32x16_bf16(b1, qr[0], cinit, 0, 0, 0); }
        else { p0 = __builtin_amdgcn_mfma_f32_32x32x16_bf16(b0, qr[d0], p0, 0, 0, 0); p1 = __builtin_amdgcn_mfma_f32_32x32x16_bf16(b1, qr[d0], p1, 0, 0, 0); }
    }
}
__device__ __forceinline__ void pv(f32x16* o, lds_cptr vp, bf16x8 pa0, bf16x8 pa1, bf16x8 pa2, bf16x8 pa3) {
#pragma unroll
    for (int d0 = 0; d0 < 2; ++d0) {
        s16x4 lo[4], hi[4];
#pragma unroll
        for (int ks = 0; ks < 4; ++ks) { lo[ks] = vtr(vp + d0 * 4096 + ks * 1024); hi[ks] = vtr(vp + d0 * 4096 + ks * 1024 + 512); }
#define MIX_PK(k) (bf16x8){lo[k][0], lo[k][1], lo[k][2], lo[k][3], hi[k][0], hi[k][1], hi[k][2], hi[k][3]}
        o[d0] = __builtin_amdgcn_mfma_f32_32x32x16_bf16(pa0, MIX_PK(0), o[d0], 0, 0, 0);
        o[d0] = __builtin_amdgcn_mfma_f32_32x32x16_bf16(pa1, MIX_PK(1), o[d0], 0, 0, 0);
        o[d0] = __builtin_amdgcn_mfma_f32_32x32x16_bf16(pa2, MIX_PK(2), o[d0], 0, 0, 0);
        o[d0] = __builtin_amdgcn_mfma_f32_32x32x16_bf16(pa3, MIX_PK(3), o[d0], 0, 0, 0);
#undef MIX_PK
    }
}

__device__ __forceinline__ void attn_unit(int b, int kvh, int qb, const bf16_t* PB, bf16_t* Y, const float* sink_l, float sb2, LAS unsigned char* shm, const int probe = 0) {
    LAS unsigned char* lds = shm;
    int tid = threadIdx.x; asm volatile("" : "+v"(tid));
    const int lane = tid & 63, r32 = lane & 31, hi = lane >> 5; const int wid = __builtin_amdgcn_readfirstlane(tid >> 6);
    const int g = wid >> 1, jj = wid & 1, h = kvh * 4 + g;
    const long rowbase = (long)b * SEQ; const int q0 = qb * 128, kb0 = q0 - 128;
    const int t_lo = (qb == 0) ? 2 : 0, t_hi = (qb == SEQ / 128 - 1) ? 3 : 5;
    const unsigned lds0 = (unsigned)(uintptr_t)shm;
    const bf16_t* Kh = PB + rowbase * DIN + OFF_K + kvh * 64; const bf16_t* Vh = PB + rowbase * DIN + OFF_V + kvh * 64;
    for (int t = t_lo; t <= t_hi; ++t) {
        const long kr = kb0 + 64 * t;
        glds16(Kh + (kr + 8 * wid + (lane >> 3)) * DIN + 8 * ((lane & 7) ^ ((4 * wid + (lane >> 4)) & 7)), (unsigned)__builtin_amdgcn_readfirstlane(lds0 + L_K + t * SLOTB + wid * 1024));
        glds16(Vh + (kr + 16 * (wid & 3) + (lane >> 2)) * DIN + (wid >> 2) * 32 + (lane & 3) * 8, (unsigned)__builtin_amdgcn_readfirstlane(lds0 + L_V + t * SLOTB + wid * 1024));
    }
    const float slope2 = __builtin_amdgcn_exp2f(-(float)(h + 1)) * LOG2E;
    const float snk = __builtin_amdgcn_exp2f(sink_l[h] * LOG2E - sb2);
    LAS float* wsf = (LAS float*)(shm + L_WS) + wid * 64;
    const lds_cptr shm3 = (lds_cptr)shm;
    const lds_cptr vp0 = shm3 + L_V + ((lane >> 4) & 1) * 32 + (lane & 3) * 8 + (4 * hi + ((lane & 15) >> 2)) * 64;
    int koff[4];
#pragma unroll
    for (int d0 = 0; d0 < 4; ++d0) koff[d0] = r32 * 128 + (((2 * d0 + hi) ^ ((r32 >> 1) & 7)) << 4);
    f32x16 cinit;
#pragma unroll
    for (int r = 0; r < 16; ++r) cinit[r] = -sb2;
    bf16x8 qr2[2][4]; u32x4 gav2[2][4];
    {
        const bf16_t* Qw = PB + (rowbase + q0 + 64 * jj + r32) * DIN + OFF_Q + h * 64 + hi * 8;
#pragma unroll
        for (int d0 = 0; d0 < 4; ++d0) qr2[0][d0] = *(const bf16x8*)(Qw + d0 * 16);
    }
    asm volatile("s_waitcnt vmcnt(0)" ::: "memory");
    __syncthreads();
    {
        const bf16_t* Qw = PB + (rowbase + q0 + 64 * jj + 32 + r32) * DIN + OFF_Q + h * 64 + hi * 8;
#pragma unroll
        for (int d0 = 0; d0 < 4; ++d0) qr2[1][d0] = *(const bf16x8*)(Qw + d0 * 16);
    }
#pragma unroll
    for (int i = 0; i < 2; ++i) {
        const int R0 = q0 + 64 * jj + 32 * i;
#pragma unroll
        for (int it = 0; it < 4; ++it) gav2[i][it] = *(const u32x4*)(PB + (rowbase + R0 + it * 8 + (lane >> 3)) * DIN + OFF_GA + h * 64 + (lane & 7) * 8);
    }
    if (PROBE_TS == 130 && probe) STAMPG(1);
#pragma unroll
    for (int i = 0; i < 2; ++i) {
        if (PROBE_TS == 131 && probe && i == 1) STAMPG(1);
        const int R0 = q0 + 64 * jj + 32 * i;
        bf16x8 qr[4];
#pragma unroll
        for (int d0 = 0; d0 < 4; ++d0) qr[d0] = qr2[i][d0];
        f32x16 o[2]; o[0] = f32x16{}; o[1] = f32x16{};
        float lsum = 0.f;
        const int ta = jj > t_lo ? jj : t_lo, tb = (jj + 4) < t_hi ? (jj + 4) : t_hi;
        for (int t = ta; t <= tb; ++t) {
            f32x16 p0, p1;
            qkt(p0, p1, shm3 + L_K + t * SLOTB, koff, qr, cinit);
            const float Lf = (float)(kb0 + 64 * t + 4 * hi - (R0 + r32));
            const bool edge = (t == jj) || (t == jj + 4);
            if (edge) {
#pragma unroll
                for (int r = 0; r < 16; ++r) {
                    const float c = (float)((r & 3) + 8 * (r >> 2));
                    const float x0 = __builtin_fabsf(Lf + c), x1 = __builtin_fabsf(Lf + (c + 32.f));
                    const float a0 = (x0 > 128.f) ? -INFINITY : p0[r] - slope2 * x0, a1 = (x1 > 128.f) ? -INFINITY : p1[r] - slope2 * x1;
                    p0[r] = __builtin_amdgcn_exp2f(a0); p1[r] = __builtin_amdgcn_exp2f(a1);
                }
            } else {
#pragma unroll
                for (int r = 0; r < 16; ++r) {
                    const float c = (float)((r & 3) + 8 * (r >> 2));
                    const float x0 = __builtin_fabsf(Lf + c), x1 = __builtin_fabsf(Lf + (c + 32.f));
                    p0[r] = __builtin_amdgcn_exp2f(p0[r] - slope2 * x0); p1[r] = __builtin_amdgcn_exp2f(p1[r] - slope2 * x1);
                }
            }
            float sacc = 0.f;
#pragma unroll
            for (int r = 0; r < 16; ++r) sacc += p0[r] + p1[r];
            lsum += sacc;
            u32x4 pw0, pw1, pw2, pw3;
            pw0 = (u32x4){cvtpk(p0[0], p0[1]), cvtpk(p0[2], p0[3]), cvtpk(p0[4], p0[5]), cvtpk(p0[6], p0[7])};
            pw1 = (u32x4){cvtpk(p0[8], p0[9]), cvtpk(p0[10], p0[11]), cvtpk(p0[12], p0[13]), cvtpk(p0[14], p0[15])};
            pw2 = (u32x4){cvtpk(p1[0], p1[1]), cvtpk(p1[2], p1[3]), cvtpk(p1[4], p1[5]), cvtpk(p1[6], p1[7])};
            pw3 = (u32x4){cvtpk(p1[8], p1[9]), cvtpk(p1[10], p1[11]), cvtpk(p1[12], p1[13]), cvtpk(p1[14], p1[15])};
            pv(o, vp0 + t * SLOTB, __builtin_bit_cast(bf16x8, pw0), __builtin_bit_cast(bf16x8, pw1), __builtin_bit_cast(bf16x8, pw2), __builtin_bit_cast(bf16x8, pw3));
        }
        if (i == 0) {
#pragma unroll
            for (int i2 = 0; i2 < 2; ++i2)
#pragma unroll
                for (int it = 0; it < 4; ++it) asm volatile("" : "+v"(gav2[i2][it]));
#pragma unroll
            for (int d0 = 0; d0 < 4; ++d0) asm volatile("" : "+v"(qr2[1][d0]));
        }
        lsum += __shfl_xor(lsum, 32);
        const float rl = __builtin_amdgcn_rcpf(lsum + snk);
        if (hi == 0) wsf[r32] = rl;
        asm volatile("s_waitcnt lgkmcnt(0)" ::: "memory");
        LAS bf16_t* stg = (LAS bf16_t*)(shm + L_OST) + wid * 2048;
#pragma unroll
        for (int r = 0; r < 16; ++r) { const int orow = crow(r, hi); const float rr = wsf[orow];
#pragma unroll
            for (int d0 = 0; d0 < 2; ++d0) stg[orow * 64 + d0 * 32 + r32] = (bf16_t)cvtpk(o[d0][r] * rr, 0.f); }
        asm volatile("s_waitcnt lgkmcnt(0)" ::: "memory");
#pragma unroll
        for (int it = 0; it < 4; ++it) {
            const int row = it * 8 + (lane >> 3), ch = lane & 7;
            const u32x4 ov = *(const LAS u32x4*)(stg + row * 64 + ch * 8);
            const u32x4 gv = gav2[i][it];
            u32x4 w;
#pragma unroll
            for (int e = 0; e < 4; ++e) w[e] = cvtpk(bflo(ov[e]) * bflo(gv[e]), bfhi(ov[e]) * bfhi(gv[e]));
            st16wt(Y + (rowbase + R0 + row) * DM + h * 64 + ch * 8, w);
        }
        asm volatile("s_waitcnt lgkmcnt(0)" ::: "memory");
    }
    if (PROBE_TS == 132 && probe) STAMPG(1);
    __syncthreads();
    if (PROBE_TS == 133 && probe) STAMPG(1);
}

__device__ __forceinline__ void gmlp_half(int item, const bf16_t* PB, bf16_t* Y, const bf16_t* Wsb, const float* bs_l, LAS unsigned char* shw  ) {
    int tid = threadIdx.x; asm volatile("" : "+v"(tid));
    const int lane = tid & 63, r32 = lane & 31, hi = lane >> 5;
    const int th = item & 1, g = (item >> 1) & 7, ch = item >> 4;
    const long row0 = (long)ch * 128;
    const unsigned ldsw = (unsigned)(uintptr_t)shw;
#pragma unroll
    for (int pc = 0; pc < 16; ++pc) { const int tt = pc >> 3, pw = pc & 7;
        glds16(PB + (row0 + 64 * tt + 16 * (pw & 3) + (lane >> 2)) * DIN + OFF_VG + g * 64 + (pw >> 2) * 32 + (lane & 3) * 8, (unsigned)__builtin_amdgcn_readfirstlane(ldsw + tt * 8192 + pw * 1024)); }
    u32x4 wq[2][8];
#pragma unroll
    for (int tb = 0; tb < 2; ++tb) {
        const bf16_t* wrow = Wsb + ((size_t)g * 128 + 64 * th + 32 * tb + r32) * 128 + 8 * hi;
#pragma unroll
        for (int ks = 0; ks < 8; ++ks) wq[tb][ks] = *(const u32x4*)(wrow + 16 * ks);
    }
    float bsr[8];
#pragma unroll
    for (int it = 0; it < 8; ++it) bsr[it] = bs_l[g * 128 + 64 * th + it * 8 + (lane >> 3)];
    asm volatile("s_waitcnt vmcnt(0)" ::: "memory");
    const lds_cptr vp0 = (lds_cptr)shw + ((lane >> 4) & 1) * 32 + (lane & 3) * 8 + (4 * hi + ((lane & 15) >> 2)) * 64;
    f32x16 o[2][2];
#pragma unroll
    for (int tb = 0; tb < 2; ++tb) {
        o[tb][0] = f32x16{}; o[tb][1] = f32x16{};
#pragma unroll
        for (int ks = 0; ks < 8; ++ks) {
            const auto s0_ = __builtin_amdgcn_permlane32_swap(wq[tb][ks].x, wq[tb][ks].z, false, false), s1_ = __builtin_amdgcn_permlane32_swap(wq[tb][ks].y, wq[tb][ks].w, false, false);
            const u32x4 wa = (u32x4){s0_[0], s1_[0], s0_[1], s1_[1]};
            const bf16x8 A = __builtin_bit_cast(bf16x8, wa);
#pragma unroll
            for (int d0 = 0; d0 < 2; ++d0) {
                const s16x4 lo = vtr(vp0 + (ks >> 2) * 8192 + d0 * 4096 + (ks & 3) * 1024), hh = vtr(vp0 + (ks >> 2) * 8192 + d0 * 4096 + (ks & 3) * 1024 + 512);
                const bf16x8 B = (bf16x8){lo[0], lo[1], lo[2], lo[3], hh[0], hh[1], hh[2], hh[3]};
                o[tb][d0] = __builtin_amdgcn_mfma_f32_32x32x16_bf16(A, B, o[tb][d0], 0, 0, 0);
            }
        }
    }
    u32x4 uv[8];
    const bf16_t* pe = PB + (row0 + 64 * th + (lane >> 3)) * DIN + g * 64 + (lane & 7) * 8;
#pragma unroll
    for (int it = 0; it < 8; ++it) uv[it] = *(const u32x4*)(pe + (size_t)it * 8 * DIN + OFF_U);
    asm volatile("s_waitcnt lgkmcnt(0)" ::: "memory");
    LAS float* sv = (LAS float*)shw;
#pragma unroll
    for (int tb = 0; tb < 2; ++tb)
#pragma unroll
        for (int r = 0; r < 16; ++r)
#pragma unroll
            for (int d0 = 0; d0 < 2; ++d0) sv[(32 * tb + crow(r, hi)) * 64 + 32 * d0 + r32] = o[tb][d0][r];
    asm volatile("s_waitcnt lgkmcnt(0)" ::: "memory");
    bf16_t* ye = Y + (row0 + 64 * th + (lane >> 3)) * DM + 512 + g * 64 + (lane & 7) * 8;
#pragma unroll
    for (int it = 0; it < 8; ++it) asm volatile("" : "+v"(uv[it]));
#pragma unroll
    for (int it = 0; it < 8; ++it) {
        const LAS float* sp = sv + (it * 8 + (lane >> 3)) * 64 + (lane & 7) * 8;
        const f32x4 s0 = *(const LAS f32x4*)sp + bsr[it], s1 = *(const LAS f32x4*)(sp + 4) + bsr[it];
        u32x4 w;
        w.x = cvtpk(s0[0] * bflo(uv[it].x), s0[1] * bfhi(uv[it].x));
        w.y = cvtpk(s0[2] * bflo(uv[it].y), s0[3] * bfhi(uv[it].y));
        w.z = cvtpk(s1[0] * bflo(uv[it].z), s1[1] * bfhi(uv[it].z));
        w.w = cvtpk(s1[2] * bflo(uv[it].w), s1[3] * bfhi(uv[it].w));
        st16wt(ye + (size_t)it * 8 * DM, w);
    }
    asm volatile("s_waitcnt lgkmcnt(0)" ::: "memory");
}
}

constexpr int NWAVES = 8;
constexpr size_t MiB = 1u << 20;
constexpr size_t WS_CTL = 0, CTL_ZERO_BYTES = 192 * 1024;
constexpr size_t WS_ADA = 64 * 1024;
constexpr size_t WS_BIAS = 128 * 1024;
constexpr size_t WS_SSQ = 1 * MiB + 256 * 1024;
constexpr size_t WS_WIN = 2 * MiB;
constexpr size_t WS_WOUT = 26 * MiB;
constexpr size_t WS_WS = 34 * MiB;
constexpr size_t WS_XB = 36 * MiB;
constexpr size_t WS_Y = 68 * MiB;
constexpr size_t WS_PB = 100 * MiB;
constexpr size_t WS_END = 192 * MiB;
static_assert(WS_WIN + (size_t)NL * 2 * DIN * DM * 2 <= WS_WOUT && WS_PB + (size_t)M * DIN * 2 <= WS_END, "ws map");
constexpr int CW_PANEL = 256;
constexpr int CW_PANEL2 = 2304;
constexpr int CW_PANEL0 = 3968;
constexpr int CW_CONV0 = 3360;
constexpr int CW_MIXDONE = 3328;
constexpr int CW_CONVDONE = 3392;
constexpr int CW_PANEL3 = 3456;
constexpr int CW_BAR = 4096;

constexpr int RING_BYTES = 136 * 1024;
constexpr int MISC_OFF = RING_BYTES;
constexpr int LDS_BYTES = 144 * 1024;
static_assert(mix::L_END <= RING_BYTES && pg8::STAGE_BYTES <= RING_BYTES && 8 * 16384 <= RING_BYTES, "LDS map");

#define XB_TMO      128
#define XB_XCNT(j)  (256  + 64 * (j))
#define XB_XSUB(j)  (1280 + 64 * (j))
#define XB_XGEN(j)  (2304 + 64 * (j))
#define XB_TOP      3328
#define XB_TOPGEN   3392
#define XCD_BAR_WORDS 3456
#define XB_SPIN_CAP (1u << 18)
static_assert(CW_PANEL + 2 * 64 * 16 <= CW_PANEL2 && CW_PANEL2 + 64 * 16 <= CW_MIXDONE && CW_MIXDONE < CW_CONVDONE && CW_CONVDONE < CW_PANEL3 && CW_PANEL3 + 2 * 64 * 4 <= CW_BAR && (CW_BAR + XCD_BAR_WORDS) * 4 <= 64 * 1024, "control words inside the memset region, below the ada table");

__device__ __forceinline__ void poll3(unsigned* a, unsigned ta, unsigned* b, unsigned tb, unsigned* c, unsigned tc) {
    unsigned sp_ = 0;
    for (;;) {
        const unsigned va = __hip_atomic_load(a, __ATOMIC_RELAXED, __HIP_MEMORY_SCOPE_AGENT), vb = __hip_atomic_load(b, __ATOMIC_RELAXED, __HIP_MEMORY_SCOPE_AGENT), vc = __hip_atomic_load(c, __ATOMIC_RELAXED, __HIP_MEMORY_SCOPE_AGENT);
        if (va >= ta && vb >= tb && vc >= tc) break;
        if (++sp_ > (1u << 22)) break;
    }
}
__device__ __forceinline__ unsigned xb_ld(unsigned* p)              { return __hip_atomic_load(p, __ATOMIC_RELAXED, __HIP_MEMORY_SCOPE_AGENT); }
__device__ __forceinline__ unsigned xb_add(unsigned* p, unsigned v) { return __hip_atomic_fetch_add(p, v, __ATOMIC_RELAXED, __HIP_MEMORY_SCOPE_AGENT); }
__device__ __forceinline__ unsigned xb_xcc_id() { return (unsigned)__builtin_amdgcn_s_getreg((3 << 11) | 20) & 0xFu; }
#define XB_SPIN(cond, bar) do { unsigned _sp = 0; while (cond) { __builtin_amdgcn_s_sleep(1); \
    if ((++_sp & 255u) == 0u) { if (xb_ld(&(bar)[XB_TMO])) break; if (_sp > XB_SPIN_CAP) { atomicAdd(&(bar)[XB_TMO], 1u); break; } } } } while (0)

struct XcdBarrier { unsigned* bar; unsigned x; volatile LAS unsigned* st; };
__device__ __forceinline__ XcdBarrier xcd_barrier_post(unsigned* bar, volatile LAS unsigned* st) {
    XcdBarrier b; b.bar = bar; b.x = xb_xcc_id(); b.st = st;
    if (threadIdx.x == 0) (void)xb_add(&bar[XB_XCNT(b.x)], 1u);
    return b;
}
__device__ __forceinline__ void xcd_barrier_complete(unsigned* bar, unsigned x, unsigned& nloc, unsigned& nx) {
    const unsigned G = gridDim.x * gridDim.y * gridDim.z;
    unsigned sum, cnt, mine, sp = 0u;
    for (;;) {
        sum = 0u; cnt = 0u; mine = 0u;
#pragma unroll
        for (unsigned j = 0; j < 16; ++j) { const unsigned c = xb_ld(&bar[XB_XCNT(j)]); sum += c; cnt += (c > 0u) ? 1u : 0u; mine = (j == x) ? c : mine; }
        if (sum == G) break;
        __builtin_amdgcn_s_sleep(1);
        if ((++sp & 255u) == 0u) { if (xb_ld(&bar[XB_TMO])) break; if (sp > XB_SPIN_CAP) { atomicAdd(&bar[XB_TMO], 1u); break; } }
    }
    nloc = mine > 0u ? mine : 1u; nx = cnt > 0u ? cnt : 1u;
}
__device__ __forceinline__ void xcd_barrier(const XcdBarrier& b, const bool release = true) {
    asm volatile("s_waitcnt vmcnt(0)" ::: "memory");
    __syncthreads();
    if (threadIdx.x == 0) {
        unsigned* bar = b.bar;
        __builtin_amdgcn_s_waitcnt(0);
        unsigned nloc = b.st[0], nx = b.st[1];
        if (nloc == 0u) { xcd_barrier_complete(bar, b.x, nloc, nx); b.st[0] = nloc; b.st[1] = nx; }
#if MK_BAR_EVERY_WG_RELEASES
        __builtin_amdgcn_fence(__ATOMIC_RELEASE, "agent");
        asm volatile("s_waitcnt vmcnt(0)" ::: "memory");
#endif
        const unsigned old = xb_add(&bar[XB_XSUB(b.x)], 1u);
        const unsigned gen = old / nloc;
        if (old + 1u == (gen + 1u) * nloc) {
#if !MK_BAR_EVERY_WG_RELEASES
            if (release) { __builtin_amdgcn_fence(__ATOMIC_RELEASE, "agent");
                asm volatile("s_waitcnt vmcnt(0)" ::: "memory"); }
#endif
            const unsigned og = xb_add(&bar[XB_TOP], 1u);
            const unsigned tg = og / nx;
            if (og + 1u == (tg + 1u) * nx) xb_add(&bar[XB_TOPGEN], 1u);
            else XB_SPIN(xb_ld(&bar[XB_TOPGEN]) == tg, bar);
            __builtin_amdgcn_fence(__ATOMIC_ACQUIRE, "agent");
            xb_add(&bar[XB_XGEN(b.x)], 1u);
            asm volatile("s_waitcnt vmcnt(0)" ::: "memory");
        } else {
            XB_SPIN(xb_ld(&bar[XB_XGEN(b.x)]) == gen, bar);
            __builtin_amdgcn_fence(__ATOMIC_ACQUIRE, "agent");
            asm volatile("s_waitcnt vmcnt(0)" ::: "memory");
        }
    }
    __syncthreads();
}

struct Args { const float* in[12]; float* out; unsigned char* ws; int ph_lo, ph_hi; };
static_assert(sizeof(Args) == 14 * 8 + 8, "Args has no padding");

__host__ __device__ __forceinline__ int permcol(int n) {
    if (n < OFF_U) return n;
    if (n < OFF_VG) { const int c = n - OFF_U; return OFF_U + 256 * (c >> 7) + 64 * ((c >> 5) & 3) + (c & 31); }
    if (n < OFF_GG) return n + 512;
    const int c = n - OFF_GG; return OFF_U + 256 * (c >> 7) + 64 * ((c >> 5) & 3) + 32 + (c & 31);
}
struct TrItem { const float* W; int N; bf16_t* WT; size_t bstride_el; const float* gain; const float* sc; const float* shift; float* bias_acc; int item; int mode; };
__device__ __forceinline__ void tr_load(const TrItem& I, int lane, float (&wv)[32], float (&shv)[2]) {
    const int nblk = I.N / 32, kb = I.item / nblk, nb = I.item % nblk, k0 = 64 * kb, n0 = 32 * nb;
#pragma unroll
    for (int i = 0; i < 32; ++i) wv[i] = __builtin_nontemporal_load(&I.W[(size_t)(k0 + 2 * i + (lane >> 5)) * I.N + n0 + (lane & 31)]);
    shv[0] = 0.f; shv[1] = 0.f;
    if (I.mode == 0) { shv[0] = I.shift[(lane >> 5) * 3 * DM + k0 + (lane & 31)]; shv[1] = I.shift[(lane >> 5) * 3 * DM + k0 + 32 + (lane & 31)]; }
}
template <int MODE>
__device__ __forceinline__ void tr_finish(const TrItem& I, int lane, const float (&wv)[32], const float (&shv)[2], LAS float* scr) {
    constexpr int K = DM, scs = 3 * DM;
    const int N = I.N, nblk = N / 32, kb = I.item / nblk, nb = I.item % nblk, k0 = 64 * kb, n0 = 32 * nb;
    const int c = lane & 7;
    float f[2][8], gtv[2][4];
    if (MODE == 0) {
#pragma unroll
        for (int e = 0; e < 8; ++e) { const float gn = I.gain[k0 + 8 * c + e]; f[0][e] = gn * (1.f + I.sc[k0 + 8 * c + e]); f[1][e] = gn * (1.f + I.sc[scs + k0 + 8 * c + e]); }
    } else {
#pragma unroll
        for (int bb = 0; bb < 2; ++bb)
#pragma unroll
            for (int j = 0; j < 4; ++j) gtv[bb][j] = I.sc[bb * scs + n0 + (lane >> 3) + 8 * j];
    }
#pragma unroll
    for (int i = 0; i < 32; ++i) scr[(2 * i + (lane >> 5)) * 33 + (lane & 31)] = wv[i];
    LAS float* shl = scr + 64 * 33;
    if (MODE == 0) { shl[(lane >> 5) * 64 + (lane & 31)] = shv[0]; shl[(lane >> 5) * 64 + 32 + (lane & 31)] = shv[1]; }
    asm volatile("s_waitcnt lgkmcnt(0)" ::: "memory");
    if (MODE == 0) {
        const int bb = lane >> 5, n = lane & 31; float a = 0.f;
#pragma unroll 16
        for (int kk = 0; kk < 64; ++kk) a += shl[bb * 64 + kk] * scr[kk * 33 + n];
        atomicAdd(I.bias_acc + bb * N + permcol(n0) + n, a);
    }
    if (MODE == 0) {
#pragma unroll
        for (int bb = 0; bb < 2; ++bb)
#pragma unroll
            for (int e = 0; e < 8; ++e) asm volatile("" : "+v"(f[bb][e]));
    } else {
#pragma unroll
        for (int bb = 0; bb < 2; ++bb)
#pragma unroll
            for (int j = 0; j < 4; ++j) asm volatile("" : "+v"(gtv[bb][j]));
    }
#pragma unroll
    for (int j = 0; j < 4; ++j) { const int n = (lane >> 3) + 8 * j; const LAS float* sp = scr + (8 * c) * 33 + n;
        float v[8];
#pragma unroll
        for (int e = 0; e < 8; ++e) v[e] = sp[e * 33];
#pragma unroll
        for (int bb = 0; bb < 2; ++bb) {
            float g[8];
            if (MODE == 0) {
#pragma unroll
                for (int e = 0; e < 8; ++e) g[e] = f[bb][e];
            } else { const float gt = gtv[bb][j];
#pragma unroll
                for (int e = 0; e < 8; ++e) g[e] = gt; }
            u32x4 o; o.x = pk2(v[0] * g[0], v[1] * g[1]); o.y = pk2(v[2] * g[2], v[3] * g[3]); o.z = pk2(v[4] * g[4], v[5] * g[5]); o.w = pk2(v[6] * g[6], v[7] * g[7]);
            st16wt(I.WT + (size_t)bb * I.bstride_el + (size_t)((MODE == 0 ? permcol(n0) : n0) + n) * K + k0 + 8 * c, o); } }
    asm volatile("s_waitcnt lgkmcnt(0)" ::: "memory");
}
constexpr int TR_I_IN = (DM / 64) * (DIN / 32), TR_I_OUT = (DM / 64) * (DM / 32), TR_TOTAL = 2 * (TR_I_IN + TR_I_OUT);
__device__ __forceinline__ TrItem tr_make(int id, const float* w_in, const float* w_out, const float* norm_gain, const float* ADA, float* BIAS, bf16_t* WIN, bf16_t* WOUT) {
    TrItem I; int l, r;
    if (id < TR_I_IN) { l = 0; r = id; I.mode = 0; } else if (id < TR_I_IN + TR_I_OUT) { l = 0; r = id - TR_I_IN; I.mode = 1; }
    else if (id < 2 * TR_I_IN + TR_I_OUT) { l = 1; r = id - TR_I_IN - TR_I_OUT; I.mode = 0; } else { l = 1; r = id - 2 * TR_I_IN - TR_I_OUT; I.mode = 1; }
    I.item = r;
    if (I.mode == 0) { I.W = w_in + (size_t)l * DM * DIN; I.N = DIN; I.WT = WIN + (size_t)l * 2 * DIN * DM; I.bstride_el = (size_t)DIN * DM; I.gain = norm_gain + l * DM; I.sc = ADA + l * 2 * 3 * DM + DM; I.shift = ADA + l * 2 * 3 * DM; I.bias_acc = BIAS + l * 2 * DIN; }
    else { I.W = w_out + (size_t)l * DM * DM; I.N = DM; I.WT = WOUT + (size_t)l * 2 * DM * DM; I.bstride_el = (size_t)DM * DM; I.gain = nullptr; I.sc = ADA + l * 2 * 3 * DM + 2 * DM; I.shift = nullptr; I.bias_acc = nullptr; }
    return I;
}
__device__ __forceinline__ void tr_run(int first, int last, int stride, int lane, LAS float* scr, const float* w_in, const float* w_out, const float* norm_gain, const float* ADA, float* BIAS, bf16_t* WIN, bf16_t* WOUT) {
    for (int id = first; id < last; id += 2 * stride) {
        const bool two = (id + stride < last);
        const TrItem I0 = tr_make(id, w_in, w_out, norm_gain, ADA, BIAS, WIN, WOUT), I1 = tr_make(two ? id + stride : id, w_in, w_out, norm_gain, ADA, BIAS, WIN, WOUT);
        float wa[32], wb[32], sa[2], sb[2];
        tr_load(I0, lane, wa, sa);
        if (two) tr_load(I1, lane, wb, sb);
        if (two) {
#pragma unroll
            for (int i = 0; i < 32; ++i) asm volatile("" : "+v"(wb[i]));
            asm volatile("" : "+v"(sb[0]), "+v"(sb[1]));
        }
        if (I0.mode == 0) tr_finish<0>(I0, lane, wa, sa, scr); else tr_finish<1>(I0, lane, wa, sa, scr);
        if (two) { if (I1.mode == 0) tr_finish<0>(I1, lane, wb, sb, scr); else tr_finish<1>(I1, lane, wb, sb, scr); }
    }
}

template <bool SILU>
__device__ __forceinline__ void gemv32(const float* W, int N, int n0, const float* vec  , int vstride, const float* addb, float* out  , int ostride, LAS float* red  ) {
    const int tid = threadIdx.x, lane = tid & 63, w = tid >> 6, cg = lane & 7, rg = lane >> 3;
    f32x4 a0 = {0.f, 0.f, 0.f, 0.f}, a1 = {0.f, 0.f, 0.f, 0.f};
#pragma unroll
    for (int it = 0; it < 16; ++it) {
        const int k = 128 * w + 8 * it + rg;
        const f32x4 wv = *(const f32x4*)(W + (size_t)k * N + n0 + 4 * cg);
        float s0 = vec[k], s1 = vec[vstride + k];
        if (SILU) { s0 = fsilu(s0); s1 = fsilu(s1); }
        a0 += wv * s0; a1 += wv * s1;
    }
#pragma unroll
    for (int e = 0; e < 4; ++e) {
        a0[e] += __shfl_xor(a0[e], 8); a0[e] += __shfl_xor(a0[e], 16); a0[e] += __shfl_xor(a0[e], 32);
        a1[e] += __shfl_xor(a1[e], 8); a1[e] += __shfl_xor(a1[e], 16); a1[e] += __shfl_xor(a1[e], 32);
    }
    if (rg == 0) {
#pragma unroll
        for (int e = 0; e < 4; ++e) { red[(w * 2 + 0) * 32 + 4 * cg + e] = a0[e]; red[(w * 2 + 1) * 32 + 4 * cg + e] = a1[e]; }
    }
    __syncthreads();
    if (tid < 64) { const int bb = tid >> 5, col = tid & 31; float s = addb ? addb[n0 + col] : 0.f;
#pragma unroll
        for (int ww = 0; ww < 8; ++ww) s += red[(ww * 2 + bb) * 32 + col];
        out[bb * ostride + n0 + col] = s; }
    __syncthreads();
}

#define XROWS(R0_, CNT_, WT_) do { \
            const int r0 = (R0_); \
            const f32x4* xr = (const f32x4*)(x + (size_t)r0 * DM) + lane; \
            f32x4 v[CNT_][4]; \
            _Pragma("unroll") for (int q = 0; q < (CNT_); ++q) _Pragma("unroll") for (int j = 0; j < 4; ++j) v[q][j] = __builtin_nontemporal_load(&xr[q * (DM / 4) + 64 * j]); \
            if (WT_) { _Pragma("unroll") for (int q = 0; q < (CNT_); ++q) _Pragma("unroll") for (int j = 0; j < 4; ++j) asm volatile("" : "+v"(v[q][j])); }     \
            _Pragma("unroll") for (int q = 0; q < (CNT_); ++q) { \
                float sq = 0.f; \
                _Pragma("unroll") for (int j = 0; j < 4; ++j) sq += (v[q][j][0] * v[q][j][0] + v[q][j][1] * v[q][j][1]) + (v[q][j][2] * v[q][j][2] + v[q][j][3] * v[q][j][3]); \
                sq = wave_sum(sq); \
                u32x2* o8 = (u32x2*)(XB + (size_t)(r0 + q) * DM) + lane; \
                _Pragma("unroll") for (int j = 0; j < 4; ++j) { u32x2 w; w.x = cvtpk(v[q][j][0], v[q][j][1]); w.y = cvtpk(v[q][j][2], v[q][j][3]); if (WT_) st8wt(o8 + 64 * j, w); else st8(o8 + 64 * j, w); } \
                if (lane == 0) { const f32x4 s4 = (f32x4){sq, 0.f, 0.f, 0.f}; if (WT_) st16wt(SSQ + (size_t)(r0 + q) * 4, __builtin_bit_cast(u32x4, s4)); else *(f32x4*)(SSQ + (size_t)(r0 + q) * 4) = s4; } \
            } } while (0)

__global__ void __launch_bounds__(NWAVES * 64, 2) mk_fwd(Args args) {
    __shared__ __attribute__((aligned(16))) unsigned char lds_raw[LDS_BYTES];
    LAS unsigned char* lds = (LAS unsigned char*)lds_raw;
    volatile LAS unsigned* MISC = (volatile LAS unsigned*)(lds + MISC_OFF);
    const int tid0 = threadIdx.x;
    const int G = gridDim.x; const int bx = blockIdx.x; const int vcu = (G % 8 == 0) ? (bx % 8) * (G / 8) + bx / 8 : bx;
    unsigned char* ws = args.ws;
    const float* x = args.in[0]; const float* cvec = args.in[1]; const float* w_ada = args.in[2]; const float* b_ada = args.in[3]; const float* norm_gain = args.in[4]; const float* w_in = args.in[5];
    const float* q_gain = args.in[6]; const float* k_gain = args.in[7]; const float* sink = args.in[8]; const float* w_s = args.in[9]; const float* b_s = args.in[10]; const float* w_out = args.in[11];
    float* out = args.out;
    float* ADA = (float*)(ws + WS_ADA); float* BIAS = (float*)(ws + WS_BIAS); float* SSQ = (float*)(ws + WS_SSQ);
    bf16_t* WIN = (bf16_t*)(ws + WS_WIN); bf16_t* WOUT = (bf16_t*)(ws + WS_WOUT); bf16_t* WSB = (bf16_t*)(ws + WS_WS);
    bf16_t* XB = (bf16_t*)(ws + WS_XB); bf16_t* Y = (bf16_t*)(ws + WS_Y); bf16_t* PB = (bf16_t*)(ws + WS_PB);
    if (tid0 < 64) MISC[tid0] = 0u;
    __syncthreads();
    const int lo = args.ph_lo, hi = args.ph_hi;
#define STAMP(i_) do { const unsigned long long t_ = __builtin_amdgcn_s_memrealtime(); if (threadIdx.x == 0) { MISC[16 + 2 * (i_)] = (unsigned)t_; MISC[17 + 2 * (i_)] = (unsigned)(t_ >> 32); } } while (0)
    if (PROBE_TS >= 0) STAMP(0);
    XcdBarrier bar; bar.bar = (unsigned*)(ws + WS_CTL) + CW_BAR; bar.x = 0; bar.st = MISC + 8;
    if (hi - lo > 1) bar = xcd_barrier_post((unsigned*)(ws + WS_CTL) + CW_BAR, MISC + 8);
#define IN(k) (lo <= (k) && (k) < hi)
#define SEAM(k) do { if ((k) + 1 < hi) xcd_barrier(bar, !((k) == 1 && lo == 0)); if (PROBE_TS == (k)) STAMP(1); } while (0)
#define REPS(k) (((k) == PROBE_REP) ? 2 : 1)

  for (int pass_ = 0; pass_ < PROBE_PASSES; ++pass_) {
    int tid = threadIdx.x; asm volatile("" : "+v"(tid));
    const int lane = tid & 63, wave = __builtin_amdgcn_readfirstlane(tid >> 6);
    const int gw = vcu * NWAVES + wave, NGW = G * NWAVES;
    if (((PH_MASK >> 0) & 1) && IN(0)) {
      for (int rep_ = 0; rep_ < REPS(0); ++rep_) {
        if (bx < NL * 2 * 48) {
            const int l = bx / 96, r = bx % 96, kh = r / 48, cb = r % 48, cg = lane & 15, rg = lane >> 4;
            const int k0 = 512 * kh + 64 * wave + 16 * rg;
            const float* wp = w_ada + ((size_t)l * DM + k0) * 3 * DM + 64 * cb + 4 * cg;
            f32x4 wr_[16];
#pragma unroll
            for (int i = 0; i < 16; ++i) wr_[i] = __builtin_nontemporal_load((const f32x4*)(wp + (size_t)i * 3 * DM));
            f32x4 a0 = {0.f, 0.f, 0.f, 0.f}, a1 = {0.f, 0.f, 0.f, 0.f};
#pragma unroll
            for (int i = 0; i < 16; ++i) { const float s0 = fsilu(cvec[k0 + i]), s1 = fsilu(cvec[DM + k0 + i]); a0 += wr_[i] * s0; a1 += wr_[i] * s1; }
#pragma unroll
            for (int e = 0; e < 4; ++e) { a0[e] += __shfl_xor(a0[e], 16); a0[e] += __shfl_xor(a0[e], 32); a1[e] += __shfl_xor(a1[e], 16); a1[e] += __shfl_xor(a1[e], 32); }
            LAS float* red = (LAS float*)lds;
            if (rg == 0) { *(LAS f32x4*)(red + (wave * 2 + 0) * 64 + 4 * cg) = a0; *(LAS f32x4*)(red + (wave * 2 + 1) * 64 + 4 * cg) = a1; }
            __syncthreads();
            if (tid < 128) {
                const int b = tid >> 6, n = tid & 63;
                float sum = (kh == 0) ? b_ada[l * 3 * DM + 64 * cb + n] : 0.f;
#pragma unroll
                for (int w = 0; w < 8; ++w) sum += red[(w * 2 + b) * 64 + n];
                atomicAdd(ADA + (size_t)(l * 2 + b) * 3 * DM + 64 * cb + n, sum);
            }
            __syncthreads();
        }
        if (PROBE_TS == 100) STAMP(1);
        for (int it = gw; it < NL * 8 * 128 * 128 / 512; it += NGW) {
            const float* sp = w_s + (size_t)it * 512 + lane * 8; const f32x4 a = *(const f32x4*)sp, b2 = *(const f32x4*)(sp + 4);
            u32x4 o; o.x = pk2(a[0], a[1]); o.y = pk2(a[2], a[3]); o.z = pk2(b2[0], b2[1]); o.w = pk2(b2[2], b2[3]);
            *(u32x4*)(WSB + (size_t)it * 512 + lane * 8) = o; }
        XROWS(gw * 4, 4, 0);
      }
        if (PROBE_TS == 101) STAMP(1);
        SEAM(0);
    }
    if (((PH_MASK >> 1) & 1) && IN(1)) {
      for (int rep_ = 0; rep_ < REPS(1); ++rep_) {
        tr_run(gw, TR_I_IN, NGW, lane, (LAS float*)(lds + wave * 16384), w_in, w_out, norm_gain, ADA, BIAS, WIN, WOUT);
      }
        if (PROBE_TS == 111) STAMP(1);
        for (int xb_ = 0; xb_ < PROBE_BAR; ++xb_) SEAM(1);
        SEAM(1);
        if (lo < 2 && (bx % 8) >= 4) {
            int tid3 = threadIdx.x; asm volatile("" : "+v"(tid3));
            const int lane3 = tid3 & 63, wave3 = __builtin_amdgcn_readfirstlane(tid3 >> 6);
            const int pmb = 8 * (bx % 8) + (bx / 8) % 8, qb3 = (bx / 64) & 3;
            { const int lane = lane3; XROWS(256 * pmb + 64 * qb3 + 8 * wave3, 8, 1); }
            asm volatile("s_waitcnt vmcnt(0)" ::: "memory");
            __syncthreads();
            if (tid3 == 0) __hip_atomic_fetch_add((unsigned*)(ws + WS_CTL) + CW_PANEL0 + pmb * 2, 1u, __ATOMIC_RELAXED, __HIP_MEMORY_SCOPE_AGENT);
            const int gwB = (((bx % 8) - 4) * 32 + bx / 8) * NWAVES + wave3;
            tr_run(TR_I_IN + gwB, TR_I_IN + TR_I_OUT, (G / 2) * NWAVES, lane3, (LAS float*)(lds + wave3 * 16384), w_in, w_out, norm_gain, ADA, BIAS, WIN, WOUT);
            asm volatile("s_waitcnt vmcnt(0)" ::: "memory");
            __syncthreads();
            if (tid3 == 0) __hip_atomic_fetch_add((unsigned*)(ws + WS_CTL) + CW_CONV0, 1u, __ATOMIC_RELAXED, __HIP_MEMORY_SCOPE_AGENT);
        }
    }
    for (int l = 0; l < NL; ++l) {
        const int p0 = 2 + 3 * l;
        if (((PH_MASK >> 2) & 1) && IN(p0)) {
            if (l == 0 && lo < 2 && (bx % 8) >= 4) {
                if (tid == 0) { unsigned sp_ = 0;
                    while (__hip_atomic_load((unsigned*)(ws + WS_CTL) + CW_PANEL0 + (8 * (bx % 8) + (bx / 8) % 8) * 2, __ATOMIC_RELAXED, __HIP_MEMORY_SCOPE_AGENT) < 4u) { if (++sp_ > (1u << 22)) break; }
                    __builtin_amdgcn_fence(__ATOMIC_ACQUIRE, "agent"); asm volatile("s_waitcnt vmcnt(0)" ::: "memory"); }
                __syncthreads();
            }
            if (l == 1 && lo < 3 && 5 < hi) {
                if (tid == 0) { unsigned sp_ = 0;
                    poll3((unsigned*)(ws + WS_CTL) + CW_PANEL2 + (8 * (bx % 8) + (bx / 8) % 8) * 16, 4u,
                          (unsigned*)(ws + WS_CTL) + CW_MIXDONE + 16 * ((bx % 8) >= 4 ? 1 : 0), (unsigned)(G / 2),
                          (unsigned*)(ws + WS_CTL) + CW_CONVDONE, (unsigned)(3 * G - (M / 256) * (DIN / 256)));
                    __builtin_amdgcn_fence(__ATOMIC_ACQUIRE, "agent"); asm volatile("s_waitcnt vmcnt(0)" ::: "memory"); }
                __syncthreads();
            }
            if (DESYNC_TICKS > 0 && l == 0 && lo < 2 && (bx % 8) >= 4) { const unsigned long long t0_ = __builtin_amdgcn_s_memrealtime(); while (__builtin_amdgcn_s_memrealtime() - t0_ < (unsigned long long)DESYNC_TICKS) __builtin_amdgcn_s_sleep(8); }
            pg8::Gemm g{XB, WIN + (size_t)l * 2 * DIN * DM, M, DIN, DM, (size_t)DIN * DM * 2, nullptr, nullptr, 0}; pg8::StaticOrder S; S.init(M, DIN, G, bx);
            pg8::EpiProj E{PB, SSQ, BIAS + l * 2 * DIN, q_gain + l * 64, k_gain + l * 64};
            for (int rep_ = 0; rep_ < REPS(p0); ++rep_) pg8::gemm_phase<pg8::EpiProj, true>(lds, g, S, E, l == 0);
            if (l == 0 && bx >= (M / 256) * (DIN / 256) - 2 * G) {
                __syncthreads();
                int tid2 = threadIdx.x; asm volatile("" : "+v"(tid2));
                const int lane2 = tid2 & 63, wave2 = __builtin_amdgcn_readfirstlane(tid2 >> 6);
                const int nidle = G - ((M / 256) * (DIN / 256) - 2 * G), dw = (bx - (G - nidle)) * NWAVES + wave2;
                tr_run(TR_I_IN + TR_I_OUT + dw, TR_TOTAL, nidle * NWAVES, lane2, (LAS float*)(lds + wave2 * 16384), w_in, w_out, norm_gain, ADA, BIAS, WIN, WOUT);
                if (PROBE_TS == 126) STAMP(1);
            }
            if (PROBE_TS == 127 && l == 0) STAMP(1);
            if (lo < 2 && p0 + 1 < hi) {
                asm volatile("s_waitcnt vmcnt(0)" ::: "memory");
                __syncthreads();
                if (tid == 0) { __hip_atomic_fetch_add((unsigned*)(ws + WS_CTL) + CW_PANEL3 + (l * 64 + 8 * (bx % 8) + (bx / 8) % 8) * 4, 1u, __ATOMIC_RELAXED, __HIP_MEMORY_SCOPE_AGENT);
                    if (l == 0 && bx >= (M / 256) * (DIN / 256) - 2 * G) __hip_atomic_fetch_add((unsigned*)(ws + WS_CTL) + CW_CONVDONE, 1u, __ATOMIC_RELAXED, __HIP_MEMORY_SCOPE_AGENT); }
            } else SEAM(p0);
        }
        if (((PH_MASK >> 3) & 3) && IN(p0 + 1)) {
            const float qv_pre = __builtin_fabsf(q_gain[l * 64 + lane]), kv_pre = __builtin_fabsf(k_gain[l * 64 + lane]);
            if (lo < 2 && p0 + 1 < hi) {
                const int pmw = 8 * (bx % 8) + (bx / 8) % 8, qw = (bx / 64) & 3;
                const int nbw = (qw & 1) ? ((pmw & 31) < 31 ? pmw + 1 : pmw) : ((pmw & 31) > 0 ? pmw - 1 : pmw);
                if (tid == 0) { unsigned sp_ = 0;
                    poll3((unsigned*)(ws + WS_CTL) + CW_PANEL3 + (l * 64 + pmw) * 4, 4u, (unsigned*)(ws + WS_CTL) + CW_PANEL3 + (l * 64 + nbw) * 4, 4u,
                          (unsigned*)(ws + WS_CTL) + CW_CONV0, l == 0 ? (unsigned)(G / 2) : 0u);
                    __builtin_amdgcn_fence(__ATOMIC_ACQUIRE, "agent"); asm volatile("s_waitcnt vmcnt(0)" ::: "memory"); }
                __syncthreads();
            }
            float aq = qv_pre, ak = kv_pre;
            {
#pragma unroll
              for (int o = 1; o < 64; o <<= 1) { aq = fmaxf(aq, __shfl_xor(aq, o)); ak = fmaxf(ak, __shfl_xor(ak, o)); } }
            const float sb2 = 8.f * aq * ak * LOG2E;
          for (int rep_ = 0; rep_ < REPS(p0 + 1); ++rep_) {
            const int pmx = 8 * (bx % 8) + (bx / 8) % 8, qx = (bx / 64) & 3;
            if ((PH_MASK >> 3) & 1) mix::attn_unit(pmx >> 5, qx >> 1, 2 * (pmx & 31) + (qx & 1), PB, Y, sink + l * 8, sb2, lds);
            if ((PH_MASK >> 4) & 1) mix::gmlp_half(((2 * pmx + (qx >> 1)) << 4) | ((4 * (qx & 1) + (wave >> 1)) << 1) | (wave & 1), PB, Y, WSB + (size_t)l * 8 * 128 * 128, b_s + l * 8 * 128, lds + wave * 16384);
            if (REPS(p0 + 1) > 1) __syncthreads();
          }
            if (PROBE_TS == 134 && l == 0) STAMP(1);
            if (p0 + 2 < hi) {
                asm volatile("s_waitcnt vmcnt(0)" ::: "memory");
                __syncthreads();
                if (tid == 0) { __hip_atomic_fetch_add((unsigned*)(ws + WS_CTL) + CW_PANEL + (l * 64 + 8 * (bx % 8) + (bx / 8) % 8) * 16, 1u, __ATOMIC_RELAXED, __HIP_MEMORY_SCOPE_AGENT);
                    if (l == 0) __hip_atomic_fetch_add((unsigned*)(ws + WS_CTL) + CW_MIXDONE + 16 * ((bx % 8) >= 4 ? 1 : 0), 1u, __ATOMIC_RELAXED, __HIP_MEMORY_SCOPE_AGENT); }
            }
        }
        if (((PH_MASK >> 5) & 1) && IN(p0 + 2)) {
            pg8::Gemm g{Y, WOUT + (size_t)l * 2 * DM * DM, M, DM, DM, (size_t)DM * DM * 2, nullptr, nullptr, 0}; pg8::StaticOrder S; S.init(M, DM, G, bx);
            const bool lastl = (l == NL - 1);
            pg8::EpiOut E{lastl ? nullptr : XB, out, SSQ, XB};
            const pg8::PanelWait PW{(unsigned*)(ws + WS_CTL) + CW_PANEL + (l * 64 + 8 * (bx % 8) + (bx / 8) % 8) * 16, 4u, lo < p0 + 2};
            for (int rep_ = 0; rep_ < REPS(p0 + 2); ++rep_) pg8::gemm_phase<pg8::EpiOut, false, pg8::PanelWait>(lds, g, S, E, 0, PW);
            if (l == 0 && lo < p0 + 1 && p0 + 3 < hi) {
                asm volatile("s_waitcnt vmcnt(0)" ::: "memory");
                __syncthreads();
                if (tid == 0) __hip_atomic_fetch_add((unsigned*)(ws + WS_CTL) + CW_PANEL2 + (8 * (bx % 8) + (bx / 8) % 8) * 16, 1u, __ATOMIC_RELAXED, __HIP_MEMORY_SCOPE_AGENT);
            } else SEAM(p0 + 2);
        }
    }
    if (pass_ + 1 < PROBE_PASSES) xcd_barrier(bar);
  }
    if (PROBE_TS >= 0) { xcd_barrier(bar); if (vcu == PROBE_VCU && threadIdx.x == 0) { const unsigned long long a_ = ((unsigned long long)MISC[19] << 32) | MISC[18], b_ = ((unsigned long long)MISC[17] << 32) | MISC[16]; out[0] += ((float)(a_ - b_) * 0.01f - PROBE_TS_OFF) * PROBE_TS_SCALE; } }
#undef IN
#undef SEAM
}

extern "C" void kernel_launch(void* const* d_in, const int* in_sizes, int n_in, void* d_out, int out_size, void* d_ws, size_t ws_size, hipStream_t stream) {
    static int grid = 0;
    if (grid == 0) {
        if (n_in != 12 || in_sizes[0] != M * DM || out_size != M * DM || ws_size < WS_END) { fprintf(stderr, "kernel_launch: unexpected shapes (n_in %d, in0 %d, out %d, ws %zu)\n", n_in, n_in > 0 ? in_sizes[0] : -1, out_size, ws_size); grid = -1; return; }
        int dev = 0, cus = 0, per_cu = 0;
        if (hipGetDevice(&dev) != hipSuccess || hipDeviceGetAttribute(&cus, hipDeviceAttributeMultiprocessorCount, dev) != hipSuccess) { grid = -1; return; }
        if (hipOccupancyMaxActiveBlocksPerMultiprocessor(&per_cu, (const void*)mk_fwd, NWAVES * 64, 0) != hipSuccess || per_cu < 1) { fprintf(stderr, "kernel_launch: occupancy query says %d\n", per_cu); per_cu = 1; }
        (void)hipGetLastError();
        grid = cus;
    }
    if (grid < 0) return;
    (void)hipMemsetAsync((char*)d_ws + WS_CTL, 0, CTL_ZERO_BYTES, stream);
    Args a{};
    for (int i = 0; i < 12; ++i) a.in[i] = (const float*)d_in[i];
    a.out = (float*)d_out; a.ws = (unsigned char*)d_ws;
#if MK_PER_PHASE
    for (int p = 0; p < 8; ++p) { a.ph_lo = p; a.ph_hi = p + 1; hipLaunchKernelGGL(mk_fwd, dim3(grid), dim3(NWAVES * 64), 0, stream, a); }
#else
    a.ph_lo = 0; a.ph_hi = 8;
    hipLaunchKernelGGL(mk_fwd, dim3(grid), dim3(NWAVES * 64), 0, stream, a);
#endif
}
```

```cpp
#include <hip/hip_runtime.h>
#include <cstdio>
#include <cstdint>

#ifndef PH_MASK
#define PH_MASK 0xff
#endif
#ifndef PROBE_REP
#define PROBE_REP -1
#endif
#ifndef PROBE_BAR
#define PROBE_BAR 0
#endif
#ifndef PROBE_PASSES
#define PROBE_PASSES 1
#endif
#ifndef PROBE_VCU
#define PROBE_VCU 0
#endif
#ifndef DESYNC_TICKS
#define DESYNC_TICKS 0
#endif
#define PROBE_TS_OFF 0.0f
#ifndef PROBE_TS_SCALE
#define PROBE_TS_SCALE 0.05f
#endif
#ifndef PROBE_TS
#define PROBE_TS -1
#endif
#ifndef MK_PER_PHASE
#define MK_PER_PHASE 0
#endif

constexpr int NB = 2, SEQ = 8192, DM = 1024, M = NB * SEQ, DIN = 2816, NL = 2;
constexpr int OFF_Q = 0, OFF_K = 512, OFF_V = 640, OFF_GA = 768, OFF_U = 1280, OFF_VG = 1792, OFF_GG = 2304;
constexpr float EPS = 1e-6f;
constexpr float LOG2E = 1.4426950408889634f;
constexpr float C2 = 0.125f * LOG2E;

#define LAS __attribute__((address_space(3)))
#define GAS __attribute__((address_space(1)))
typedef unsigned short bf16_t;
typedef short bf16x8 __attribute__((ext_vector_type(8)));
typedef short s16x4 __attribute__((ext_vector_type(4)));
typedef float f32x4 __attribute__((ext_vector_type(4)));
typedef float f32x16 __attribute__((ext_vector_type(16)));
typedef unsigned u32x4 __attribute__((ext_vector_type(4)));
typedef unsigned u32x2 __attribute__((ext_vector_type(2)));
typedef GAS unsigned gu32;

__device__ __forceinline__ unsigned f2bf(float f) { unsigned u = __builtin_bit_cast(unsigned, f); return (u + 0x7fffu + ((u >> 16) & 1u)) >> 16; }
__device__ __forceinline__ unsigned pk2(float lo, float hi) { return f2bf(lo) | (f2bf(hi) << 16); }
__device__ __forceinline__ float bf2f(unsigned short h) { return __builtin_bit_cast(float, (unsigned)h << 16); }
__device__ __forceinline__ float bflo(unsigned w) { return __builtin_bit_cast(float, w << 16); }
__device__ __forceinline__ float bfhi(unsigned w) { return __builtin_bit_cast(float, w & 0xffff0000u); }
typedef float f32x2_t __attribute__((ext_vector_type(2))); typedef __bf16 bf16x2_t __attribute__((ext_vector_type(2)));
__device__ __forceinline__ unsigned cvtpk(float lo, float hi) { f32x2_t v = {lo, hi}; bf16x2_t b = __builtin_convertvector(v, bf16x2_t); return __builtin_bit_cast(unsigned, b); }
__device__ __forceinline__ float fsilu(float v) { return v * __builtin_amdgcn_rcpf(1.f + __builtin_amdgcn_exp2f(-LOG2E * v)); }
__device__ __forceinline__ float wave_sum(float v) {
#pragma unroll
    for (int o = 1; o < 64; o <<= 1) v += __shfl_xor(v, o);
    return v;
}

#ifndef MK_BAR_EVERY_WG_RELEASES
#define MK_BAR_EVERY_WG_RELEASES 0
#endif
#ifndef MK_WT
#define MK_WT 0
#endif
__device__ __forceinline__ void st16(void* p, u32x4 v) {
#if MK_WT
    asm volatile("global_store_dwordx4 %0, %1, off sc1\n\ts_nop 1" :: "v"(p), "v"(v) : "memory");
#else
    *(u32x4*)p = v;
#endif
}
__device__ __forceinline__ void st8wt(void* p, u32x2 v) { asm volatile("global_store_dwordx2 %0, %1, off sc1\n\ts_nop 1" :: "v"(p), "v"(v) : "memory"); }
__device__ __forceinline__ void st16wt(void* p, u32x4 v) { asm volatile("global_store_dwordx4 %0, %1, off sc1\n\ts_nop 1" :: "v"(p), "v"(v) : "memory"); }
__device__ __forceinline__ void st8(void* p, u32x2 v) {
#if MK_WT
    asm volatile("global_store_dwordx2 %0, %1, off sc1\n\ts_nop 1" :: "v"(p), "v"(v) : "memory");
#else
    *(u32x2*)p = v;
#endif
}
__device__ __forceinline__ void glds16s(const void* sbase, unsigned voff, unsigned lds_dst) { unsigned keep;
    asm volatile("s_nop 4\n\ts_mov_b32 %0, m0\n\ts_mov_b32 m0, %3\n\ts_nop 0\n\tglobal_load_lds_dwordx4 %1, %2\n\ts_mov_b32 m0, %0" : "=&s"(keep) : "v"(voff), "s"(sbase), "s"(lds_dst) : "memory"); }
__device__ __forceinline__ void glds16k(const void* sbase, unsigned voff, unsigned lds_dst) {
    asm volatile("s_mov_b32 m0, %2\n\ts_nop 0\n\tglobal_load_lds_dwordx4 %0, %1" :: "v"(voff), "s"(sbase), "s"(lds_dst) : "memory"); }

namespace pg8 {
constexpr int BM = 256, BK = 64, HALF = 128, HTB = HALF * BK * 2, STAGE_BYTES = 8 * HTB, NXCD = 8, WGM = 8;
__host__ __device__ __forceinline__ int lds_byte(int r, int c) { const int st = (r >> 4) * 2 + (c >> 5), rr = r & 15, cc = c & 31, ob = rr * 64 + cc * 2; return st * 1024 + (ob ^ (((ob >> 9) & 1) << 5)); }
__host__ __device__ __forceinline__ void stage_rc(int b, int& R, int& C) { const int st = b / 1024, sb = b % 1024, swz = sb ^ (((sb >> 9) & 1) << 5); R = (st >> 1) * 16 + swz / 64; C = (st & 1) * 32 + (swz % 64) / 2; }
__host__ __device__ __forceinline__ int perm32(int rho) { const int n = rho >> 4, i = rho & 15; return 8 * (i >> 2) + 4 * n + (i & 3); }

struct Unit { int pm, pn; };
struct Gemm { const bf16_t* A; const bf16_t* Bt; int M, N, K; size_t bstride;
              const bf16_t* Ax; const bf16_t* Bx; int nxt; };

struct StaticOrder {
    int nM, nN, nwg, G, c;
    __host__ __device__ void init(int M_, int N_, int G_, int c_) { nM = M_ / BM; nN = N_ / BM; nwg = nM * nN; G = G_; c = c_; }
    __host__ __device__ bool next(int i, Unit& u) const {
        const long L = (long)i * G + c; if (L >= nwg) return false;
        int wgid = (int)L; { const int q = nwg / NXCD, r = nwg % NXCD, xcd = wgid % NXCD, off = wgid / NXCD; wgid = (xcd < r ? xcd * (q + 1) : r * (q + 1) + (xcd - r) * q) + off; }
        const int nig = WGM * nN, gid = wgid / nig, fm = gid * WGM, gsz = (nM - fm) < WGM ? (nM - fm) : WGM;
        u.pm = fm + ((wgid % nig) % gsz); u.pn = (wgid % nig) / gsz; return true;
    }
};

#define STAMPG(i_) do { const unsigned long long t_ = __builtin_amdgcn_s_memrealtime(); if (threadIdx.x == 0) { volatile LAS unsigned* M_ = (volatile LAS unsigned*)(lds + 136 * 1024); M_[16 + 2 * (i_)] = (unsigned)t_; M_[17 + 2 * (i_)] = (unsigned)(t_ >> 32); } } while (0)
struct NoWait { __device__ __forceinline__ void operator()() const {} };
struct PanelWait { unsigned* cnt; unsigned target; bool active;
    __device__ __forceinline__ void operator()() const {
        if (!active) return;
        if (threadIdx.x == 0) { unsigned sp_ = 0; while (__hip_atomic_load(cnt, __ATOMIC_RELAXED, __HIP_MEMORY_SCOPE_AGENT) < target) { if (++sp_ > (1u << 22)) break; }
            __builtin_amdgcn_fence(__ATOMIC_ACQUIRE, "agent"); asm volatile("s_waitcnt vmcnt(0)" ::: "memory"); }
        __syncthreads();
    } };
template <class Epi, bool ALIGN_EPI, class Wait = NoWait>
__device__ __forceinline__ void gemm_phase(LAS unsigned char* lds, const Gemm g, const StaticOrder& S, const Epi& E, const int probe = 0, const Wait& W = Wait()) {
    int tid = threadIdx.x; asm volatile("" : "+v"(tid));
    const int wid = __builtin_amdgcn_readfirstlane(tid >> 6), lane = tid & 63, wr = wid >> 2, wc = wid & 3, fr = lane & 15, fq = lane >> 4;
    const int K = g.K, nt = K / BK;
    unsigned voffA[2], voffB0[2], voffB1[2];
#pragma unroll
    for (int i = 0; i < 2; ++i) { int R, C; stage_rc(tid * 16 + i * 8192, R, C); const int cb = 64 * (R >> 5) + perm32(R & 31);
        voffA[i] = (unsigned)(R * K + C) * 2u; voffB0[i] = (unsigned)(cb * K + C) * 2u; voffB1[i] = (unsigned)((cb + 32) * K + C) * 2u; }
    const size_t kstep = (size_t)(BK * 2);
    const size_t hstep = (size_t)HALF * K * 2;
    const size_t tstep = 2 * hstep;
    const unsigned ldsw = (unsigned)wid * 1024u;
    const unsigned lds0 = (unsigned)(uintptr_t)lds;
    const int aoff = lds_byte(wr * 64 + fr, fq * 8);
    int boffB = 4 * HTB + lds_byte(wc * 32 + fr, fq * 8); asm volatile("" : "+v"(boffB));
#define PG8_SA(b, h) (((b) * 2 + (h)) * HTB)
#define PG8_SB(b, h) ((4 + (b) * 2 + (h)) * HTB)
#define PG8_SBR(b, h) (((b) * 2 + (h)) * HTB)
#define PG8_STAGE(bufoff, gbase, voff) do { _Pragma("unroll") for (int _i = 0; _i < 2; ++_i) \
        glds16s((const void*)(gbase), (voff)[_i], (unsigned)__builtin_amdgcn_readfirstlane((int)(lds0 + (unsigned)(bufoff) + ldsw + (unsigned)_i * 8192u))); } while (0)
#define PG8_STAGEK(bufoff, gbase, voff) do { _Pragma("unroll") for (int _i = 0; _i < 2; ++_i) \
        glds16k((const void*)(gbase), (voff)[_i], (unsigned)__builtin_amdgcn_readfirstlane((int)(lds0 + (unsigned)(bufoff) + ldsw + (unsigned)_i * 8192u))); } while (0)
#define PG8_LDA(dst, b, h) do { _Pragma("unroll") for (int m = 0; m < 4; ++m) _Pragma("unroll") for (int k = 0; k < 2; ++k) dst[m][k] = *(const LAS bf16x8*)(lds + PG8_SA(b, h) + aoff + m * 2048 + k * 1024); } while (0)
#define PG8_LDB(dst, b, h) do { _Pragma("unroll") for (int n = 0; n < 2; ++n) _Pragma("unroll") for (int k = 0; k < 2; ++k) dst[n][k] = *(const LAS bf16x8*)(lds + boffB + (PG8_SBR(b, h) + n * 2048 + k * 1024)); } while (0)
#define PG8_MMA(ai, bj, At, Bt) do { __builtin_amdgcn_s_setprio(3); _Pragma("unroll") for (int m = 0; m < 4; ++m) _Pragma("unroll") for (int n = 0; n < 2; ++n) _Pragma("unroll") for (int k = 0; k < 2; ++k) \
        acc[ai][bj][m][n] = __builtin_amdgcn_mfma_f32_16x16x32_bf16(Bt[n][k], At[m][k], acc[ai][bj][m][n], 0, 0, 0); __builtin_amdgcn_s_setprio(0); } while (0)
#define PG8_WAIT_V(n) asm volatile("s_waitcnt vmcnt(" #n ")" ::: "memory")
#define PG8_WAIT_L(n) asm volatile("s_waitcnt lgkmcnt(" #n ")" ::: "memory")
#define PG8_BAR __builtin_amdgcn_s_barrier()
#define PG8_SCHED __builtin_amdgcn_sched_barrier(0)
    Unit cur, nxt; int ui = 0;
    if (!S.next(0, cur)) return;
    f32x4 acc[2][2][4][2];
    u32x4 ini[2][4][2];
    if constexpr (Epi::ACC_INIT) E.load_init(ini, cur, wr, wc, fr, fq);
    W();
    if constexpr (Epi::ACC_INIT) {
#pragma unroll
        for (int a = 0; a < 2; ++a)
#pragma unroll
            for (int m = 0; m < 4; ++m)
#pragma unroll
                for (int b = 0; b < 2; ++b) asm volatile("" : "+v"(ini[a][m][b]));
    }
    bf16x8 At[4][2], B0[2][2], B1[2][2];
    const int ntot = nt + g.nxt;
#define PG8_UA(u_) ((const char*)g.A + (size_t)(u_).pm * tstep)
#define PG8_UB(u_) ((const char*)g.Bt + (size_t)((u_).pm >> 5) * g.bstride + (size_t)(u_).pn * tstep)
#define PG8_UX(u_) ((const char*)g.Ax + (size_t)(u_).pm * tstep + (size_t)(u_).pn * 512)
    const char* cA = PG8_UA(cur); const char* cB = PG8_UB(cur); const char* xA = PG8_UX(cur); const char* xB = (const char*)g.Bx;
    PG8_STAGE(PG8_SB(0, 0), cB, voffB0); PG8_STAGE(PG8_SB(0, 1), cB, voffB1); PG8_STAGE(PG8_SA(0, 0), cA, voffA); PG8_STAGE(PG8_SA(0, 1), cA + hstep, voffA);
    if (wr == 1) PG8_BAR;
    PG8_WAIT_V(2); PG8_BAR;
    PG8_STAGE(PG8_SB(1, 0), cB + kstep, voffB0); PG8_STAGE(PG8_SA(1, 0), cA + kstep, voffA); PG8_STAGE(PG8_SB(1, 1), cB + kstep, voffB1);
    if constexpr (Epi::ACC_INIT) {
#pragma unroll
        for (int a = 0; a < 2; ++a)
#pragma unroll
            for (int m = 0; m < 4; ++m)
#pragma unroll
                for (int b = 0; b < 2; ++b) { const u32x4 t = ini[a][m][b]; acc[a][b][m][0] = (f32x4){bflo(t.x), bfhi(t.x), bflo(t.y), bfhi(t.y)}; acc[a][b][m][1] = (f32x4){bflo(t.z), bfhi(t.z), bflo(t.w), bfhi(t.w)}; }
    } else {
#pragma unroll
        for (int a = 0; a < 2; ++a)
#pragma unroll
            for (int b = 0; b < 2; ++b)
#pragma unroll
                for (int m = 0; m < 4; ++m)
#pragma unroll
                    for (int n = 0; n < 2; ++n) acc[a][b][m][n] = (f32x4){0.f, 0.f, 0.f, 0.f};
    }
    PG8_WAIT_V(6); PG8_BAR;
    for (;;) {
        const bool has_next = S.next(ui + 1, nxt);
        const char* nA = has_next ? PG8_UA(nxt) : cA; const char* nB = has_next ? PG8_UB(nxt) : cB;
        for (int t = 0; t < ntot; t += 2) {
            const char* a1 = (t < nt ? cA + (size_t)(t + 1) * kstep : xA + (size_t)(t + 1 - nt) * kstep);
            const int t2 = t + 2;
            const char* a2 = t2 < nt ? cA + (size_t)t2 * kstep : (t2 < ntot ? xA + (size_t)(t2 - nt) * kstep : nA);
            const char* b2 = t2 < nt ? cB + (size_t)t2 * kstep : (t2 < ntot ? xB + (size_t)(t2 - nt) * kstep : nB);
            const char* a3 = a2 + kstep; const char* b3 = b2 + kstep;
            PG8_LDB(B0, 0, 0); PG8_LDB(B1, 0, 1); PG8_SCHED; PG8_LDA(At, 0, 0); PG8_STAGEK(PG8_SA(1, 1), a1 + hstep, voffA);
            PG8_WAIT_V(8); PG8_WAIT_L(0); PG8_BAR; PG8_MMA(0, 0, At, B0); PG8_MMA(0, 1, At, B1); PG8_BAR; PG8_SCHED;
            PG8_LDA(At, 0, 1); PG8_STAGEK(PG8_SB(0, 0), b2, voffB0); PG8_STAGEK(PG8_SB(0, 1), b2, voffB1); PG8_STAGEK(PG8_SA(0, 0), a2, voffA);
            PG8_WAIT_V(8); PG8_WAIT_L(0); PG8_BAR; PG8_MMA(1, 0, At, B0); PG8_MMA(1, 1, At, B1); PG8_BAR; PG8_SCHED;
            PG8_LDB(B0, 1, 0); PG8_LDB(B1, 1, 1); PG8_SCHED; PG8_LDA(At, 1, 0); PG8_STAGEK(PG8_SA(0, 1), a2 + hstep, voffA);
            PG8_WAIT_V(8); PG8_WAIT_L(0); PG8_BAR; PG8_MMA(0, 0, At, B0); PG8_MMA(0, 1, At, B1); PG8_BAR; PG8_SCHED;
            PG8_LDA(At, 1, 1); PG8_STAGEK(PG8_SB(1, 0), b3, voffB0); PG8_STAGEK(PG8_SB(1, 1), b3, voffB1); PG8_STAGEK(PG8_SA(1, 0), a3, voffA);
            PG8_WAIT_V(8); PG8_WAIT_L(0); PG8_BAR; PG8_MMA(1, 0, At, B0); PG8_MMA(1, 1, At, B1); PG8_BAR; PG8_SCHED;
        }
        if constexpr (ALIGN_EPI) { if (wr == 0) PG8_BAR; }
        if (PROBE_TS == 120 && probe && ui == 0) STAMPG(1);
        if (PROBE_TS == 122 && probe && ui == 1) STAMPG(1);
        if (PROBE_TS == 124 && probe && ui == 2) STAMPG(1);
        if constexpr (!Epi::AFTER_DRAIN) { E(acc, cur, wr, wc, fr, fq); }
        if (PROBE_TS == 121 && probe && ui == 0) STAMPG(1);
        if (PROBE_TS == 123 && probe && ui == 1) STAMPG(1);
        if (PROBE_TS == 125 && probe && ui == 2) STAMPG(1);
        if (!has_next) break;
#pragma unroll
        for (int a = 0; a < 2; ++a)
#pragma unroll
            for (int b = 0; b < 2; ++b)
#pragma unroll
                for (int m = 0; m < 4; ++m)
#pragma unroll
                    for (int n = 0; n < 2; ++n) acc[a][b][m][n] = (f32x4){0.f, 0.f, 0.f, 0.f};
        cur = nxt; cA = nA; cB = nB; xA = PG8_UX(cur); ++ui;
        if constexpr (ALIGN_EPI) { if (wr == 1) PG8_BAR; }
    }
    PG8_WAIT_V(0);
    if constexpr (!ALIGN_EPI) { if (wr == 0) PG8_BAR; }
    PG8_BAR;
    if constexpr (Epi::AFTER_DRAIN) { E.fused(acc, cur, wr, wc, fr, fq, lds, wid, lane); }
#undef PG8_UA
#undef PG8_UB
#undef PG8_UX
#undef PG8_SA
#undef PG8_SB
#undef PG8_SBR
#undef PG8_STAGE
#undef PG8_STAGEK
#undef PG8_LDA
#undef PG8_LDB
#undef PG8_MMA
#undef PG8_WAIT_V
#undef PG8_WAIT_L
#undef PG8_BAR
#undef PG8_SCHED
}

struct EpiProj {
    static constexpr bool AFTER_DRAIN = false, ACC_INIT = false;
    __device__ __forceinline__ void load_init(u32x4 (&)[2][4][2], const Unit&, int, int, int, int) const {}
    bf16_t* PB; const float* ssq4; const float* bias; const float* qg; const float* kg;
    __device__ __forceinline__ void operator()(const f32x4 (&acc)[2][2][4][2], const Unit& u, int wr, int wc, int fr, int fq) const {
        const int b = u.pm >> 5;
        const int colw = u.pn * 256 + wc * 64 + 8 * fq;
        int type;
        if (u.pn < 2) type = 0; else if (u.pn == 2) type = (wc < 2) ? 1 : 2; else if (u.pn < 5) type = 3; else if (u.pn < 9) type = 5; else type = 4;
        const int cst = (type == 5) ? OFF_U + 128 * (u.pn - 5) + 32 * wc + 8 * fq : (type == 4 ? colw - 512 : colw);
        const float* bp = bias + b * DIN + colw;
        f32x4 bv[2][2];
#pragma unroll
        for (int bj = 0; bj < 2; ++bj)
#pragma unroll
            for (int n = 0; n < 2; ++n) bv[bj][n] = *(const f32x4*)(bp + 32 * bj + 4 * n);
        float rstd[2][4];
        const float* sp = ssq4 + (size_t)(u.pm * 256 + wr * 64 + fr) * 4;
#pragma unroll
        for (int ai = 0; ai < 2; ++ai)
#pragma unroll
            for (int m = 0; m < 4; ++m) { const f32x4 s4 = *(const f32x4*)(sp + (size_t)(ai * 128 + m * 16) * 4); rstd[ai][m] = __builtin_amdgcn_rsqf(((s4[0] + s4[1]) + (s4[2] + s4[3])) * (1.f / DM) + EPS); }
        f32x4 gk[2][2];
        if (type == 1) {
#pragma unroll
            for (int bj = 0; bj < 2; ++bj)
#pragma unroll
                for (int n = 0; n < 2; ++n) gk[bj][n] = *(const f32x4*)(kg + 8 * fq + 32 * bj + 4 * n) * *(const f32x4*)(qg + 8 * fq + 32 * bj + 4 * n);
        }
        const float gsc = (type == 0) ? C2 : 1.f;
#pragma unroll
        for (int ai = 0; ai < 2; ++ai)
#pragma unroll
            for (int m = 0; m < 4; ++m) asm volatile("" : "+v"(rstd[ai][m]));
#pragma unroll
        for (int bj = 0; bj < 2; ++bj)
#pragma unroll
            for (int n = 0; n < 2; ++n) { asm volatile("" : "+v"(bv[bj][n])); if (type == 1) asm volatile("" : "+v"(gk[bj][n])); }
#pragma unroll
        for (int ai = 0; ai < 2; ++ai)
#pragma unroll
            for (int m = 0; m < 4; ++m) {
                const int row = u.pm * 256 + ai * 128 + wr * 64 + m * 16 + fr;
                f32x4 v[2][2];
#pragma unroll
                for (int bj = 0; bj < 2; ++bj)
#pragma unroll
                    for (int n = 0; n < 2; ++n) v[bj][n] = acc[ai][bj][m][n] * rstd[ai][m] + bv[bj][n];
                bf16_t* rowp = PB + (size_t)row * DIN + cst;
                if (type == 5) {
#pragma unroll
                    for (int n = 0; n < 2; ++n)
#pragma unroll
                        for (int e = 0; e < 4; ++e) v[0][n][e] = v[0][n][e] * fsilu(v[1][n][e]);
                    u32x4 w; w.x = cvtpk(v[0][0][0], v[0][0][1]); w.y = cvtpk(v[0][0][2], v[0][0][3]); w.z = cvtpk(v[0][1][0], v[0][1][1]); w.w = cvtpk(v[0][1][2], v[0][1][3]);
                    st16wt(rowp, w);
                    continue;
                }
                if (type == 0 || type == 1 || type == 4) {
                    float ss = 0.f;
#pragma unroll
                    for (int bj = 0; bj < 2; ++bj)
#pragma unroll
                        for (int n = 0; n < 2; ++n) ss += (v[bj][n][0] * v[bj][n][0] + v[bj][n][1] * v[bj][n][1]) + (v[bj][n][2] * v[bj][n][2] + v[bj][n][3] * v[bj][n][3]);
                    ss += __shfl_xor(ss, 16); ss += __shfl_xor(ss, 32);
                    const float rs = __builtin_amdgcn_rsqf(ss * (1.f / 64.f) + EPS) * gsc;
                    if (type == 1) {
#pragma unroll
                        for (int bj = 0; bj < 2; ++bj)
#pragma unroll
                            for (int n = 0; n < 2; ++n) v[bj][n] = v[bj][n] * rs * gk[bj][n];
                    } else {
#pragma unroll
                        for (int bj = 0; bj < 2; ++bj)
#pragma unroll
                            for (int n = 0; n < 2; ++n) v[bj][n] = v[bj][n] * rs;
                    }
                } else if (type == 3) {
#pragma unroll
                    for (int bj = 0; bj < 2; ++bj)
#pragma unroll
                        for (int n = 0; n < 2; ++n)
#pragma unroll
                            for (int e = 0; e < 4; ++e) v[bj][n][e] = fsilu(v[bj][n][e]);
                }
#pragma unroll
                for (int bj = 0; bj < 2; ++bj) {
                    u32x4 w; w.x = cvtpk(v[bj][0][0], v[bj][0][1]); w.y = cvtpk(v[bj][0][2], v[bj][0][3]); w.z = cvtpk(v[bj][1][0], v[bj][1][1]); w.w = cvtpk(v[bj][1][2], v[bj][1][3]);
                    st16wt(rowp + 32 * bj, w);
                }
            }
    }
};

struct EpiOut {
    static constexpr bool AFTER_DRAIN = true, ACC_INIT = true;
    bf16_t* xb; float* out; float* ssq4; const bf16_t* xres;
    __device__ __forceinline__ void load_init(u32x4 (&ini)[2][4][2], const Unit& u, int wr, int wc, int fr, int fq) const {
        const bf16_t* p = xres + (size_t)(u.pm * 256 + wr * 64 + fr) * DM + u.pn * 256 + wc * 64 + 8 * fq;
#pragma unroll
        for (int a = 0; a < 2; ++a)
#pragma unroll
            for (int m = 0; m < 4; ++m)
#pragma unroll
                for (int b = 0; b < 2; ++b) ini[a][m][b] = *(const u32x4*)(p + (size_t)(a * 128 + m * 16) * DM + 32 * b);
    }
    __device__ __forceinline__ void fused(f32x4 (&acc)[2][2][4][2], const Unit& u, int wr, int wc, int fr, int fq, LAS unsigned char* lds, int wid, int lane) const {
        const int colw = u.pn * 256 + wc * 64 + 8 * fq;
        if (xb != nullptr) {
            LAS float* P = (LAS float*)lds;
#pragma unroll
            for (int ai = 0; ai < 2; ++ai)
#pragma unroll
                for (int m = 0; m < 4; ++m) {
                    const int rl = ai * 128 + wr * 64 + m * 16 + fr;
                    bf16_t* rowp = xb + (size_t)(u.pm * 256 + rl) * DM + colw;
                    float ss = 0.f;
#pragma unroll
                    for (int bj = 0; bj < 2; ++bj) {
                        const f32x4 a = acc[ai][bj][m][0], c = acc[ai][bj][m][1];
                        ss += (a[0] * a[0] + a[1] * a[1]) + (a[2] * a[2] + a[3] * a[3]) + (c[0] * c[0] + c[1] * c[1]) + (c[2] * c[2] + c[3] * c[3]);
                        u32x4 w; w.x = cvtpk(a[0], a[1]); w.y = cvtpk(a[2], a[3]); w.z = cvtpk(c[0], c[1]); w.w = cvtpk(c[2], c[3]);
                        st16wt(rowp + 32 * bj, w);
                    }
                    ss += __shfl_xor(ss, 16); ss += __shfl_xor(ss, 32); if (fq == 0) P[rl * 4 + wc] = ss;
                }
            __syncthreads();
            if (threadIdx.x < 256) { const int rl = threadIdx.x; const float s = (P[rl * 4 + 0] + P[rl * 4 + 1]) + (P[rl * 4 + 2] + P[rl * 4 + 3]); __hip_atomic_store(ssq4 + (size_t)(u.pm * 256 + rl) * 4 + u.pn, s, __ATOMIC_RELAXED, __HIP_MEMORY_SCOPE_AGENT); }
            __syncthreads();
        } else {
#pragma unroll
            for (int ai = 0; ai < 2; ++ai)
#pragma unroll
                for (int m = 0; m < 4; ++m) {
                    float* rowp = out + (size_t)(u.pm * 256 + ai * 128 + wr * 64 + m * 16 + fr) * DM + colw;
#pragma unroll
                    for (int bj = 0; bj < 2; ++bj)
#pragma unroll
                        for (int n = 0; n < 2; ++n) __builtin_nontemporal_store(acc[ai][bj][m][n], (f32x4*)(rowp + 32 * bj + 4 * n));
                }
        }
    }
};
}

namespace mix {
typedef LAS const char* lds_cptr;
constexpr int SLOTB = 8192, NSLOT = 6;
constexpr int L_K = 0, L_V = NSLOT * SLOTB, L_WS = 2 * NSLOT * SLOTB, L_OST = L_WS + 8 * 256, L_END = L_OST + 8 * 4096;
__device__ __forceinline__ int crow(int r, int hi) { return (r & 3) + 8 * (r >> 2) + 4 * hi; }
__device__ __forceinline__ void glds16(const void* gsrc, unsigned lds_dst) { unsigned keep;
    asm volatile("s_mov_b32 %0, m0\n\ts_mov_b32 m0, %2\n\ts_nop 0\n\tglobal_load_lds_dwordx4 %1, off\n\ts_mov_b32 m0, %0" : "=&s"(keep) : "v"(gsrc), "s"(lds_dst) : "memory"); }
__device__ __forceinline__ s16x4 vtr(lds_cptr p) { typedef short v4i16_t __attribute__((ext_vector_type(4))); return __builtin_bit_cast(s16x4, __builtin_amdgcn_ds_read_tr16_b64_v4i16((LAS v4i16_t*)p)); }

__device__ __forceinline__ void qkt(f32x16& p0, f32x16& p1, lds_cptr kslot, const int (&koff)[4], const bf16x8* qr, const f32x16& cinit) {
#pragma unroll
    for (int d0 = 0; d0 < 4; ++d0) {
        const bf16x8 b0 = *(const LAS bf16x8*)(kslot + koff[d0]);
        const bf16x8 b1 = *(const LAS bf16x8*)(kslot + koff[d0] + 4096);
        if (d0 == 0) { p0 = __builtin_amdgcn_mfma_f32_32x32x16_bf16(b0, qr[0], cinit, 0, 0, 0); p1 = __builtin_amdgcn_mfma_f32_32x32x16_bf16(b1, qr[0], cinit, 0, 0, 0); }
        else { p0 = __builtin_amdgcn_mfma_f32_32x32x16_bf16(b0, qr[d0], p0, 0, 0, 0); p1 = __builtin_amdgcn_mfma_f32_32x32x16_bf16(b1, qr[d0], p1, 0, 0, 0); }
    }
}
__device__ __forceinline__ void pv(f32x16* o, lds_cptr vp, bf16x8 pa0, bf16x8 pa1, bf16x8 pa2, bf16x8 pa3) {
#pragma unroll
    for (int d0 = 0; d0 < 2; ++d0) {
        s16x4 lo[4], hi[4];
#pragma unroll
        for (int ks = 0; ks < 4; ++ks) { lo[ks] = vtr(vp + d0 * 4096 + ks * 1024); hi[ks] = vtr(vp + d0 * 4096 + ks * 1024 + 512); }
#define MIX_PK(k) (bf16x8){lo[k][0], lo[k][1], lo[k][2], lo[k][3], hi[k][0], hi[k][1], hi[k][2], hi[k][3]}
        o[d0] = __builtin_amdgcn_mfma_f32_32x32x16_bf16(pa0, MIX_PK(0), o[d0], 0, 0, 0);
        o[d0] = __builtin_amdgcn_mfma_f32_32x32x16_bf16(pa1, MIX_PK(1), o[d0], 0, 0, 0);
        o[d0] = __builtin_amdgcn_mfma_f32_32x32x16_bf16(pa2, MIX_PK(2), o[d0], 0, 0, 0);
        o[d0] = __builtin_amdgcn_mfma_f32_32x32x16_bf16(pa3, MIX_PK(3), o[d0], 0, 0, 0);
#undef MIX_PK
    }
}

__device__ __forceinline__ void attn_unit(int b, int kvh, int qb, const bf16_t* PB, bf16_t* Y, const float* sink_l, float sb2, LAS unsigned char* shm, const int probe = 0) {
    LAS unsigned char* lds = shm;
    int tid = threadIdx.x; asm volatile("" : "+v"(tid));
    const int lane = tid & 63, r32 = lane & 31, hi = lane >> 5; const int wid = __builtin_amdgcn_readfirstlane(tid >> 6);
    const int g = wid >> 1, jj = wid & 1, h = kvh * 4 + g;
    const long rowbase = (long)b * SEQ; const int q0 = qb * 128, kb0 = q0 - 128;
    const int t_lo = (qb == 0) ? 2 : 0, t_hi = (qb == SEQ / 128 - 1) ? 3 : 5;
    const unsigned lds0 = (unsigned)(uintptr_t)shm;
    const bf16_t* Kh = PB + rowbase * DIN + OFF_K + kvh * 64; const bf16_t* Vh = PB + rowbase * DIN + OFF_V + kvh * 64;
    for (int t = t_lo; t <= t_hi; ++t) {
        const long kr = kb0 + 64 * t;
        glds16(Kh + (kr + 8 * wid + (lane >> 3)) * DIN + 8 * ((lane & 7) ^ ((4 * wid + (lane >> 4)) & 7)), (unsigned)__builtin_amdgcn_readfirstlane(lds0 + L_K + t * SLOTB + wid * 1024));
        glds16(Vh + (kr + 16 * (wid & 3) + (lane >> 2)) * DIN + (wid >> 2) * 32 + (lane & 3) * 8, (unsigned)__builtin_amdgcn_readfirstlane(lds0 + L_V + t * SLOTB + wid * 1024));
    }
    const float slope2 = __builtin_amdgcn_exp2f(-(float)(h + 1)) * LOG2E;
    const float snk = __builtin_amdgcn_exp2f(sink_l[h] * LOG2E - sb2);
    LAS float* wsf = (LAS float*)(shm + L_WS) + wid * 64;
    const lds_cptr shm3 = (lds_cptr)shm;
    const lds_cptr vp0 = shm3 + L_V + ((lane >> 4) & 1) * 32 + (lane & 3) * 8 + (4 * hi + ((lane & 15) >> 2)) * 64;
    int koff[4];
#pragma unroll
    for (int d0 = 0; d0 < 4; ++d0) koff[d0] = r32 * 128 + (((2 * d0 + hi) ^ ((r32 >> 1) & 7)) << 4);
    f32x16 cinit;
#pragma unroll
    for (int r = 0; r < 16; ++r) cinit[r] = -sb2;
    bf16x8 qr2[2][4]; u32x4 gav2[2][4];
    {
        const bf16_t* Qw = PB + (rowbase + q0 + 64 * jj + r32) * DIN + OFF_Q + h * 64 + hi * 8;
#pragma unroll
        for (int d0 = 0; d0 < 4; ++d0) qr2[0][d0] = *(const bf16x8*)(Qw + d0 * 16);
    }
    asm volatile("s_waitcnt vmcnt(0)" ::: "memory");
    __syncthreads();
    {
        const bf16_t* Qw = PB + (rowbase + q0 + 64 * jj + 32 + r32) * DIN + OFF_Q + h * 64 + hi * 8;
#pragma unroll
        for (int d0 = 0; d0 < 4; ++d0) qr2[1][d0] = *(const bf16x8*)(Qw + d0 * 16);
    }
#pragma unroll
    for (int i = 0; i < 2; ++i) {
        const int R0 = q0 + 64 * jj + 32 * i;
#pragma unroll
        for (int it = 0; it < 4; ++it) gav2[i][it] = *(const u32x4*)(PB + (rowbase + R0 + it * 8 + (lane >> 3)) * DIN + OFF_GA + h * 64 + (lane & 7) * 8);
    }
    if (PROBE_TS == 130 && probe) STAMPG(1);
#pragma unroll
    for (int i = 0; i < 2; ++i) {
        if (PROBE_TS == 131 && probe && i == 1) STAMPG(1);
        const int R0 = q0 + 64 * jj + 32 * i;
        bf16x8 qr[4];
#pragma unroll
        for (int d0 = 0; d0 < 4; ++d0) qr[d0] = qr2[i][d0];
        f32x16 o[2]; o[0] = f32x16{}; o[1] = f32x16{};
        float lsum = 0.f;
        const int ta = jj > t_lo ? jj : t_lo, tb = (jj + 4) < t_hi ? (jj + 4) : t_hi;
        for (int t = ta; t <= tb; ++t) {
            f32x16 p0, p1;
            qkt(p0, p1, shm3 + L_K + t * SLOTB, koff, qr, cinit);
            const float Lf = (float)(kb0 + 64 * t + 4 * hi - (R0 + r32));
            const bool edge = (t == jj) || (t == jj + 4);
            if (edge) {
#pragma unroll
                for (int r = 0; r < 16; ++r) {
                    const float c = (float)((r & 3) + 8 * (r >> 2));
                    const float x0 = __builtin_fabsf(Lf + c), x1 = __builtin_fabsf(Lf + (c + 32.f));
                    const float a0 = (x0 > 128.f) ? -INFINITY : p0[r] - slope2 * x0, a1 = (x1 > 128.f) ? -INFINITY : p1[r] - slope2 * x1;
                    p0[r] = __builtin_amdgcn_exp2f(a0); p1[r] = __builtin_amdgcn_exp2f(a1);
                }
            } else {
#pragma unroll
                for (int r = 0; r < 16; ++r) {
                    const float c = (float)((r & 3) + 8 * (r >> 2));
                    const float x0 = __builtin_fabsf(Lf + c), x1 = __builtin_fabsf(Lf + (c + 32.f));
                    p0[r] = __builtin_amdgcn_exp2f(p0[r] - slope2 * x0); p1[r] = __builtin_amdgcn_exp2f(p1[r] - slope2 * x1);
                }
            }
            float sacc = 0.f;
#pragma unroll
            for (int r = 0; r < 16; ++r) sacc += p0[r] + p1[r];
            lsum += sacc;
            u32x4 pw0, pw1, pw2, pw3;
            pw0 = (u32x4){cvtpk(p0[0], p0[1]), cvtpk(p0[2], p0[3]), cvtpk(p0[4], p0[5]), cvtpk(p0[6], p0[7])};
            pw1 = (u32x4){cvtpk(p0[8], p0[9]), cvtpk(p0[10], p0[11]), cvtpk(p0[12], p0[13]), cvtpk(p0[14], p0[15])};
            pw2 = (u32x4){cvtpk(p1[0], p1[1]), cvtpk(p1[2], p1[3]), cvtpk(p1[4], p1[5]), cvtpk(p1[6], p1[7])};
            pw3 = (u32x4){cvtpk(p1[8], p1[9]), cvtpk(p1[10], p1[11]), cvtpk(p1[12], p1[13]), cvtpk(p1[14], p1[15])};
            pv(o, vp0 + t * SLOTB, __builtin_bit_cast(bf16x8, pw0), __builtin_bit_cast(bf16x8, pw1), __builtin_bit_cast(bf16x8, pw2), __builtin_bit_cast(bf16x8, pw3));
        }
        if (i == 0) {
#pragma unroll
            for (int i2 = 0; i2 < 2; ++i2)
#pragma unroll
                for (int it = 0; it < 4; ++it) asm volatile("" : "+v"(gav2[i2][it]));
#pragma unroll
            for (int d0 = 0; d0 < 4; ++d0) asm volatile("" : "+v"(qr2[1][d0]));
        }
        lsum += __shfl_xor(lsum, 32);
        const float rl = __builtin_amdgcn_rcpf(lsum + snk);
        if (hi == 0) wsf[r32] = rl;
        asm volatile("s_waitcnt lgkmcnt(0)" ::: "memory");
        LAS bf16_t* stg = (LAS bf16_t*)(shm + L_OST) + wid * 2048;
#pragma unroll
        for (int r = 0; r < 16; ++r) { const int orow = crow(r, hi); const float rr = wsf[orow];
#pragma unroll
            for (int d0 = 0; d0 < 2; ++d0) stg[orow * 64 + d0 * 32 + r32] = (bf16_t)cvtpk(o[d0][r] * rr, 0.f); }
        asm volatile("s_waitcnt lgkmcnt(0)" ::: "memory");
#pragma unroll
        for (int it = 0; it < 4; ++it) {
            const int row = it * 8 + (lane >> 3), ch = lane & 7;
            const u32x4 ov = *(const LAS u32x4*)(stg + row * 64 + ch * 8);
            const u32x4 gv = gav2[i][it];
            u32x4 w;
#pragma unroll
            for (int e = 0; e < 4; ++e) w[e] = cvtpk(bflo(ov[e]) * bflo(gv[e]), bfhi(ov[e]) * bfhi(gv[e]));
            st16wt(Y + (rowbase + R0 + row) * DM + h * 64 + ch * 8, w);
        }
        asm volatile("s_waitcnt lgkmcnt(0)" ::: "memory");
    }
    if (PROBE_TS == 132 && probe) STAMPG(1);
    __syncthreads();
    if (PROBE_TS == 133 && probe) STAMPG(1);
}

__device__ __forceinline__ void gmlp_half(int item, const bf16_t* PB, bf16_t* Y, const bf16_t* Wsb, const float* bs_l, LAS unsigned char* shw  ) {
    int tid = threadIdx.x; asm volatile("" : "+v"(tid));
    const int lane = tid & 63, r32 = lane & 31, hi = lane >> 5;
    const int th = item & 1, g = (item >> 1) & 7, ch = item >> 4;
    const long row0 = (long)ch * 128;
    const unsigned ldsw = (unsigned)(uintptr_t)shw;
#pragma unroll
    for (int pc = 0; pc < 16; ++pc) { const int tt = pc >> 3, pw = pc & 7;
        glds16(PB + (row0 + 64 * tt + 16 * (pw & 3) + (lane >> 2)) * DIN + OFF_VG + g * 64 + (pw >> 2) * 32 + (lane & 3) * 8, (unsigned)__builtin_amdgcn_readfirstlane(ldsw + tt * 8192 + pw * 1024)); }
    u32x4 wq[2][8];
#pragma unroll
    for (int tb = 0; tb < 2; ++tb) {
        const bf16_t* wrow = Wsb + ((size_t)g * 128 + 64 * th + 32 * tb + r32) * 128 + 8 * hi;
#pragma unroll
        for (int ks = 0; ks < 8; ++ks) wq[tb][ks] = *(const u32x4*)(wrow + 16 * ks);
    }
    float bsr[8];
#pragma unroll
    for (int it = 0; it < 8; ++it) bsr[it] = bs_l[g * 128 + 64 * th + it * 8 + (lane >> 3)];
    asm volatile("s_waitcnt vmcnt(0)" ::: "memory");
    const lds_cptr vp0 = (lds_cptr)shw + ((lane >> 4) & 1) * 32 + (lane & 3) * 8 + (4 * hi + ((lane & 15) >> 2)) * 64;
    f32x16 o[2][2];
#pragma unroll
    for (int tb = 0; tb < 2; ++tb) {
        o[tb][0] = f32x16{}; o[tb][1] = f32x16{};
#pragma unroll
        for (int ks = 0; ks < 8; ++ks) {
            const auto s0_ = __builtin_amdgcn_permlane32_swap(wq[tb][ks].x, wq[tb][ks].z, false, false), s1_ = __builtin_amdgcn_permlane32_swap(wq[tb][ks].y, wq[tb][ks].w, false, false);
            const u32x4 wa = (u32x4){s0_[0], s1_[0], s0_[1], s1_[1]};
            const bf16x8 A = __builtin_bit_cast(bf16x8, wa);
#pragma unroll
            for (int d0 = 0; d0 < 2; ++d0) {
                const s16x4 lo = vtr(vp0 + (ks >> 2) * 8192 + d0 * 4096 + (ks & 3) * 1024), hh = vtr(vp0 + (ks >> 2) * 8192 + d0 * 4096 + (ks & 3) * 1024 + 512);
                const bf16x8 B = (bf16x8){lo[0], lo[1], lo[2], lo[3], hh[0], hh[1], hh[2], hh[3]};
                o[tb][d0] = __builtin_amdgcn_mfma_f32_32x32x16_bf16(A, B, o[tb][d0], 0, 0, 0);
            }
        }
    }
    u32x4 uv[8];
    const bf16_t* pe = PB + (row0 + 64 * th + (lane >> 3)) * DIN + g * 64 + (lane & 7) * 8;
#pragma unroll
    for (int it = 0; it < 8; ++it) uv[it] = *(const u32x4*)(pe + (size_t)it * 8 * DIN + OFF_U);
    asm volatile("s_waitcnt lgkmcnt(0)" ::: "memory");
    LAS float* sv = (LAS float*)shw;
#pragma unroll
    for (int tb = 0; tb < 2; ++tb)
#pragma unroll
        for (int r = 0; r < 16; ++r)
#pragma unroll
            for (int d0 = 0; d0 < 2; ++d0) sv[(32 * tb + crow(r, hi)) * 64 + 32 * d0 + r32] = o[tb][d0][r];
    asm volatile("s_waitcnt lgkmcnt(0)" ::: "memory");
    bf16_t* ye = Y + (row0 + 64 * th + (lane >> 3)) * DM + 512 + g * 64 + (lane & 7) * 8;
#pragma unroll
    for (int it = 0; it < 8; ++it) asm volatile("" : "+v"(uv[it]));
#pragma unroll
    for (int it = 0; it < 8; ++it) {
        const LAS float* sp = sv + (it * 8 + (lane >> 3)) * 64 + (lane & 7) * 8;
        const f32x4 s0 = *(const LAS f32x4*)sp + bsr[it], s1 = *(const LAS f32x4*)(sp + 4) + bsr[it];
        u32x4 w;
        w.x = cvtpk(s0[0] * bflo(uv[it].x), s0[1] * bfhi(uv[it].x));
        w.y = cvtpk(s0[2] * bflo(uv[it].y), s0[3] * bfhi(uv[it].y));
        w.z = cvtpk(s1[0] * bflo(uv[it].z), s1[1] * bfhi(uv[it].z));
        w.w = cvtpk(s1[2] * bflo(uv[it].w), s1[3] * bfhi(uv[it].w));
        st16wt(ye + (size_t)it * 8 * DM, w);
    }
    asm volatile("s_waitcnt lgkmcnt(0)" ::: "memory");
}
}

constexpr int NWAVES = 8;
constexpr size_t MiB = 1u << 20;
constexpr size_t WS_CTL = 0, CTL_ZERO_BYTES = 192 * 1024;
constexpr size_t WS_ADA = 64 * 1024;
constexpr size_t WS_BIAS = 128 * 1024;
constexpr size_t WS_SSQ = 1 * MiB + 256 * 1024;
constexpr size_t WS_WIN = 2 * MiB;
constexpr size_t WS_WOUT = 26 * MiB;
constexpr size_t WS_WS = 34 * MiB;
constexpr size_t WS_XB = 36 * MiB;
constexpr size_t WS_Y = 68 * MiB;
constexpr size_t WS_PB = 100 * MiB;
constexpr size_t WS_END = 192 * MiB;
static_assert(WS_WIN + (size_t)NL * 2 * DIN * DM * 2 <= WS_WOUT && WS_PB + (size_t)M * DIN * 2 <= WS_END, "ws map");
constexpr int CW_PANEL = 256;
constexpr int CW_PANEL2 = 2304;
constexpr int CW_PANEL0 = 3968;
constexpr int CW_CONV0 = 3360;
constexpr int CW_MIXDONE = 3328;
constexpr int CW_CONVDONE = 3392;
constexpr int CW_PANEL3 = 3456;
constexpr int CW_BAR = 4096;

constexpr int RING_BYTES = 136 * 1024;
constexpr int MISC_OFF = RING_BYTES;
constexpr int LDS_BYTES = 144 * 1024;
static_assert(mix::L_END <= RING_BYTES && pg8::STAGE_BYTES <= RING_BYTES && 8 * 16384 <= RING_BYTES, "LDS map");

#define XB_TMO      128
#define XB_XCNT(j)  (256  + 64 * (j))
#define XB_XSUB(j)  (1280 + 64 * (j))
#define XB_XGEN(j)  (2304 + 64 * (j))
#define XB_TOP      3328
#define XB_TOPGEN   3392
#define XCD_BAR_WORDS 3456
#define XB_SPIN_CAP (1u << 18)
static_assert(CW_PANEL + 2 * 64 * 16 <= CW_PANEL2 && CW_PANEL2 + 64 * 16 <= CW_MIXDONE && CW_MIXDONE < CW_CONVDONE && CW_CONVDONE < CW_PANEL3 && CW_PANEL3 + 2 * 64 * 4 <= CW_BAR && (CW_BAR + XCD_BAR_WORDS) * 4 <= 64 * 1024, "control words inside the memset region, below the ada table");

__device__ __forceinline__ void poll3(unsigned* a, unsigned ta, unsigned* b, unsigned tb, unsigned* c, unsigned tc) {
    unsigned sp_ = 0;
    for (;;) {
        const unsigned va = __hip_atomic_load(a, __ATOMIC_RELAXED, __HIP_MEMORY_SCOPE_AGENT), vb = __hip_atomic_load(b, __ATOMIC_RELAXED, __HIP_MEMORY_SCOPE_AGENT), vc = __hip_atomic_load(c, __ATOMIC_RELAXED, __HIP_MEMORY_SCOPE_AGENT);
        if (va >= ta && vb >= tb && vc >= tc) break;
        if (++sp_ > (1u << 22)) break;
    }
}
__device__ __forceinline__ unsigned xb_ld(unsigned* p)              { return __hip_atomic_load(p, __ATOMIC_RELAXED, __HIP_MEMORY_SCOPE_AGENT); }
__device__ __forceinline__ unsigned xb_add(unsigned* p, unsigned v) { return __hip_atomic_fetch_add(p, v, __ATOMIC_RELAXED, __HIP_MEMORY_SCOPE_AGENT); }
__device__ __forceinline__ unsigned xb_xcc_id() { return (unsigned)__builtin_amdgcn_s_getreg((3 << 11) | 20) & 0xFu; }
#define XB_SPIN(cond, bar) do { unsigned _sp = 0; while (cond) { __builtin_amdgcn_s_sleep(1); \
    if ((++_sp & 255u) == 0u) { if (xb_ld(&(bar)[XB_TMO])) break; if (_sp > XB_SPIN_CAP) { atomicAdd(&(bar)[XB_TMO], 1u); break; } } } } while (0)

struct XcdBarrier { unsigned* bar; unsigned x; volatile LAS unsigned* st; };
__device__ __forceinline__ XcdBarrier xcd_barrier_post(unsigned* bar, volatile LAS unsigned* st) {
    XcdBarrier b; b.bar = bar; b.x = xb_xcc_id(); b.st = st;
    if (threadIdx.x == 0) (void)xb_add(&bar[XB_XCNT(b.x)], 1u);
    return b;
}
__device__ __forceinline__ void xcd_barrier_complete(unsigned* bar, unsigned x, unsigned& nloc, unsigned& nx) {
    const unsigned G = gridDim.x * gridDim.y * gridDim.z;
    unsigned sum, cnt, mine, sp = 0u;
    for (;;) {
        sum = 0u; cnt = 0u; mine = 0u;
#pragma unroll
        for (unsigned j = 0; j < 16; ++j) { const unsigned c = xb_ld(&bar[XB_XCNT(j)]); sum += c; cnt += (c > 0u) ? 1u : 0u; mine = (j == x) ? c : mine; }
        if (sum == G) break;
        __builtin_amdgcn_s_sleep(1);
        if ((++sp & 255u) == 0u) { if (xb_ld(&bar[XB_TMO])) break; if (sp > XB_SPIN_CAP) { atomicAdd(&bar[XB_TMO], 1u); break; } }
    }
    nloc = mine > 0u ? mine : 1u; nx = cnt > 0u ? cnt : 1u;
}
__device__ __forceinline__ void xcd_barrier(const XcdBarrier& b) {
    asm volatile("s_waitcnt vmcnt(0)" ::: "memory");
    __syncthreads();
    if (threadIdx.x == 0) {
        unsigned* bar = b.bar;
        __builtin_amdgcn_s_waitcnt(0);
        unsigned nloc = b.st[0], nx = b.st[1];
        if (nloc == 0u) { xcd_barrier_complete(bar, b.x, nloc, nx); b.st[0] = nloc; b.st[1] = nx; }
#if MK_BAR_EVERY_WG_RELEASES
        __builtin_amdgcn_fence(__ATOMIC_RELEASE, "agent");
        asm volatile("s_waitcnt vmcnt(0)" ::: "memory");
#endif
        const unsigned old = xb_add(&bar[XB_XSUB(b.x)], 1u);
        const unsigned gen = old / nloc;
        if (old + 1u == (gen + 1u) * nloc) {
#if !MK_BAR_EVERY_WG_RELEASES
            __builtin_amdgcn_fence(__ATOMIC_RELEASE, "agent");
            asm volatile("s_waitcnt vmcnt(0)" ::: "memory");
#endif
            const unsigned og = xb_add(&bar[XB_TOP], 1u);
            const unsigned tg = og / nx;
            if (og + 1u == (tg + 1u) * nx) xb_add(&bar[XB_TOPGEN], 1u);
            else XB_SPIN(xb_ld(&bar[XB_TOPGEN]) == tg, bar);
            __builtin_amdgcn_fence(__ATOMIC_ACQUIRE, "agent");
            xb_add(&bar[XB_XGEN(b.x)], 1u);
            asm volatile("s_waitcnt vmcnt(0)" ::: "memory");
        } else {
            XB_SPIN(xb_ld(&bar[XB_XGEN(b.x)]) == gen, bar);
            __builtin_amdgcn_fence(__ATOMIC_ACQUIRE, "agent");
            asm volatile("s_waitcnt vmcnt(0)" ::: "memory");
        }
    }
    __syncthreads();
}

struct Args { const float* in[12]; float* out; unsigned char* ws; int ph_lo, ph_hi; };
static_assert(sizeof(Args) == 14 * 8 + 8, "Args has no padding");

__host__ __device__ __forceinline__ int permcol(int n) {
    if (n < OFF_U) return n;
    if (n < OFF_VG) { const int c = n - OFF_U; return OFF_U + 256 * (c >> 7) + 64 * ((c >> 5) & 3) + (c & 31); }
    if (n < OFF_GG) return n + 512;
    const int c = n - OFF_GG; return OFF_U + 256 * (c >> 7) + 64 * ((c >> 5) & 3) + 32 + (c & 31);
}
struct TrItem { const float* W; int N; bf16_t* WT; size_t bstride_el; const float* gain; const float* sc; const float* shift; float* bias_acc; int item; int mode; };
__device__ __forceinline__ void tr_load(const TrItem& I, int lane, float (&wv)[32], float (&shv)[2]) {
    const int nblk = I.N / 32, kb = I.item / nblk, nb = I.item % nblk, k0 = 64 * kb, n0 = 32 * nb;
#pragma unroll
    for (int i = 0; i < 32; ++i) wv[i] = __builtin_nontemporal_load(&I.W[(size_t)(k0 + 2 * i + (lane >> 5)) * I.N + n0 + (lane & 31)]);
    shv[0] = 0.f; shv[1] = 0.f;
    if (I.mode == 0) { shv[0] = I.shift[(lane >> 5) * 3 * DM + k0 + (lane & 31)]; shv[1] = I.shift[(lane >> 5) * 3 * DM + k0 + 32 + (lane & 31)]; }
}
template <int MODE>
__device__ __forceinline__ void tr_finish(const TrItem& I, int lane, const float (&wv)[32], const float (&shv)[2], LAS float* scr) {
    constexpr int K = DM, scs = 3 * DM;
    const int N = I.N, nblk = N / 32, kb = I.item / nblk, nb = I.item % nblk, k0 = 64 * kb, n0 = 32 * nb;
    const int c = lane & 7;
    float f[2][8], gtv[2][4];
    if (MODE == 0) {
#pragma unroll
        for (int e = 0; e < 8; ++e) { const float gn = I.gain[k0 + 8 * c + e]; f[0][e] = gn * (1.f + I.sc[k0 + 8 * c + e]); f[1][e] = gn * (1.f + I.sc[scs + k0 + 8 * c + e]); }
    } else {
#pragma unroll
        for (int bb = 0; bb < 2; ++bb)
#pragma unroll
            for (int j = 0; j < 4; ++j) gtv[bb][j] = I.sc[bb * scs + n0 + (lane >> 3) + 8 * j];
    }
#pragma unroll
    for (int i = 0; i < 32; ++i) scr[(2 * i + (lane >> 5)) * 33 + (lane & 31)] = wv[i];
    LAS float* shl = scr + 64 * 33;
    if (MODE == 0) { shl[(lane >> 5) * 64 + (lane & 31)] = shv[0]; shl[(lane >> 5) * 64 + 32 + (lane & 31)] = shv[1]; }
    asm volatile("s_waitcnt lgkmcnt(0)" ::: "memory");
    if (MODE == 0) {
        const int bb = lane >> 5, n = lane & 31; float a = 0.f;
#pragma unroll 16
        for (int kk = 0; kk < 64; ++kk) a += shl[bb * 64 + kk] * scr[kk * 33 + n];
        atomicAdd(I.bias_acc + bb * N + permcol(n0) + n, a);
    }
    if (MODE == 0) {
#pragma unroll
        for (int bb = 0; bb < 2; ++bb)
#pragma unroll
            for (int e = 0; e < 8; ++e) asm volatile("" : "+v"(f[bb][e]));
    } else {
#pragma unroll
        for (int bb = 0; bb < 2; ++bb)
#pragma unroll
            for (int j = 0; j < 4; ++j) asm volatile("" : "+v"(gtv[bb][j]));
    }
#pragma unroll
    for (int j = 0; j < 4; ++j) { const int n = (lane >> 3) + 8 * j; const LAS float* sp = scr + (8 * c) * 33 + n;
        float v[8];
#pragma unroll
        for (int e = 0; e < 8; ++e) v[e] = sp[e * 33];
#pragma unroll
        for (int bb = 0; bb < 2; ++bb) {
            float g[8];
            if (MODE == 0) {
#pragma unroll
                for (int e = 0; e < 8; ++e) g[e] = f[bb][e];
            } else { const float gt = gtv[bb][j];
#pragma unroll
                for (int e = 0; e < 8; ++e) g[e] = gt; }
            u32x4 o; o.x = pk2(v[0] * g[0], v[1] * g[1]); o.y = pk2(v[2] * g[2], v[3] * g[3]); o.z = pk2(v[4] * g[4], v[5] * g[5]); o.w = pk2(v[6] * g[6], v[7] * g[7]);
            st16wt(I.WT + (size_t)bb * I.bstride_el + (size_t)((MODE == 0 ? permcol(n0) : n0) + n) * K + k0 + 8 * c, o); } }
    asm volatile("s_waitcnt lgkmcnt(0)" ::: "memory");
}
constexpr int TR_I_IN = (DM / 64) * (DIN / 32), TR_I_OUT = (DM / 64) * (DM / 32), TR_TOTAL = 2 * (TR_I_IN + TR_I_OUT);
__device__ __forceinline__ TrItem tr_make(int id, const float* w_in, const float* w_out, const float* norm_gain, const float* ADA, float* BIAS, bf16_t* WIN, bf16_t* WOUT) {
    TrItem I; int l, r;
    if (id < TR_I_IN) { l = 0; r = id; I.mode = 0; } else if (id < TR_I_IN + TR_I_OUT) { l = 0; r = id - TR_I_IN; I.mode = 1; }
    else if (id < 2 * TR_I_IN + TR_I_OUT) { l = 1; r = id - TR_I_IN - TR_I_OUT; I.mode = 0; } else { l = 1; r = id - 2 * TR_I_IN - TR_I_OUT; I.mode = 1; }
    I.item = r;
    if (I.mode == 0) { I.W = w_in + (size_t)l * DM * DIN; I.N = DIN; I.WT = WIN + (size_t)l * 2 * DIN * DM; I.bstride_el = (size_t)DIN * DM; I.gain = norm_gain + l * DM; I.sc = ADA + l * 2 * 3 * DM + DM; I.shift = ADA + l * 2 * 3 * DM; I.bias_acc = BIAS + l * 2 * DIN; }
    else { I.W = w_out + (size_t)l * DM * DM; I.N = DM; I.WT = WOUT + (size_t)l * 2 * DM * DM; I.bstride_el = (size_t)DM * DM; I.gain = nullptr; I.sc = ADA + l * 2 * 3 * DM + 2 * DM; I.shift = nullptr; I.bias_acc = nullptr; }
    return I;
}
__device__ __forceinline__ void tr_run(int first, int last, int stride, int lane, LAS float* scr, const float* w_in, const float* w_out, const float* norm_gain, const float* ADA, float* BIAS, bf16_t* WIN, bf16_t* WOUT) {
    for (int id = first; id < last; id += 2 * stride) {
        const bool two = (id + stride < last);
        const TrItem I0 = tr_make(id, w_in, w_out, norm_gain, ADA, BIAS, WIN, WOUT), I1 = tr_make(two ? id + stride : id, w_in, w_out, norm_gain, ADA, BIAS, WIN, WOUT);
        float wa[32], wb[32], sa[2], sb[2];
        tr_load(I0, lane, wa, sa);
        if (two) tr_load(I1, lane, wb, sb);
        if (two) {
#pragma unroll
            for (int i = 0; i < 32; ++i) asm volatile("" : "+v"(wb[i]));
            asm volatile("" : "+v"(sb[0]), "+v"(sb[1]));
        }
        if (I0.mode == 0) tr_finish<0>(I0, lane, wa, sa, scr); else tr_finish<1>(I0, lane, wa, sa, scr);
        if (two) { if (I1.mode == 0) tr_finish<0>(I1, lane, wb, sb, scr); else tr_finish<1>(I1, lane, wb, sb, scr); }
    }
}

template <bool SILU>
__device__ __forceinline__ void gemv32(const float* W, int N, int n0, const float* vec  , int vstride, const float* addb, float* out  , int ostride, LAS float* red  ) {
    const int tid = threadIdx.x, lane = tid & 63, w = tid >> 6, cg = lane & 7, rg = lane >> 3;
    f32x4 a0 = {0.f, 0.f, 0.f, 0.f}, a1 = {0.f, 0.f, 0.f, 0.f};
#pragma unroll
    for (int it = 0; it < 16; ++it) {
        const int k = 128 * w + 8 * it + rg;
        const f32x4 wv = *(const f32x4*)(W + (size_t)k * N + n0 + 4 * cg);
        float s0 = vec[k], s1 = vec[vstride + k];
        if (SILU) { s0 = fsilu(s0); s1 = fsilu(s1); }
        a0 += wv * s0; a1 += wv * s1;
    }
#pragma unroll
    for (int e = 0; e < 4; ++e) {
        a0[e] += __shfl_xor(a0[e], 8); a0[e] += __shfl_xor(a0[e], 16); a0[e] += __shfl_xor(a0[e], 32);
        a1[e] += __shfl_xor(a1[e], 8); a1[e] += __shfl_xor(a1[e], 16); a1[e] += __shfl_xor(a1[e], 32);
    }
    if (rg == 0) {
#pragma unroll
        for (int e = 0; e < 4; ++e) { red[(w * 2 + 0) * 32 + 4 * cg + e] = a0[e]; red[(w * 2 + 1) * 32 + 4 * cg + e] = a1[e]; }
    }
    __syncthreads();
    if (tid < 64) { const int bb = tid >> 5, col = tid & 31; float s = addb ? addb[n0 + col] : 0.f;
#pragma unroll
        for (int ww = 0; ww < 8; ++ww) s += red[(ww * 2 + bb) * 32 + col];
        out[bb * ostride + n0 + col] = s; }
    __syncthreads();
}

#define XROWS(R0_, CNT_, WT_) do { \
            const int r0 = (R0_); \
            const f32x4* xr = (const f32x4*)(x + (size_t)r0 * DM) + lane; \
            f32x4 v[CNT_][4]; \
            _Pragma("unroll") for (int q = 0; q < (CNT_); ++q) _Pragma("unroll") for (int j = 0; j < 4; ++j) v[q][j] = __builtin_nontemporal_load(&xr[q * (DM / 4) + 64 * j]); \
            if (WT_) { _Pragma("unroll") for (int q = 0; q < (CNT_); ++q) _Pragma("unroll") for (int j = 0; j < 4; ++j) asm volatile("" : "+v"(v[q][j])); }     \
            _Pragma("unroll") for (int q = 0; q < (CNT_); ++q) { \
                float sq = 0.f; \
                _Pragma("unroll") for (int j = 0; j < 4; ++j) sq += (v[q][j][0] * v[q][j][0] + v[q][j][1] * v[q][j][1]) + (v[q][j][2] * v[q][j][2] + v[q][j][3] * v[q][j][3]); \
                sq = wave_sum(sq); \
                u32x2* o8 = (u32x2*)(XB + (size_t)(r0 + q) * DM) + lane; \
                _Pragma("unroll") for (int j = 0; j < 4; ++j) { u32x2 w; w.x = cvtpk(v[q][j][0], v[q][j][1]); w.y = cvtpk(v[q][j][2], v[q][j][3]); if (WT_) st8wt(o8 + 64 * j, w); else st8(o8 + 64 * j, w); } \
                if (lane == 0) { const f32x4 s4 = (f32x4){sq, 0.f, 0.f, 0.f}; if (WT_) st16wt(SSQ + (size_t)(r0 + q) * 4, __builtin_bit_cast(u32x4, s4)); else *(f32x4*)(SSQ + (size_t)(r0 + q) * 4) = s4; } \
            } } while (0)

__global__ void __launch_bounds__(NWAVES * 64, 2) mk_fwd(Args args) {
    __shared__ __attribute__((aligned(16))) unsigned char lds_raw[LDS_BYTES];
    LAS unsigned char* lds = (LAS unsigned char*)lds_raw;
    volatile LAS unsigned* MISC = (volatile LAS unsigned*)(lds + MISC_OFF);
    const int tid0 = threadIdx.x;
    const int G = gridDim.x; const int bx = blockIdx.x; const int vcu = (G % 8 == 0) ? (bx % 8) * (G / 8) + bx / 8 : bx;
    unsigned char* ws = args.ws;
    const float* x = args.in[0]; const float* cvec = args.in[1]; const float* w_ada = args.in[2]; const float* b_ada = args.in[3]; const float* norm_gain = args.in[4]; const float* w_in = args.in[5];
    const float* q_gain = args.in[6]; const float* k_gain = args.in[7]; const float* sink = args.in[8]; const float* w_s = args.in[9]; const float* b_s = args.in[10]; const float* w_out = args.in[11];
    float* out = args.out;
    float* ADA = (float*)(ws + WS_ADA); float* BIAS = (float*)(ws + WS_BIAS); float* SSQ = (float*)(ws + WS_SSQ);
    bf16_t* WIN = (bf16_t*)(ws + WS_WIN); bf16_t* WOUT = (bf16_t*)(ws + WS_WOUT); bf16_t* WSB = (bf16_t*)(ws + WS_WS);
    bf16_t* XB = (bf16_t*)(ws + WS_XB); bf16_t* Y = (bf16_t*)(ws + WS_Y); bf16_t* PB = (bf16_t*)(ws + WS_PB);
    if (tid0 < 64) MISC[tid0] = 0u;
    __syncthreads();
    const int lo = args.ph_lo, hi = args.ph_hi;
#define STAMP(i_) do { const unsigned long long t_ = __builtin_amdgcn_s_memrealtime(); if (threadIdx.x == 0) { MISC[16 + 2 * (i_)] = (unsigned)t_; MISC[17 + 2 * (i_)] = (unsigned)(t_ >> 32); } } while (0)
    if (PROBE_TS >= 0) STAMP(0);
    XcdBarrier bar; bar.bar = (unsigned*)(ws + WS_CTL) + CW_BAR; bar.x = 0; bar.st = MISC + 8;
    if (hi - lo > 1) bar = xcd_barrier_post((unsigned*)(ws + WS_CTL) + CW_BAR, MISC + 8);
#define IN(k) (lo <= (k) && (k) < hi)
#define SEAM(k) do { if ((k) + 1 < hi) xcd_barrier(bar); if (PROBE_TS == (k)) STAMP(1); } while (0)
#define REPS(k) (((k) == PROBE_REP) ? 2 : 1)

  for (int pass_ = 0; pass_ < PROBE_PASSES; ++pass_) {
    int tid = threadIdx.x; asm volatile("" : "+v"(tid));
    const int lane = tid & 63, wave = __builtin_amdgcn_readfirstlane(tid >> 6);
    const int gw = vcu * NWAVES + wave, NGW = G * NWAVES;
    if (((PH_MASK >> 0) & 1) && IN(0)) {
      for (int rep_ = 0; rep_ < REPS(0); ++rep_) {
        if (bx < NL * 2 * 48) {
            const int l = bx / 96, r = bx % 96, kh = r / 48, cb = r % 48, cg = lane & 15, rg = lane >> 4;
            const int k0 = 512 * kh + 64 * wave + 16 * rg;
            const float* wp = w_ada + ((size_t)l * DM + k0) * 3 * DM + 64 * cb + 4 * cg;
            f32x4 wr_[16];
#pragma unroll
            for (int i = 0; i < 16; ++i) wr_[i] = __builtin_nontemporal_load((const f32x4*)(wp + (size_t)i * 3 * DM));
            f32x4 a0 = {0.f, 0.f, 0.f, 0.f}, a1 = {0.f, 0.f, 0.f, 0.f};
#pragma unroll
            for (int i = 0; i < 16; ++i) { const float s0 = fsilu(cvec[k0 + i]), s1 = fsilu(cvec[DM + k0 + i]); a0 += wr_[i] * s0; a1 += wr_[i] * s1; }
#pragma unroll
            for (int e = 0; e < 4; ++e) { a0[e] += __shfl_xor(a0[e], 16); a0[e] += __shfl_xor(a0[e], 32); a1[e] += __shfl_xor(a1[e], 16); a1[e] += __shfl_xor(a1[e], 32); }
            LAS float* red = (LAS float*)lds;
            if (rg == 0) { *(LAS f32x4*)(red + (wave * 2 + 0) * 64 + 4 * cg) = a0; *(LAS f32x4*)(red + (wave * 2 + 1) * 64 + 4 * cg) = a1; }
            __syncthreads();
            if (tid < 128) {
                const int b = tid >> 6, n = tid & 63;
                float sum = (kh == 0) ? b_ada[l * 3 * DM + 64 * cb + n] : 0.f;
#pragma unroll
                for (int w = 0; w < 8; ++w) sum += red[(w * 2 + b) * 64 + n];
                atomicAdd(ADA + (size_t)(l * 2 + b) * 3 * DM + 64 * cb + n, sum);
            }
            __syncthreads();
        }
        if (PROBE_TS == 100) STAMP(1);
        for (int it = gw; it < NL * 8 * 128 * 128 / 512; it += NGW) {
            const float* sp = w_s + (size_t)it * 512 + lane * 8; const f32x4 a = *(const f32x4*)sp, b2 = *(const f32x4*)(sp + 4);
            u32x4 o; o.x = pk2(a[0], a[1]); o.y = pk2(a[2], a[3]); o.z = pk2(b2[0], b2[1]); o.w = pk2(b2[2], b2[3]);
            *(u32x4*)(WSB + (size_t)it * 512 + lane * 8) = o; }
        XROWS(gw * 4, 4, 0);
      }
        if (PROBE_TS == 101) STAMP(1);
        SEAM(0);
    }
    if (((PH_MASK >> 1) & 1) && IN(1)) {
      for (int rep_ = 0; rep_ < REPS(1); ++rep_) {
        tr_run(gw, TR_I_IN, NGW, lane, (LAS float*)(lds + wave * 16384), w_in, w_out, norm_gain, ADA, BIAS, WIN, WOUT);
      }
        if (PROBE_TS == 111) STAMP(1);
        for (int xb_ = 0; xb_ < PROBE_BAR; ++xb_) SEAM(1);
        SEAM(1);
        if (lo < 2 && (bx % 8) >= 4) {
            int tid3 = threadIdx.x; asm volatile("" : "+v"(tid3));
            const int lane3 = tid3 & 63, wave3 = __builtin_amdgcn_readfirstlane(tid3 >> 6);
            const int pmb = 8 * (bx % 8) + (bx / 8) % 8, qb3 = (bx / 64) & 3;
            { const int lane = lane3; XROWS(256 * pmb + 64 * qb3 + 8 * wave3, 8, 1); }
            asm volatile("s_waitcnt vmcnt(0)" ::: "memory");
            __syncthreads();
            if (tid3 == 0) __hip_atomic_fetch_add((unsigned*)(ws + WS_CTL) + CW_PANEL0 + pmb * 2, 1u, __ATOMIC_RELAXED, __HIP_MEMORY_SCOPE_AGENT);
            const int gwB = (((bx % 8) - 4) * 32 + bx / 8) * NWAVES + wave3;
            tr_run(TR_I_IN + gwB, TR_I_IN + TR_I_OUT, (G / 2) * NWAVES, lane3, (LAS float*)(lds + wave3 * 16384), w_in, w_out, norm_gain, ADA, BIAS, WIN, WOUT);
            asm volatile("s_waitcnt vmcnt(0)" ::: "memory");
            __syncthreads();
            if (tid3 == 0) __hip_atomic_fetch_add((unsigned*)(ws + WS_CTL) + CW_CONV0, 1u, __ATOMIC_RELAXED, __HIP_MEMORY_SCOPE_AGENT);
        }
    }
    for (int l = 0; l < NL; ++l) {
        const int p0 = 2 + 3 * l;
        if (((PH_MASK >> 2) & 1) && IN(p0)) {
            if (l == 0 && lo < 2 && (bx % 8) >= 4) {
                if (tid == 0) { unsigned sp_ = 0;
                    while (__hip_atomic_load((unsigned*)(ws + WS_CTL) + CW_PANEL0 + (8 * (bx % 8) + (bx / 8) % 8) * 2, __ATOMIC_RELAXED, __HIP_MEMORY_SCOPE_AGENT) < 4u) { if (++sp_ > (1u << 22)) break; }
                    __builtin_amdgcn_fence(__ATOMIC_ACQUIRE, "agent"); asm volatile("s_waitcnt vmcnt(0)" ::: "memory"); }
                __syncthreads();
            }
            if (l == 1 && lo < 3 && 5 < hi) {
                if (tid == 0) { unsigned sp_ = 0;
                    poll3((unsigned*)(ws + WS_CTL) + CW_PANEL2 + (8 * (bx % 8) + (bx / 8) % 8) * 16, 4u,
                          (unsigned*)(ws + WS_CTL) + CW_MIXDONE + 16 * ((bx % 8) >= 4 ? 1 : 0), (unsigned)(G / 2),
                          (unsigned*)(ws + WS_CTL) + CW_CONVDONE, (unsigned)(3 * G - (M / 256) * (DIN / 256)));
                    __builtin_amdgcn_fence(__ATOMIC_ACQUIRE, "agent"); asm volatile("s_waitcnt vmcnt(0)" ::: "memory"); }
                __syncthreads();
            }
            if (DESYNC_TICKS > 0 && l == 0 && lo < 2 && (bx % 8) >= 4) { const unsigned long long t0_ = __builtin_amdgcn_s_memrealtime(); while (__builtin_amdgcn_s_memrealtime() - t0_ < (unsigned long long)DESYNC_TICKS) __builtin_amdgcn_s_sleep(8); }
            pg8::Gemm g{XB, WIN + (size_t)l * 2 * DIN * DM, M, DIN, DM, (size_t)DIN * DM * 2, nullptr, nullptr, 0}; pg8::StaticOrder S; S.init(M, DIN, G, bx);
            pg8::EpiProj E{PB, SSQ, BIAS + l * 2 * DIN, q_gain + l * 64, k_gain + l * 64};
            for (int rep_ = 0; rep_ < REPS(p0); ++rep_) pg8::gemm_phase<pg8::EpiProj, true>(lds, g, S, E, l == 0);
            if (l == 0 && bx >= (M / 256) * (DIN / 256) - 2 * G) {
                __syncthreads();
                int tid2 = threadIdx.x; asm volatile("" : "+v"(tid2));
                const int lane2 = tid2 & 63, wave2 = __builtin_amdgcn_readfirstlane(tid2 >> 6);
                const int nidle = G - ((M / 256) * (DIN / 256) - 2 * G), dw = (bx - (G - nidle)) * NWAVES + wave2;
                tr_run(TR_I_IN + TR_I_OUT + dw, TR_TOTAL, nidle * NWAVES, lane2, (LAS float*)(lds + wave2 * 16384), w_in, w_out, norm_gain, ADA, BIAS, WIN, WOUT);
                if (PROBE_TS == 126) STAMP(1);
            }
            if (PROBE_TS == 127 && l == 0) STAMP(1);
            if (lo < 2 && p0 + 1 < hi) {
                asm volatile("s_waitcnt vmcnt(0)" ::: "memory");
                __syncthreads();
                if (tid == 0) { __hip_atomic_fetch_add((unsigned*)(ws + WS_CTL) + CW_PANEL3 + (l * 64 + 8 * (bx % 8) + (bx / 8) % 8) * 4, 1u, __ATOMIC_RELAXED, __HIP_MEMORY_SCOPE_AGENT);
                    if (l == 0 && bx >= (M / 256) * (DIN / 256) - 2 * G) __hip_atomic_fetch_add((unsigned*)(ws + WS_CTL) + CW_CONVDONE, 1u, __ATOMIC_RELAXED, __HIP_MEMORY_SCOPE_AGENT); }
            } else SEAM(p0);
        }
        if (((PH_MASK >> 3) & 3) && IN(p0 + 1)) {
            const float qv_pre = __builtin_fabsf(q_gain[l * 64 + lane]), kv_pre = __builtin_fabsf(k_gain[l * 64 + lane]);
            if (lo < 2 && p0 + 1 < hi) {
                const int pmw = 8 * (bx % 8) + (bx / 8) % 8, qw = (bx / 64) & 3;
                const int nbw = (qw & 1) ? ((pmw & 31) < 31 ? pmw + 1 : pmw) : ((pmw & 31) > 0 ? pmw - 1 : pmw);
                if (tid == 0) { unsigned sp_ = 0;
                    poll3((unsigned*)(ws + WS_CTL) + CW_PANEL3 + (l * 64 + pmw) * 4, 4u, (unsigned*)(ws + WS_CTL) + CW_PANEL3 + (l * 64 + nbw) * 4, 4u,
                          (unsigned*)(ws + WS_CTL) + CW_CONV0, l == 0 ? (unsigned)(G / 2) : 0u);
                    __builtin_amdgcn_fence(__ATOMIC_ACQUIRE, "agent"); asm volatile("s_waitcnt vmcnt(0)" ::: "memory"); }
                __syncthreads();
            }
            float aq = qv_pre, ak = kv_pre;
            {
#pragma unroll
              for (int o = 1; o < 64; o <<= 1) { aq = fmaxf(aq, __shfl_xor(aq, o)); ak = fmaxf(ak, __shfl_xor(ak, o)); } }
            const float sb2 = 8.f * aq * ak * LOG2E;
          for (int rep_ = 0; rep_ < REPS(p0 + 1); ++rep_) {
            const int pmx = 8 * (bx % 8) + (bx / 8) % 8, qx = (bx / 64) & 3;
            if ((PH_MASK >> 3) & 1) mix::attn_unit(pmx >> 5, qx >> 1, 2 * (pmx & 31) + (qx & 1), PB, Y, sink + l * 8, sb2, lds);
            if ((PH_MASK >> 4) & 1) mix::gmlp_half(((2 * pmx + (qx >> 1)) << 4) | ((4 * (qx & 1) + (wave >> 1)) << 1) | (wave & 1), PB, Y, WSB + (size_t)l * 8 * 128 * 128, b_s + l * 8 * 128, lds + wave * 16384);
            if (REPS(p0 + 1) > 1) __syncthreads();
          }
            if (PROBE_TS == 134 && l == 0) STAMP(1);
            if (p0 + 2 < hi) {
                asm volatile("s_waitcnt vmcnt(0)" ::: "memory");
                __syncthreads();
                if (tid == 0) { __hip_atomic_fetch_add((unsigned*)(ws + WS_CTL) + CW_PANEL + (l * 64 + 8 * (bx % 8) + (bx / 8) % 8) * 16, 1u, __ATOMIC_RELAXED, __HIP_MEMORY_SCOPE_AGENT);
                    if (l == 0) __hip_atomic_fetch_add((unsigned*)(ws + WS_CTL) + CW_MIXDONE + 16 * ((bx % 8) >= 4 ? 1 : 0), 1u, __ATOMIC_RELAXED, __HIP_MEMORY_SCOPE_AGENT); }
            }
        }
        if (((PH_MASK >> 5) & 1) && IN(p0 + 2)) {
            pg8::Gemm g{Y, WOUT + (size_t)l * 2 * DM * DM, M, DM, DM, (size_t)DM * DM * 2, nullptr, nullptr, 0}; pg8::StaticOrder S; S.init(M, DM, G, bx);
            const bool lastl = (l == NL - 1);
            pg8::EpiOut E{lastl ? nullptr : XB, out, SSQ, XB};
            const pg8::PanelWait PW{(unsigned*)(ws + WS_CTL) + CW_PANEL + (l * 64 + 8 * (bx % 8) + (bx / 8) % 8) * 16, 4u, lo < p0 + 2};
            for (int rep_ = 0; rep_ < REPS(p0 + 2); ++rep_) pg8::gemm_phase<pg8::EpiOut, false, pg8::PanelWait>(lds, g, S, E, 0, PW);
            if (l == 0 && lo < p0 + 1 && p0 + 3 < hi) {
                asm volatile("s_waitcnt vmcnt(0)" ::: "memory");
                __syncthreads();
                if (tid == 0) __hip_atomic_fetch_add((unsigned*)(ws + WS_CTL) + CW_PANEL2 + (8 * (bx % 8) + (bx / 8) % 8) * 16, 1u, __ATOMIC_RELAXED, __HIP_MEMORY_SCOPE_AGENT);
            } else SEAM(p0 + 2);
        }
    }
    if (pass_ + 1 < PROBE_PASSES) xcd_barrier(bar);
  }
    if (PROBE_TS >= 0) { xcd_barrier(bar); if (vcu == PROBE_VCU && threadIdx.x == 0) { const unsigned long long a_ = ((unsigned long long)MISC[19] << 32) | MISC[18], b_ = ((unsigned long long)MISC[17] << 32) | MISC[16]; out[0] += ((float)(a_ - b_) * 0.01f - PROBE_TS_OFF) * PROBE_TS_SCALE; } }
#undef IN
#undef SEAM
}

extern "C" void kernel_launch(void* const* d_in, const int* in_sizes, int n_in, void* d_out, int out_size, void* d_ws, size_t ws_size, hipStream_t stream) {
    static int grid = 0;
    if (grid == 0) {
        if (n_in != 12 || in_sizes[0] != M * DM || out_size != M * DM || ws_size < WS_END) { fprintf(stderr, "kernel_launch: unexpected shapes (n_in %d, in0 %d, out %d, ws %zu)\n", n_in, n_in > 0 ? in_sizes[0] : -1, out_size, ws_size); grid = -1; return; }
        int dev = 0, cus = 0, per_cu = 0;
        if (hipGetDevice(&dev) != hipSuccess || hipDeviceGetAttribute(&cus, hipDeviceAttributeMultiprocessorCount, dev) != hipSuccess) { grid = -1; return; }
        if (hipOccupancyMaxActiveBlocksPerMultiprocessor(&per_cu, (const void*)mk_fwd, NWAVES * 64, 0) != hipSuccess || per_cu < 1) { fprintf(stderr, "kernel_launch: occupancy query says %d\n", per_cu); per_cu = 1; }
        (void)hipGetLastError();
        grid = cus;
    }
    if (grid < 0) return;
    (void)hipMemsetAsync((char*)d_ws + WS_CTL, 0, CTL_ZERO_BYTES, stream);
    Args a{};
    for (int i = 0; i < 12; ++i) a.in[i] = (const float*)d_in[i];
    a.out = (float*)d_out; a.ws = (unsigned char*)d_ws;
#if MK_PER_PHASE
    for (int p = 0; p < 8; ++p) { a.ph_lo = p; a.ph_hi = p + 1; hipLaunchKernelGGL(mk_fwd, dim3(grid), dim3(NWAVES * 64), 0, stream, a); }
#else
    a.ph_lo = 0; a.ph_hi = 8;
    hipLaunchKernelGGL(mk_fwd, dim3(grid), dim3(NWAVES * 64), 0, stream, a);
#endif
}
```
